# Optimizing an MI355X kernel written in HIP

```python
import math
import numpy as np
import jax
import jax.numpy as jnp
from jax import lax

D_MODEL = 1024
BATCH = 32
SEQ = 2048
DEPTH = 4

N_A_LAYERS = DEPTH // 2
N_B_LAYERS = DEPTH - N_A_LAYERS
DN_ALPHA = (2.0 * DEPTH) ** 0.25
DN_BETA = (8.0 * DEPTH) ** -0.25
LN_EPS = 1e-5
FFN_DIM = int(math.ceil(8 * D_MODEL / 3 / 256)) * 256
SGU_HIDDEN = 4 * D_MODEL
SGU_HALF = SGU_HIDDEN // 2
SGU_GROUPS = 8
SGU_GROUP_DIM = SGU_HALF // SGU_GROUPS
SGU_CHUNK = 128
N_HEADS = 16
N_KV_GROUPS = 4
HEADS_PER_GROUP = N_HEADS // N_KV_GROUPS
HEAD_DIM = D_MODEL // N_HEADS
CMP_LEN = 32
CMP_STRIDE = 16
PHI_HIDDEN = 256
SEL_LEN = 64
SEL_TOP_N = 8
N_LOCAL_BLOCKS = 2
WINDOW = 512
NSA_Q_BLOCK = 32
N_KV_SLOTS = 6
REL_BUCKETS = 32
REL_MAX_DIST = 128
NEG = -1e30

kernel_name = 'yoco_gmlp_nsa_macaron_deepnorm'


def layer_norm(x, g, b):
    xf = x.astype(jnp.float32)
    mu = jnp.mean(xf, axis=-1, keepdims=True)
    var = jnp.mean(jnp.square(xf - mu), axis=-1, keepdims=True)
    y = (xf - mu) * lax.rsqrt(var + LN_EPS)
    return (y * g.astype(jnp.float32) + b.astype(jnp.float32)).astype(x.dtype)


def post_norm(x, sub, g, b):
    return layer_norm(DN_ALPHA * x + sub, g, b)


def swiglu(x, w1, w3, w2):
    return (jax.nn.silu(x @ w1) * (x @ w3)) @ w2


def rel_bucket(dist):
    n = jnp.maximum(dist, 0)
    max_exact = REL_BUCKETS // 2
    nf = jnp.maximum(n, 1).astype(jnp.float32)
    large = max_exact + (jnp.log(nf / max_exact) / math.log(REL_MAX_DIST / max_exact)
                         * (REL_BUCKETS - max_exact)).astype(jnp.int32)
    return jnp.where(n < max_exact, n, jnp.minimum(large, REL_BUCKETS - 1))


def chunked_sgu_mixer(x, w_in, ln_g, ln_b, w_s, b_s, w_out):
    B, S, _ = x.shape
    z = jax.nn.gelu(x @ w_in, approximate=False)
    u, v = jnp.split(z, 2, axis=-1)
    v = layer_norm(v, ln_g, ln_b)
    n_chunks = S // SGU_CHUNK
    v = v.reshape(B, n_chunks, SGU_CHUNK, SGU_GROUPS, SGU_GROUP_DIM)
    causal = jnp.tril(jnp.ones((SGU_CHUNK, SGU_CHUNK), dtype=bool))
    w = jnp.where(causal[None], w_s, jnp.zeros_like(w_s))
    mixed = jnp.einsum('gts,bnsgc->bntgc', w, v) + b_s.T[None, None, :, :, None]
    return (u * mixed.reshape(B, S, SGU_HALF)) @ w_out


def compress(kv, pe, w1, b1, w2):
    B, S, G, Dh = kv.shape
    n_sub = CMP_LEN // CMP_STRIDE
    n_chunks = S // CMP_STRIDE
    n_cmp = n_chunks - n_sub + 1
    chunks = kv.reshape(B, n_chunks, CMP_STRIDE, G, Dh)
    blocks = jnp.concatenate([chunks[:, i:i + n_cmp] for i in range(n_sub)], axis=2)
    blocks = blocks + pe[None, None, :, None, :]
    flat = blocks.transpose(0, 1, 3, 2, 4).reshape(B, n_cmp, G, CMP_LEN * Dh)
    return jax.nn.gelu(flat @ w1 + b1, approximate=False) @ w2


def nsa_shared_kv(h, kv_w, cmp_pe, cmp_w1, cmp_b1, cmp_w2):
    B, S, _ = h.shape
    kv = (h @ kv_w).reshape(B, S, N_KV_SLOTS, N_KV_GROUPS, HEAD_DIM)
    k_cmp = compress(kv[:, :, 0], cmp_pe[0], cmp_w1[0], cmp_b1[0], cmp_w2[0])
    v_cmp = compress(kv[:, :, 1], cmp_pe[1], cmp_w1[1], cmp_b1[1], cmp_w2[1])
    n_sel = S // SEL_LEN
    k_sel = kv[:, :, 2].reshape(B, n_sel, SEL_LEN, N_KV_GROUPS, HEAD_DIM).transpose(0, 3, 1, 2, 4)
    v_sel = kv[:, :, 3].reshape(B, n_sel, SEL_LEN, N_KV_GROUPS, HEAD_DIM).transpose(0, 3, 1, 2, 4)
    pad = ((0, 0), (WINDOW, 0), (0, 0), (0, 0))
    k_win = jnp.pad(kv[:, :, 4], pad)
    v_win = jnp.pad(kv[:, :, 5], pad)
    return (k_cmp, v_cmp, k_sel, v_sel, k_win, v_win)


def masked_softmax(s, mask):
    p = jax.nn.softmax(jnp.where(mask, s, NEG), axis=-1)
    return jnp.where(mask, p, 0.0)


def cmp_to_sel_overlap(n_cmp, n_sel):
    i = np.arange(n_cmp)[:, None]
    j = np.arange(n_sel)[None, :]
    ov = (i * CMP_STRIDE < (j + 1) * SEL_LEN) & (i * CMP_STRIDE + CMP_LEN > j * SEL_LEN)
    return ov.astype(np.float32)


def nsa_mixer(h, shared, w_qg, w_o, rel_table):
    k_cmp, v_cmp, k_sel, v_sel, k_win, v_win = shared
    B, S, _ = h.shape
    G, HG, Dh, QB = N_KV_GROUPS, HEADS_PER_GROUP, HEAD_DIM, NSA_Q_BLOCK
    qg = h @ w_qg
    q = qg[..., :N_HEADS * Dh].reshape(B, S, G, HG, Dh) * (Dh ** -0.5)
    gates = jax.nn.sigmoid(qg[..., N_HEADS * Dh:]).reshape(B, S, G, HG, 3)
    n_qb = S // QB
    n_cmp = k_cmp.shape[1]
    n_sel = k_sel.shape[2]
    n_top = min(SEL_TOP_N, n_sel)
    overlap = jnp.asarray(cmp_to_sel_overlap(n_cmp, n_sel))
    cmp_end = jnp.arange(n_cmp, dtype=jnp.int32) * CMP_STRIDE + (CMP_LEN - 1)
    sel_ids = jnp.arange(n_sel, dtype=jnp.int32)
    b_idx = jnp.arange(B)[:, None, None]
    g_idx = jnp.arange(G)[None, :, None]
    g_idx4 = jnp.arange(G)[None, :, None, None]
    tbl_g = rel_table.reshape(REL_BUCKETS, G, HG)

    def head_bias(dist):
        return rel_table[rel_bucket(dist)].reshape(dist.shape + (G, HG)).transpose(2, 3, 0, 1).astype(jnp.float32)

    def block(args):
        q_b, g_b, q0 = args
        t = q0 + jnp.arange(QB, dtype=jnp.int32)
        dist_c = t[:, None] - cmp_end[None, :]
        mask_c = dist_c >= 0
        s_c = jnp.einsum('bqghd,bngd->bghqn', q_b, k_cmp).astype(jnp.float32) + head_bias(dist_c)
        p_c = masked_softmax(s_c, mask_c)
        o_c = jnp.einsum('bghqn,bngd->bqghd', p_c.astype(v_cmp.dtype), v_cmp)
        imp = jnp.einsum('bghqn,nj->bgqj', p_c, overlap)
        cur = t // SEL_LEN
        valid = sel_ids[None, :] <= cur[:, None]
        forced = valid & ((sel_ids[None, :] == 0) | (sel_ids[None, :] > cur[:, None] - N_LOCAL_BLOCKS))
        imp = jnp.where(forced, -NEG, jnp.where(valid, imp, NEG))
        _, idx = lax.top_k(imp, n_top)
        flat = idx.reshape(B, G, QB * n_top)
        k_g = k_sel[b_idx, g_idx, flat].reshape(B, G, QB, n_top * SEL_LEN, Dh)
        v_g = v_sel[b_idx, g_idx, flat].reshape(B, G, QB, n_top * SEL_LEN, Dh)
        pos = (idx[..., None] * SEL_LEN + jnp.arange(SEL_LEN, dtype=jnp.int32)).reshape(B, G, QB, n_top * SEL_LEN)
        dist_s = t[None, None, :, None] - pos
        mask_s = (dist_s >= 0)[:, :, None]
        bias_s = tbl_g[rel_bucket(dist_s), g_idx4].transpose(0, 1, 4, 2, 3).astype(jnp.float32)
        s_s = jnp.einsum('bqghd,bgqkd->bghqk', q_b, k_g).astype(jnp.float32) + bias_s
        p_s = masked_softmax(s_s, mask_s)
        o_s = jnp.einsum('bghqk,bgqkd->bqghd', p_s.astype(v_g.dtype), v_g)
        k_w = lax.dynamic_slice_in_dim(k_win, q0, WINDOW + QB, axis=1)
        v_w = lax.dynamic_slice_in_dim(v_win, q0, WINDOW + QB, axis=1)
        pos_w = q0 - WINDOW + jnp.arange(WINDOW + QB, dtype=jnp.int32)
        dist_w = t[:, None] - pos_w[None, :]
        mask_w = (dist_w >= 0) & (dist_w < WINDOW) & (pos_w[None, :] >= 0)
        s_w = jnp.einsum('bqghd,bkgd->bghqk', q_b, k_w).astype(jnp.float32) + head_bias(dist_w)
        p_w = masked_softmax(s_w, mask_w)
        o_w = jnp.einsum('bghqk,bkgd->bqghd', p_w.astype(v_w.dtype), v_w)
        return g_b[..., 0:1] * o_c + g_b[..., 1:2] * o_s + g_b[..., 2:3] * o_w

    q_blocks = q.reshape(B, n_qb, QB, G, HG, Dh).swapaxes(0, 1)
    g_blocks = gates.reshape(B, n_qb, QB, G, HG, 3).swapaxes(0, 1)
    starts = jnp.arange(n_qb, dtype=jnp.int32) * QB
    out = lax.map(block, (q_blocks, g_blocks, starts))
    out = out.swapaxes(0, 1).reshape(B, S, N_HEADS * Dh)
    return out @ w_o


def setup_inputs(seed: int = 0) -> dict:
    key = jax.random.key(seed)
    ks = jax.random.split(key, 24)
    f32 = jnp.float32

    def nrm(k, shape, scale):
        return jax.random.normal(k, shape, f32) * scale

    kv_scale = jnp.array([1.0, DN_BETA, 1.0, DN_BETA, 1.0, DN_BETA], f32)[None, :, None]
    kv_w = (nrm(ks[13], (D_MODEL, N_KV_SLOTS, N_KV_GROUPS * HEAD_DIM), D_MODEL ** -0.5) * kv_scale)
    return {
        'x': nrm(ks[0], (BATCH, SEQ, D_MODEL), 1.0),
        'rel_table': nrm(ks[1], (REL_BUCKETS, N_HEADS), 0.5),
        'ln_g': 1.0 + nrm(ks[2], (DEPTH, 3, D_MODEL), 0.05),
        'ln_b': nrm(ks[3], (DEPTH, 3, D_MODEL), 0.02),
        'ffn_w1': nrm(ks[4], (DEPTH, 2, D_MODEL, FFN_DIM), D_MODEL ** -0.5),
        'ffn_w3': nrm(ks[5], (DEPTH, 2, D_MODEL, FFN_DIM), D_MODEL ** -0.5),
        'ffn_w2': nrm(ks[6], (DEPTH, 2, FFN_DIM, D_MODEL), DN_BETA * FFN_DIM ** -0.5),
        'sgu_w_in': nrm(ks[7], (N_A_LAYERS, D_MODEL, SGU_HIDDEN), D_MODEL ** -0.5),
        'sgu_ln_g': 1.0 + nrm(ks[8], (N_A_LAYERS, SGU_HALF), 0.05),
        'sgu_ln_b': nrm(ks[9], (N_A_LAYERS, SGU_HALF), 0.02),
        'sgu_w_s': nrm(ks[10], (N_A_LAYERS, SGU_GROUPS, SGU_CHUNK, SGU_CHUNK), 0.05),
        'sgu_b_s': 1.0 + nrm(ks[11], (N_A_LAYERS, SGU_GROUPS, SGU_CHUNK), 0.05),
        'sgu_w_out': nrm(ks[12], (N_A_LAYERS, SGU_HALF, D_MODEL), DN_BETA * SGU_HALF ** -0.5),
        'kv_w': kv_w.reshape(D_MODEL, N_KV_SLOTS * N_KV_GROUPS * HEAD_DIM),
        'cmp_pe': nrm(ks[14], (2, CMP_LEN, HEAD_DIM), 0.5),
        'cmp_w1': nrm(ks[15], (2, CMP_LEN * HEAD_DIM, PHI_HIDDEN), (CMP_LEN * HEAD_DIM) ** -0.5),
        'cmp_b1': nrm(ks[16], (2, PHI_HIDDEN), 0.02),
        'cmp_w2': nrm(ks[17], (2, PHI_HIDDEN, HEAD_DIM), PHI_HIDDEN ** -0.5),
        'nsa_w_qg': nrm(ks[18], (N_B_LAYERS, D_MODEL, N_HEADS * HEAD_DIM + 3 * N_HEADS), D_MODEL ** -0.5),
        'nsa_w_o': nrm(ks[19], (N_B_LAYERS, N_HEADS * HEAD_DIM, D_MODEL), DN_BETA * (N_HEADS * HEAD_DIM) ** -0.5),
    }


def reference(x, rel_table, ln_g, ln_b, ffn_w1, ffn_w3, ffn_w2, sgu_w_in, sgu_ln_g, sgu_ln_b, sgu_w_s,
              sgu_b_s, sgu_w_out, kv_w, cmp_pe, cmp_w1, cmp_b1, cmp_w2, nsa_w_qg, nsa_w_o):
    h = x
    shared = None
    for layer in range(DEPTH):
        if layer == N_A_LAYERS:
            shared = nsa_shared_kv(h, kv_w, cmp_pe, cmp_w1, cmp_b1, cmp_w2)
        h = post_norm(h, 0.5 * swiglu(h, ffn_w1[layer, 0], ffn_w3[layer, 0], ffn_w2[layer, 0]),
                      ln_g[layer, 0], ln_b[layer, 0])
        if layer < N_A_LAYERS:
            a = layer
            mix = chunked_sgu_mixer(h, sgu_w_in[a], sgu_ln_g[a], sgu_ln_b[a], sgu_w_s[a], sgu_b_s[a], sgu_w_out[a])
        else:
            bl = layer - N_A_LAYERS
            mix = nsa_mixer(h, shared, nsa_w_qg[bl], nsa_w_o[bl], rel_table)
        h = post_norm(h, mix, ln_g[layer, 1], ln_b[layer, 1])
        h = post_norm(h, 0.5 * swiglu(h, ffn_w1[layer, 1], ffn_w3[layer, 1], ffn_w2[layer, 1]),
                      ln_g[layer, 2], ln_b[layer, 2])
    return h
```

```cpp
#include <hip/hip_runtime.h>
#include <hip/hip_cooperative_groups.h>
#include <cstdio>
#include <cstdint>
namespace cg = cooperative_groups;

#ifndef MK_PER_PHASE
#define MK_PER_PHASE 0
#endif
#ifndef NAIVE_SPATIAL
#define NAIVE_SPATIAL 1
#endif

namespace pg8 {
#define PG8_LAS __attribute__((address_space(3)))
typedef unsigned short bf16_t;
typedef short bf16x8 __attribute__((ext_vector_type(8)));
typedef float f32x4 __attribute__((ext_vector_type(4)));
typedef float f32x2 __attribute__((ext_vector_type(2)));
typedef unsigned u32x4 __attribute__((ext_vector_type(4)));
typedef unsigned u32x2 __attribute__((ext_vector_type(2)));
constexpr int BM = 256, BK = 64, HALF = 128, HTB = HALF * BK * 2, STAGE_BYTES = 8 * HTB, NXCD = 8, WGM = 8;

__host__ __device__ __forceinline__ int lds_byte(int r, int c) { const int st = (r >> 4) * 2 + (c >> 5), rr = r & 15, cc = c & 31, ob = rr * 64 + cc * 2; return st * 1024 + (ob ^ (((ob >> 9) & 1) << 5)); }
__host__ __device__ __forceinline__ void stage_rc(int b, int& R, int& C) { const int st = b / 1024, sb = b % 1024, swz = sb ^ (((sb >> 9) & 1) << 5); R = (st >> 1) * 16 + swz / 64; C = (st & 1) * 32 + (swz % 64) / 2; }
__host__ __device__ __forceinline__ int perm32(int rho) { const int n = rho >> 4, i = rho & 15; return 8 * (i >> 2) + 4 * n + (i & 3); }

struct Unit { int pm, pn; };
struct Gemm { const bf16_t* A; const bf16_t* Bt; int M, N, K; int lda; long a_kstep, a_hstep; int a_div; long a_thi, a_tlo; };
__device__ __forceinline__ Gemm make_gemm(const bf16_t* A, const bf16_t* Bt, int M, int N, int K) {
    Gemm g; g.A = A; g.Bt = Bt; g.M = M; g.N = N; g.K = K; g.lda = K; g.a_kstep = BK * 2; g.a_hstep = (long)HALF * K * 2; g.a_div = 1; g.a_thi = (long)BM * K * 2; g.a_tlo = 0; return g;
}

struct StaticOrder {
    int nM, nN, nwg, G, c;
    __host__ __device__ void init(int M, int N, int G_, int c_) { nM = M / BM; nN = N / BM; nwg = nM * nN; G = G_; c = c_; }
    __host__ __device__ bool next(int i, Unit& u) const {
        const long L = (long)i * G + c; if (L >= nwg) return false;
        int wgid = (int)L; { const int q = nwg / NXCD, r = nwg % NXCD, xcd = wgid % NXCD, off = wgid / NXCD; wgid = (xcd < r ? xcd * (q + 1) : r * (q + 1) + (xcd - r) * q) + off; }
        const int nig = WGM * nN, gid = wgid / nig, fm = gid * WGM, gsz = (nM - fm) < WGM ? (nM - fm) : WGM;
        u.pm = fm + ((wgid % nig) % gsz); u.pn = (wgid % nig) / gsz; return true;
    }
};

__device__ __forceinline__ unsigned cvt_pk_bf16(float lo, float hi) { unsigned r; asm volatile("v_cvt_pk_bf16_f32 %0, %1, %2" : "=v"(r) : "v"(lo), "v"(hi)); return r; }
__device__ __forceinline__ f32x2 gelu_pk(f32x2 v) {
    const f32x2 av = __builtin_elementwise_abs(v), d = av * 0.2316418882f + 1.0f;
    f32x2 t; t.x = __builtin_amdgcn_rcpf(d.x); t.y = __builtin_amdgcn_rcpf(d.y);
    f32x2 q = t * 0.5307027145f + (-0.7265760135f); q = q * t + 0.7107068705f; q = q * t + (-0.142248368f); q = q * t + 0.127414796f; q = q * t;
    const f32x2 s = (v * v) * (-0.72134752044f);
    f32x2 e; e.x = __builtin_amdgcn_exp2f(s.x); e.y = __builtin_amdgcn_exp2f(s.y);
    const f32x2 m = v * (q * e), r = v - m;
    f32x2 o; o.x = v.x < 0.f ? m.x : r.x; o.y = v.y < 0.f ? m.y : r.y; return o;
}
__device__ __forceinline__ f32x4 gelu4(f32x4 v) { f32x2 a = gelu_pk((f32x2){v[0], v[1]}), b = gelu_pk((f32x2){v[2], v[3]}); return (f32x4){a.x, a.y, b.x, b.y}; }
__device__ __forceinline__ float bf2f(unsigned short b) { return __uint_as_float(((unsigned)b) << 16); }

template <int ACT> struct EpiBf16 {
    static constexpr bool PERM = true;
    bf16_t* O; int ldc; const float* bias;
    __device__ __forceinline__ void operator()(const f32x4 (&acc)[2][2][4][2], const Unit& u, int wr, int wc, int fr, int fq) const {
        const int row0 = u.pm * BM + wr * 64 + fr; const int col0 = u.pn * BM + wc * 32 + 8 * fq;
        f32x4 bv[2][2];
#pragma unroll
        for (int bj = 0; bj < 2; ++bj)
#pragma unroll
            for (int n = 0; n < 2; ++n) bv[bj][n] = bias ? *(const f32x4*)(bias + col0 + bj * HALF + 4 * n) : (f32x4){0.f, 0.f, 0.f, 0.f};
#pragma unroll
        for (int ai = 0; ai < 2; ++ai)
#pragma unroll
            for (int m = 0; m < 4; ++m) { bf16_t* rowp = O + (size_t)(row0 + ai * HALF + m * 16) * ldc + col0;
#pragma unroll
                for (int bj = 0; bj < 2; ++bj) { f32x4 v0 = acc[ai][bj][m][0] + bv[bj][0], v1 = acc[ai][bj][m][1] + bv[bj][1];
                    if (ACT == 1) { v0 = gelu4(v0); v1 = gelu4(v1); }
                    u32x4 w; w.x = cvt_pk_bf16(v0[0], v0[1]); w.y = cvt_pk_bf16(v0[2], v0[3]); w.z = cvt_pk_bf16(v1[0], v1[1]); w.w = cvt_pk_bf16(v1[2], v1[3]);
                    *(u32x4*)(rowp + bj * HALF) = w; } }
    }
};
struct EpiSwiGLU {
    static constexpr bool PERM = false;
    bf16_t* U; int ldc;
    __device__ __forceinline__ void operator()(const f32x4 (&acc)[2][2][4][2], const Unit& u, int wr, int wc, int fr, int fq) const {
        const int row0 = u.pm * BM + wr * 64 + fr;
#pragma unroll
        for (int ai = 0; ai < 2; ++ai)
#pragma unroll
            for (int m = 0; m < 4; ++m) { bf16_t* rowp = U + (size_t)(row0 + ai * HALF + m * 16) * ldc;
#pragma unroll
                for (int bj = 0; bj < 2; ++bj) { const int G32 = u.pn * 8 + bj * 4 + wc; const f32x4 a = acc[ai][bj][m][0], b = acc[ai][bj][m][1]; f32x4 o;
#pragma unroll
                    for (int j = 0; j < 4; ++j) { const float e = __builtin_amdgcn_exp2f(a[j] * -1.44269504089f); o[j] = a[j] * __builtin_amdgcn_rcpf(1.0f + e) * b[j]; }
                    u32x2 w; w.x = cvt_pk_bf16(o[0], o[1]); w.y = cvt_pk_bf16(o[2], o[3]);
                    *(u32x2*)(rowp + G32 * 16 + fq * 4) = w; } }
    }
};
struct EpiResid {
    static constexpr bool PERM = false;
    const float* Yin; float* Yout; const float* stats; const float* g; const float* b; float alpha, scale;
    __device__ __forceinline__ void operator()(const f32x4 (&acc)[2][2][4][2], const Unit& u, int wr, int wc, int fr, int fq) const {
        const int row0 = u.pm * BM + wr * 64 + fr, col0 = u.pn * BM + wc * 32 + 4 * fq;
#pragma unroll
        for (int bj = 0; bj < 2; ++bj)
#pragma unroll
            for (int n = 0; n < 2; ++n) { const int col = col0 + bj * HALF + n * 16;
                f32x4 gv = (f32x4){1.f, 1.f, 1.f, 1.f}, bv = (f32x4){0.f, 0.f, 0.f, 0.f};
                if (stats) { gv = *(const f32x4*)(g + col); bv = *(const f32x4*)(b + col); }
#pragma unroll
                for (int ai = 0; ai < 2; ++ai)
#pragma unroll
                    for (int m = 0; m < 4; ++m) { const int row = row0 + ai * HALF + m * 16; const size_t off = (size_t)row * 1024 + col;
                        f32x4 y = *(const f32x4*)(Yin + off);
                        if (stats) { const f32x2 st = *(const f32x2*)(stats + 2 * (size_t)row); y = (y - st.x) * st.y * gv + bv; }
                        *(f32x4*)(Yout + off) = y * alpha + acc[ai][bj][m][n] * scale; } }
    }
};
struct EpiSguIn {
    static constexpr bool PERM = false;
    bf16_t* UG; bf16_t* VT; float* VSTAT;
    __device__ __forceinline__ void operator()(const f32x4 (&acc)[2][2][4][2], const Unit& u, int wr, int wc, int fr, int fq) const {
        const int row0 = u.pm * BM + wr * 64 + fr, col0 = u.pn * BM + wc * 32 + 4 * fq;
        if (u.pn < 8) {
#pragma unroll
            for (int ai = 0; ai < 2; ++ai)
#pragma unroll
                for (int m = 0; m < 4; ++m) { bf16_t* rowp = UG + (size_t)(row0 + ai * HALF + m * 16) * 2048 + col0;
#pragma unroll
                    for (int bj = 0; bj < 2; ++bj)
#pragma unroll
                        for (int n = 0; n < 2; ++n) { const f32x4 v = gelu4(acc[ai][bj][m][n]); u32x2 w; w.x = cvt_pk_bf16(v[0], v[1]); w.y = cvt_pk_bf16(v[2], v[3]); *(u32x2*)(rowp + bj * HALF + n * 16) = w; } }
        } else {
            const int c0 = col0 - 2048;
#pragma unroll
            for (int ai = 0; ai < 2; ++ai)
#pragma unroll
                for (int m = 0; m < 4; ++m) { const int row = row0 + ai * HALF + m * 16; float s = 0.f, q = 0.f;
                    bf16_t* base = VT + (size_t)(row >> 7) * (2048 * 128) + (row & 127);
#pragma unroll
                    for (int bj = 0; bj < 2; ++bj)
#pragma unroll
                        for (int n = 0; n < 2; ++n) { const f32x4 v = gelu4(acc[ai][bj][m][n]); const unsigned w0 = cvt_pk_bf16(v[0], v[1]), w1 = cvt_pk_bf16(v[2], v[3]);
                            const int c = c0 + bj * HALF + n * 16; bf16_t* p = base + (size_t)c * 128;
                            const unsigned short h0 = (unsigned short)(w0 & 0xffff), h1 = (unsigned short)(w0 >> 16), h2 = (unsigned short)(w1 & 0xffff), h3 = (unsigned short)(w1 >> 16);
                            p[0] = h0; p[128] = h1; p[256] = h2; p[384] = h3;
                            const float f0 = bf2f(h0), f1 = bf2f(h1), f2 = bf2f(h2), f3 = bf2f(h3);
                            s += (f0 + f1) + (f2 + f3); q += (f0 * f0 + f1 * f1) + (f2 * f2 + f3 * f3); }
                    s += __shfl_xor(s, 16); s += __shfl_xor(s, 32); q += __shfl_xor(q, 16); q += __shfl_xor(q, 32);
                    if (fq == 0) *(f32x2*)(VSTAT + ((size_t)row * 32 + (u.pn - 8) * 4 + wc) * 2) = (f32x2){s, q}; }
        }
    }
};
struct EpiCmp2 {
    static constexpr bool PERM = false;
    bf16_t* KC;
    __device__ __forceinline__ void operator()(const f32x4 (&acc)[2][2][4][2], const Unit& u, int wr, int wc, int fr, int fq) const {
        if (u.pn != 0 || wc >= 2) return;
        const int row0 = u.pm * BM + wr * 64 + fr, col0 = wc * 32 + 4 * fq;
#pragma unroll
        for (int ai = 0; ai < 2; ++ai)
#pragma unroll
            for (int m = 0; m < 4; ++m) { const int row = row0 + ai * HALF + m * 16; const bool z = (row & 127) == 127;
#pragma unroll
                for (int n = 0; n < 2; ++n) { const f32x4 v = acc[ai][0][m][n]; u32x2 w; w.x = cvt_pk_bf16(v[0], v[1]); w.y = cvt_pk_bf16(v[2], v[3]); if (z) { w.x = 0u; w.y = 0u; }
                    *(u32x2*)(KC + (size_t)row * 64 + col0 + n * 16) = w; } }
    }
};
struct EpiQG {
    static constexpr bool PERM = false;
    bf16_t* Q; float* GATES;
    __device__ __forceinline__ void operator()(const f32x4 (&acc)[2][2][4][2], const Unit& u, int wr, int wc, int fr, int fq) const {
        const int row0 = u.pm * BM + wr * 64 + fr, col0 = u.pn * BM + wc * 32 + 4 * fq;
#pragma unroll
        for (int ai = 0; ai < 2; ++ai)
#pragma unroll
            for (int m = 0; m < 4; ++m) { const int row = row0 + ai * HALF + m * 16;
#pragma unroll
                for (int bj = 0; bj < 2; ++bj)
#pragma unroll
                    for (int n = 0; n < 2; ++n) { const int col = col0 + bj * HALF + n * 16; const f32x4 v = acc[ai][bj][m][n];
                        if (u.pn < 4) { u32x2 w; w.x = cvt_pk_bf16(v[0] * 0.125f, v[1] * 0.125f); w.y = cvt_pk_bf16(v[2] * 0.125f, v[3] * 0.125f); *(u32x2*)(Q + (size_t)row * 1024 + col) = w; }
                        else if (col < 1072) { f32x4 o;
#pragma unroll
                            for (int j = 0; j < 4; ++j) o[j] = __builtin_amdgcn_rcpf(1.0f + __builtin_amdgcn_exp2f(v[j] * -1.44269504089f));
                            *(f32x4*)(GATES + (size_t)row * 48 + (col - 1024)) = o; } } }
    }
};

template <class Epi, class Sched, bool ALIGN_EPI = true>
__device__ __forceinline__ void gemm_phase(PG8_LAS unsigned char* lds, const Gemm g, const Sched& S, const Epi& E) {
    int tid = threadIdx.x; asm volatile("" : "+v"(tid));
    const int wid = __builtin_amdgcn_readfirstlane(tid >> 6), lane = tid & 63, wr = wid >> 2, wc = wid & 3, fr = lane & 15, fq = lane >> 4;
    const int K = g.K, nt = K / BK;
    unsigned voffA[2], voffB[2];
#pragma unroll
    for (int i = 0; i < 2; ++i) { int R, C; stage_rc(tid * 16 + i * 8192, R, C); const int Rb = Epi::PERM ? ((R & ~31) + perm32(R & 31)) : R;
        voffA[i] = (unsigned)(R * g.lda + C) * 2u; voffB[i] = (unsigned)(Rb * K + C) * 2u; }
    const size_t kstepB = (size_t)(BK * 2), hstepB = (size_t)HALF * K * 2, tstepB = 2 * hstepB;
    const size_t kstepA = (size_t)g.a_kstep, hstepA = (size_t)g.a_hstep;
    const unsigned ldsw = (unsigned)wid * 1024u;
    const int aoff = lds_byte(wr * 64 + fr, fq * 8), boff = lds_byte(wc * 32 + fr, fq * 8);
#define PG8_ABASE(pm) ((const char*)g.A + (size_t)((pm) / g.a_div) * (size_t)g.a_thi + (size_t)((pm) % g.a_div) * (size_t)g.a_tlo)
#define PG8_SA(b, h) (((b) * 2 + (h)) * HTB)
#define PG8_SB(b, h) ((4 + (b) * 2 + (h)) * HTB)
#define PG8_STAGE(bufoff, gbase, voff) do { _Pragma("unroll") for (int _i = 0; _i < 2; ++_i) \
        __builtin_amdgcn_global_load_lds((const unsigned*)((const char*)(gbase) + (voff)[_i]), (PG8_LAS unsigned*)(lds + (bufoff) + ldsw + _i * 8192), 16, 0, 0); } while (0)
#define PG8_LDA(dst, b, h) do { _Pragma("unroll") for (int m = 0; m < 4; ++m) _Pragma("unroll") for (int k = 0; k < 2; ++k) dst[m][k] = *(const PG8_LAS bf16x8*)(lds + PG8_SA(b, h) + aoff + m * 2048 + k * 1024); } while (0)
#define PG8_LDB(dst, b, h) do { _Pragma("unroll") for (int n = 0; n < 2; ++n) _Pragma("unroll") for (int k = 0; k < 2; ++k) dst[n][k] = *(const PG8_LAS bf16x8*)(lds + PG8_SB(b, h) + boff + n * 2048 + k * 1024); } while (0)
#define PG8_MMA(ai, bj, At, Bt) do { __builtin_amdgcn_s_setprio(1); _Pragma("unroll") for (int m = 0; m < 4; ++m) _Pragma("unroll") for (int n = 0; n < 2; ++n) _Pragma("unroll") for (int k = 0; k < 2; ++k) \
        acc[ai][bj][m][n] = __builtin_amdgcn_mfma_f32_16x16x32_bf16(Bt[n][k], At[m][k], acc[ai][bj][m][n], 0, 0, 0); __builtin_amdgcn_s_setprio(0); } while (0)
#define PG8_WAIT_V(n) asm volatile("s_waitcnt vmcnt(" #n ")" ::: "memory")
#define PG8_WAIT_L(n) asm volatile("s_waitcnt lgkmcnt(" #n ")" ::: "memory")
#define PG8_BAR __builtin_amdgcn_s_barrier()
#define PG8_SCHED __builtin_amdgcn_sched_barrier(0)
    Unit cur, nxt; int ui = 0;
    if (!S.next(0, cur)) return;
    f32x4 acc[2][2][4][2];
#pragma unroll
    for (int a = 0; a < 2; ++a)
#pragma unroll
        for (int b = 0; b < 2; ++b)
#pragma unroll
            for (int m = 0; m < 4; ++m)
#pragma unroll
                for (int n = 0; n < 2; ++n) acc[a][b][m][n] = (f32x4){0.f, 0.f, 0.f, 0.f};
    bf16x8 At[4][2], B0[2][2], B1[2][2];
    const char* cA = PG8_ABASE(cur.pm); const char* cB = (const char*)g.Bt + (size_t)cur.pn * tstepB;
    PG8_STAGE(PG8_SB(0, 0), cB, voffB); PG8_STAGE(PG8_SB(0, 1), cB + hstepB, voffB); PG8_STAGE(PG8_SA(0, 0), cA, voffA); PG8_STAGE(PG8_SA(0, 1), cA + hstepA, voffA);
    if (wr == 1) PG8_BAR;
    PG8_WAIT_V(2); PG8_BAR;
    PG8_STAGE(PG8_SB(1, 0), cB + kstepB, voffB); PG8_STAGE(PG8_SA(1, 0), cA + kstepA, voffA); PG8_STAGE(PG8_SB(1, 1), cB + hstepB + kstepB, voffB);
    PG8_WAIT_V(6); PG8_BAR;
    for (;;) {
        const bool has_next = S.next(ui + 1, nxt);
        const char* nA = has_next ? PG8_ABASE(nxt.pm) : cA; const char* nB = has_next ? (const char*)g.Bt + (size_t)nxt.pn * tstepB : cB;
        for (int t = 0; t < nt; t += 2) {
            const bool last = (t == nt - 2);
            const char* a1 = cA + (size_t)(t + 1) * kstepA;
            const char* a2 = last ? nA : cA + (size_t)(t + 2) * kstepA; const char* b2 = last ? nB : cB + (size_t)(t + 2) * kstepB;
            const char* a3 = a2 + kstepA; const char* b3 = b2 + kstepB;
            PG8_LDB(B0, 0, 0); PG8_LDB(B1, 0, 1); PG8_SCHED; PG8_LDA(At, 0, 0); PG8_STAGE(PG8_SA(1, 1), a1 + hstepA, voffA);
            PG8_WAIT_V(8); PG8_WAIT_L(0); PG8_BAR; PG8_MMA(0, 0, At, B0); PG8_MMA(0, 1, At, B1); PG8_BAR; PG8_SCHED;
            PG8_LDA(At, 0, 1); PG8_STAGE(PG8_SB(0, 0), b2, voffB); PG8_STAGE(PG8_SB(0, 1), b2 + hstepB, voffB); PG8_STAGE(PG8_SA(0, 0), a2, voffA);
            PG8_WAIT_V(8); PG8_WAIT_L(0); PG8_BAR; PG8_MMA(1, 0, At, B0); PG8_MMA(1, 1, At, B1); PG8_BAR; PG8_SCHED;
            PG8_LDB(B0, 1, 0); PG8_LDB(B1, 1, 1); PG8_SCHED; PG8_LDA(At, 1, 0); PG8_STAGE(PG8_SA(0, 1), a2 + hstepA, voffA);
            PG8_WAIT_V(8); PG8_WAIT_L(0); PG8_BAR; PG8_MMA(0, 0, At, B0); PG8_MMA(0, 1, At, B1); PG8_BAR; PG8_SCHED;
            PG8_LDA(At, 1, 1); PG8_STAGE(PG8_SB(1, 0), b3, voffB); PG8_STAGE(PG8_SB(1, 1), b3 + hstepB, voffB); PG8_STAGE(PG8_SA(1, 0), a3, voffA);
            PG8_WAIT_V(8); PG8_WAIT_L(0); PG8_BAR; PG8_MMA(1, 0, At, B0); PG8_MMA(1, 1, At, B1); PG8_BAR; PG8_SCHED;
        }
        if constexpr (ALIGN_EPI) { if (wr == 0) PG8_BAR; }
        E(acc, cur, wr, wc, fr, fq);
        if (!has_next) break;
#pragma unroll
        for (int a = 0; a < 2; ++a)
#pragma unroll
            for (int b = 0; b < 2; ++b)
#pragma unroll
                for (int m = 0; m < 4; ++m)
#pragma unroll
                    for (int n = 0; n < 2; ++n) acc[a][b][m][n] = (f32x4){0.f, 0.f, 0.f, 0.f};
        cur = nxt; cA = nA; cB = nB; ++ui;
        if constexpr (ALIGN_EPI) { if (wr == 1) PG8_BAR; }
    }
    PG8_WAIT_V(0);
    if constexpr (!ALIGN_EPI) { if (wr == 0) PG8_BAR; }
    PG8_BAR;
#undef PG8_ABASE
#undef PG8_SA
#undef PG8_SB
#undef PG8_STAGE
#undef PG8_LDA
#undef PG8_LDB
#undef PG8_MMA
#undef PG8_WAIT_V
#undef PG8_WAIT_L
#undef PG8_BAR
#undef PG8_SCHED
}
}

#define LAS __attribute__((address_space(3)))
typedef unsigned short bf16;
typedef unsigned v4u __attribute__((ext_vector_type(4)));
typedef unsigned v2u __attribute__((ext_vector_type(2)));
typedef float f32x4 __attribute__((ext_vector_type(4)));
typedef float f32x2 __attribute__((ext_vector_type(2)));
constexpr int NWAVES = 8, NTHR = 512;
constexpr int BATCH = 32, SEQ = 2048, D = 1024, T = BATCH * SEQ, FFN = 2816, NUP = 2 * FFN, SGUH = 4096, SGUHALF = 2048;
constexpr int NKV = 1536, NQG = 1072, NQGP = 1280, NCMPROWS = 16384;
constexpr float ALPHA = 1.681792830507429f, LN_EPS = 1e-5f, NEGF = -1e30f;
constexpr size_t MiB = 1u << 20;
constexpr size_t WS_WUP0 = 1 * MiB, WS_WUP1 = 12 * MiB, WS_WDN0 = 23 * MiB, WS_WDN1 = 29 * MiB, WS_WMIX = 35 * MiB, WS_WMIX2 = 43 * MiB;
constexpr size_t WS_WKV = 47 * MiB, WS_WC1 = 50 * MiB, WS_WC2 = 52 * MiB, WS_BIAS2 = 53 * MiB, WS_STATS = 54 * MiB, WS_VSTAT = 56 * MiB;
constexpr size_t WS_HB = 72 * MiB, WS_SCR = 200 * MiB;
constexpr size_t WS_U = WS_SCR, WS_UG = WS_SCR, WS_VT = WS_SCR + 256 * MiB, WS_Q = WS_SCR, WS_O = WS_SCR + 128 * MiB, WS_GATES = WS_SCR + 256 * MiB;
constexpr size_t WS_KV = 712 * MiB, WS_KC = 904 * MiB, WS_VC = 906 * MiB, WS_HID = 908 * MiB, WS_END = 1000 * MiB;
constexpr int LDS_BYTES = 147456;

__device__ __forceinline__ unsigned f2bf(float f) { unsigned u = __builtin_bit_cast(unsigned, f); return (u + 0x7fffu + ((u >> 16) & 1u)) >> 16; }
__device__ __forceinline__ unsigned pk2(float lo, float hi) { return f2bf(lo) | (f2bf(hi) << 16); }
__device__ __forceinline__ float bflo(unsigned w) { return __uint_as_float(w << 16); }
__device__ __forceinline__ float bfhi(unsigned w) { return __uint_as_float(w & 0xffff0000u); }
__device__ __forceinline__ float wave_sum(float v) {
#pragma unroll
    for (int o = 1; o < 64; o <<= 1) v += __shfl_xor(v, o);
    return v;
}
#define LDS_WAIT() asm volatile("s_waitcnt lgkmcnt(0)" ::: "memory")

__device__ __forceinline__ int rowmap(int n, int mode) { return mode == 0 ? n : (32 * (n >> 4) + (n & 15) + (mode == 2 ? 16 : 0)); }
__device__ __forceinline__ void transpose_item(const float* W, int K, int N, bf16* WT, int mode, LAS float* scr, int item, int lane) {
    const int nblk = (N + 31) / 32, kb = item / nblk, nb = item % nblk, k0 = 64 * kb, n0 = 32 * nb;
    const bool nok = (n0 + (lane & 31)) < N;
#pragma unroll 8
    for (int i = 0; i < 32; ++i) { const int kk = 2 * i + (lane >> 5); scr[kk * 33 + (lane & 31)] = nok ? W[(size_t)(k0 + kk) * N + n0 + (lane & 31)] : 0.f; }
    LDS_WAIT(); asm volatile("" ::: "memory");
    const int c = lane & 7;
#pragma unroll
    for (int j = 0; j < 4; ++j) { const int n = (lane >> 3) + 8 * j; const LAS float* s = scr + (8 * c) * 33 + n;
        v4u o; o.x = pk2(s[0 * 33], s[1 * 33]); o.y = pk2(s[2 * 33], s[3 * 33]); o.z = pk2(s[4 * 33], s[5 * 33]); o.w = pk2(s[6 * 33], s[7 * 33]);
        if (n0 + n < N) *(v4u*)(WT + (size_t)rowmap(n0 + n, mode) * K + k0 + 8 * c) = o; }
    LDS_WAIT(); asm volatile("" ::: "memory");
}
struct Args { const float* in[20]; float* out; unsigned char* ws; int ph_lo, ph_hi; };

__device__ __forceinline__ void get_mat(const Args& a, unsigned char* ws, int cs, int mi, const float*& W, int& K, int& N, bf16*& WT, int& mode) {
    mode = 0;
    if (cs < 4) {
        if (mi < 6) { const int s = mi / 3, k = mi % 3; const size_t wi = (size_t)(cs * 2 + s);
            if (k < 2) { W = a.in[4 + k] + wi * D * FFN; K = D; N = FFN; WT = (bf16*)(ws + (s ? WS_WUP1 : WS_WUP0)); mode = 1 + k; }
            else { W = a.in[6] + wi * FFN * D; K = FFN; N = D; WT = (bf16*)(ws + (s ? WS_WDN1 : WS_WDN0)); } }
        else if (cs < 2) { if (mi == 6) { W = a.in[7] + (size_t)cs * D * SGUH; K = D; N = SGUH; WT = (bf16*)(ws + WS_WMIX); } else { W = a.in[12] + (size_t)cs * SGUHALF * D; K = SGUHALF; N = D; WT = (bf16*)(ws + WS_WMIX2); } }
        else { if (mi == 6) { W = a.in[18] + (size_t)(cs - 2) * D * NQG; K = D; N = NQG; WT = (bf16*)(ws + WS_WMIX); } else { W = a.in[19] + (size_t)(cs - 2) * D * D; K = D; N = D; WT = (bf16*)(ws + WS_WMIX2); } }
    } else {
        if (mi == 0) { W = a.in[13]; K = D; N = NKV; WT = (bf16*)(ws + WS_WKV); }
        else if (mi < 3) { const int s = mi - 1; W = a.in[15] + (size_t)s * 2048 * 256; K = 2048; N = 256; WT = (bf16*)(ws + WS_WC1) + (size_t)s * 256 * 2048; }
        else { const int s = mi - 3; W = a.in[17] + (size_t)s * 256 * 64; K = 256; N = 64; WT = (bf16*)(ws + WS_WC2) + (size_t)s * 256 * 256; }
    }
}
__device__ __forceinline__ void convert_set(const Args& a, unsigned char* ws, int cs, LAS float* scr, int gw, int NGW, int lane) {
    const int nmat = cs < 4 ? 8 : 5;
    for (int mi = 0; mi < nmat; ++mi) { const float* W; int K, N, mode; bf16* WT; get_mat(a, ws, cs, mi, W, K, N, WT, mode);
        const int nitems = (K / 64) * ((N + 31) / 32);
        for (int it = gw; it < nitems; it += NGW) transpose_item(W, K, N, WT, mode, scr, it, lane); }
}

__device__ __forceinline__ void ln_row(const float* yrow, const float* g, const float* b, bf16* hb, float* stats, float* fout, int lane) {
    const f32x4* xr = (const f32x4*)yrow + lane;
    f32x4 v[4]; float s = 0.f;
#pragma unroll
    for (int j = 0; j < 4; ++j) { v[j] = xr[64 * j]; s += (v[j].x + v[j].y) + (v[j].z + v[j].w); }
    const float mean = wave_sum(s) * (1.f / D); float s2 = 0.f;
#pragma unroll
    for (int j = 0; j < 4; ++j) { const f32x4 d = v[j] - mean; s2 += (d.x * d.x + d.y * d.y) + (d.z * d.z + d.w * d.w); }
    const float rstd = 1.f / sqrtf(wave_sum(s2) * (1.f / D) + LN_EPS);
#pragma unroll
    for (int j = 0; j < 4; ++j) { const f32x4 gv = *((const f32x4*)g + lane + 64 * j), bv = *((const f32x4*)b + lane + 64 * j);
        const f32x4 o = (v[j] - mean) * rstd * gv + bv;
        if (fout) *((f32x4*)fout + lane + 64 * j) = o;
        else { v2u w; w.x = pg8::cvt_pk_bf16(o.x, o.y); w.y = pg8::cvt_pk_bf16(o.z, o.w); *((v2u*)hb + lane + 64 * j) = w; } }
    if (stats && lane == 0) { stats[0] = mean; stats[1] = rstd; }
}

constexpr int SP_LD = 136;
__device__ __forceinline__ void spatial_phase(const Args& a, unsigned char* ws, int layer, LAS unsigned char* lds, int G, int bx) {
    int tid = threadIdx.x; asm volatile("" : "+v"(tid));
    LAS bf16* Ws = (LAS bf16*)lds;
    LAS bf16* Vs = (LAS bf16*)(lds + 128 * SP_LD * 2);
    LAS float* MU = (LAS float*)(lds + (128 + 256) * SP_LD * 2);
    const float* w_s = a.in[10] + (size_t)layer * 8 * 128 * 128; const float* b_s = a.in[11] + (size_t)layer * 8 * 128;
    const float* lng = a.in[8] + (size_t)layer * SGUHALF; const float* lnb = a.in[9] + (size_t)layer * SGUHALF;
    bf16* UG = (bf16*)(ws + WS_UG); const bf16* VT = (const bf16*)(ws + WS_VT); const float* VSTAT = (const float*)(ws + WS_VSTAT);
    int gl = -1;
    for (int u = bx; u < 512 * 8; u += G) {
        const int g = u & 7, bn = u >> 3;
        __syncthreads();
        if (g != gl) { gl = g;
            for (int i = tid; i < 128 * 32; i += NTHR) { const int t = i >> 5, s4 = (i & 31) * 4; f32x4 w = *(const f32x4*)(w_s + ((size_t)g * 128 + t) * 128 + s4);
                if (s4 + 0 > t) w.x = 0.f; if (s4 + 1 > t) w.y = 0.f; if (s4 + 2 > t) w.z = 0.f; if (s4 + 3 > t) w.w = 0.f;
                v2u o; o.x = pk2(w.x, w.y); o.y = pk2(w.z, w.w); *(LAS v2u*)(Ws + t * SP_LD + s4) = o; } }
        if (tid < 128) { const float* p = VSTAT + ((size_t)(bn * 128 + tid) * 32) * 2; float s = 0.f, q = 0.f;
#pragma unroll
            for (int j = 0; j < 16; ++j) { const f32x4 v = *(const f32x4*)(p + 4 * j); s += v.x + v.z; q += v.y + v.w; }
            const float mean = s * (1.f / 2048.f); const float var = q * (1.f / 2048.f) - mean * mean;
            MU[tid] = mean; MU[128 + tid] = 1.f / sqrtf(fmaxf(var, 0.f) + LN_EPS); }
        __syncthreads();
        for (int i = tid; i < 256 * 16; i += NTHR) { const int c = i >> 4, s8 = (i & 15) * 8; const int cg = g * 256 + c;
            const v4u raw = *(const v4u*)(VT + ((size_t)bn * 2048 + cg) * 128 + s8); const float gg = lng[cg], bb = lnb[cg];
            const unsigned rw[4] = {raw.x, raw.y, raw.z, raw.w}; unsigned ow[4];
#pragma unroll
            for (int j = 0; j < 4; ++j) { const int s = s8 + 2 * j; const float x0 = (bflo(rw[j]) - MU[s]) * MU[128 + s] * gg + bb, x1 = (bfhi(rw[j]) - MU[s + 1]) * MU[128 + s + 1] * gg + bb; ow[j] = pk2(x0, x1); }
            *(LAS v4u*)(Vs + c * SP_LD + s8) = (v4u){ow[0], ow[1], ow[2], ow[3]}; }
        __syncthreads();
#if NAIVE_SPATIAL
        { const int c = tid & 255, th = tid >> 8;
          for (int t = th * 64; t < th * 64 + 64; ++t) { float acc = 0.f;
              for (int s8 = 0; s8 <= (t >> 3); ++s8) { const v4u wv = *(const LAS v4u*)(Ws + t * SP_LD + s8 * 8), vv = *(const LAS v4u*)(Vs + c * SP_LD + s8 * 8);
                  acc += bflo(wv.x) * bflo(vv.x) + bfhi(wv.x) * bfhi(vv.x) + bflo(wv.y) * bflo(vv.y) + bfhi(wv.y) * bfhi(vv.y)
                       + bflo(wv.z) * bflo(vv.z) + bfhi(wv.z) * bfhi(vv.z) + bflo(wv.w) * bflo(vv.w) + bfhi(wv.w) * bfhi(vv.w); }
              const size_t off = (size_t)(bn * 128 + t) * 2048 + g * 256 + c;
              const float uu = pg8::bf2f(UG[off]); UG[off] = (bf16)f2bf(uu * (acc + b_s[g * 128 + t])); } }
#endif
    }
    __syncthreads();
}

__device__ __forceinline__ int rel_bucket(int n) {
    if (n < 16) return n;
    const int large = 16 + (int)(logf((float)n / 16.0f) / 2.0794415416798357f * 16.0f);
    return large < 31 ? large : 31;
}
__device__ __forceinline__ float dot64(const LAS bf16* qs, const bf16* kp) {
    float s = 0.f;
#pragma unroll 2
    for (int d8 = 0; d8 < 8; ++d8) { const v4u kv = *(const v4u*)(kp + d8 * 8), qv = *(const LAS v4u*)(qs + d8 * 8);
        s += bflo(kv.x) * bflo(qv.x) + bfhi(kv.x) * bfhi(qv.x) + bflo(kv.y) * bflo(qv.y) + bfhi(kv.y) * bfhi(qv.y)
           + bflo(kv.z) * bflo(qv.z) + bfhi(kv.z) * bfhi(qv.z) + bflo(kv.w) * bflo(qv.w) + bfhi(kv.w) * bfhi(qv.w); }
    return s;
}
#define ACC_PV(o, p, vp) do { _Pragma("unroll") for (int d8 = 0; d8 < 4; ++d8) { const v4u vv = *(const v4u*)((vp) + d8 * 8); \
    o[d8 * 8 + 0] += (p) * bflo(vv.x); o[d8 * 8 + 1] += (p) * bfhi(vv.x); o[d8 * 8 + 2] += (p) * bflo(vv.y); o[d8 * 8 + 3] += (p) * bfhi(vv.y); \
    o[d8 * 8 + 4] += (p) * bflo(vv.z); o[d8 * 8 + 5] += (p) * bfhi(vv.z); o[d8 * 8 + 6] += (p) * bflo(vv.w); o[d8 * 8 + 7] += (p) * bfhi(vv.w); } } while (0)

__device__ __forceinline__ void attn_naive_phase(const Args& a, unsigned char* ws, LAS unsigned char* lds, int G, int bx) {
    int tid = threadIdx.x; asm volatile("" : "+v"(tid));
    const int ql = tid >> 3, h = (tid >> 1) & 3, dh = tid & 1;
    LAS bf16* QS = (LAS bf16*)lds;
    LAS float* IMPQ = (LAS float*)(lds + 512 * 72 * 2);
    LAS float* BLUT = IMPQ + 64 * 32;
    const bf16* Q = (const bf16*)(ws + WS_Q); bf16* O = (bf16*)(ws + WS_O); const float* GATES = (const float*)(ws + WS_GATES);
    const bf16* KV = (const bf16*)(ws + WS_KV); const bf16* KC = (const bf16*)(ws + WS_KC); const bf16* VC = (const bf16*)(ws + WS_VC);
    const float* rel = a.in[1];
    LAS bf16* qs = QS + tid * 72;
    for (int item = bx; item < BATCH * 4 * 32; item += G) {
        const int qb = item & 31, g = (item >> 5) & 3, b = item >> 7;
        const int q0 = qb * 64, t = q0 + ql, head = g * 4 + h;
        const size_t row = (size_t)b * SEQ + t;
        __syncthreads();
        { const v4u* src = (const v4u*)(Q + row * 1024 + head * 64);
#pragma unroll
          for (int d8 = 0; d8 < 8; ++d8) *(LAS v4u*)(qs + d8 * 8) = src[d8]; }
        { const int hh = tid >> 7, dd = tid & 127; BLUT[hh * 128 + dd] = rel[rel_bucket(dd) * 16 + g * 4 + hh]; }
        __syncthreads();
        const LAS float* blut = BLUT + h * 128;
        const float g0 = GATES[row * 48 + head * 3 + 0], g1 = GATES[row * 48 + head * 3 + 1], g2 = GATES[row * 48 + head * 3 + 2];
        float ot[32];
#pragma unroll
        for (int d = 0; d < 32; ++d) ot[d] = 0.f;
        const bf16* kc = KC + (size_t)(b * 4 + g) * 128 * 64; const bf16* vc = VC + (size_t)(b * 4 + g) * 128 * 64 + dh * 32;
        float m = NEGF, l = 0.f;
        for (int i = 0; i < 127; ++i) { const int dist = t - (16 * i + 31); const bool valid = dist >= 0;
            float s = dot64(qs, kc + i * 64) + blut[min(max(dist, 0), 127)]; if (!valid) s = NEGF;
            const float mn = fmaxf(m, s); l = l * __expf(m - mn) + (valid ? __expf(s - mn) : 0.f); m = mn; }
        const float linv = l > 0.f ? 1.f / l : 0.f;
        {   float o[32];
#pragma unroll
            for (int d = 0; d < 32; ++d) o[d] = 0.f;
            for (int j = 0; j < 32; ++j) { float sum = 0.f;
                for (int i = max(4 * j - 1, 0); i <= min(4 * j + 3, 126); ++i) { const int dist = t - (16 * i + 31); const bool valid = dist >= 0;
                    const float s = dot64(qs, kc + i * 64) + blut[min(max(dist, 0), 127)];
                    const float p = valid ? __expf(s - m) * linv : 0.f; sum += p;
                    if (i >= 4 * j) ACC_PV(o, p, vc + i * 64); }
                sum += __shfl_xor(sum, 2); sum += __shfl_xor(sum, 4);
                if ((tid & 7) == 0) IMPQ[ql * 32 + j] = sum; }
#pragma unroll
            for (int d = 0; d < 32; ++d) ot[d] += g0 * o[d];
        }
        __syncthreads();
        unsigned mask = 0u; const int cur = t >> 6;
        for (int jj = 0; jj < 4; ++jj) { const int j = (tid & 7) * 4 + jj;
            const bool vj = j <= cur, fj = vj && (j == 0 || j > cur - 2); const float valj = fj ? 1e30f : (vj ? IMPQ[ql * 32 + j] : -1e30f);
            int rank = 0;
            for (int k = 0; k < 32; ++k) { const bool vk = k <= cur, fk = vk && (k == 0 || k > cur - 2); const float valk = fk ? 1e30f : (vk ? IMPQ[ql * 32 + k] : -1e30f);
                rank += (valk > valj || (valk == valj && k < j)) ? 1 : 0; }
            if (rank < 8) mask |= 1u << j; }
        mask |= __shfl_xor(mask, 1); mask |= __shfl_xor(mask, 2); mask |= __shfl_xor(mask, 4);
        {   float o[32];
#pragma unroll
            for (int d = 0; d < 32; ++d) o[d] = 0.f;
            m = NEGF; l = 0.f;
            const bf16* kb = KV + (size_t)b * SEQ * NKV + 2 * 256 + g * 64; const bf16* vb = KV + (size_t)b * SEQ * NKV + 3 * 256 + g * 64 + dh * 32;
            const int pend = q0 + 64;
            for (int pos = 0; pos < pend; ++pos) { const int dist = t - pos; const bool valid = dist >= 0 && ((mask >> (pos >> 6)) & 1u);
                float s = dot64(qs, kb + (size_t)pos * NKV) + blut[min(max(dist, 0), 127)]; if (!valid) s = NEGF;
                const float mn = fmaxf(m, s), corr = __expf(m - mn), p = valid ? __expf(s - mn) : 0.f; l = l * corr + p; m = mn;
#pragma unroll
                for (int d = 0; d < 32; ++d) o[d] *= corr;
                ACC_PV(o, p, vb + (size_t)pos * NKV); }
            const float sc = l > 0.f ? g1 / l : 0.f;
#pragma unroll
            for (int d = 0; d < 32; ++d) ot[d] += sc * o[d];
        }
        {   float o[32];
#pragma unroll
            for (int d = 0; d < 32; ++d) o[d] = 0.f;
            m = NEGF; l = 0.f;
            const bf16* kb = KV + (size_t)b * SEQ * NKV + 4 * 256 + g * 64; const bf16* vb = KV + (size_t)b * SEQ * NKV + 5 * 256 + g * 64 + dh * 32;
            const int pbeg = max(0, q0 - 511), pend = q0 + 64;
            for (int pos = pbeg; pos < pend; ++pos) { const int dist = t - pos; const bool valid = dist >= 0 && dist < 512;
                float s = dot64(qs, kb + (size_t)pos * NKV) + blut[min(max(dist, 0), 127)]; if (!valid) s = NEGF;
                const float mn = fmaxf(m, s), corr = __expf(m - mn), p = valid ? __expf(s - mn) : 0.f; l = l * corr + p; m = mn;
#pragma unroll
                for (int d = 0; d < 32; ++d) o[d] *= corr;
                ACC_PV(o, p, vb + (size_t)pos * NKV); }
            const float sc = l > 0.f ? g2 / l : 0.f;
#pragma unroll
            for (int d = 0; d < 32; ++d) ot[d] += sc * o[d];
        }
        { v4u* dst = (v4u*)(O + row * 1024 + head * 64 + dh * 32);
#pragma unroll
          for (int d8 = 0; d8 < 4; ++d8) dst[d8] = (v4u){pk2(ot[d8 * 8 + 0], ot[d8 * 8 + 1]), pk2(ot[d8 * 8 + 2], ot[d8 * 8 + 3]), pk2(ot[d8 * 8 + 4], ot[d8 * 8 + 5]), pk2(ot[d8 * 8 + 6], ot[d8 * 8 + 7])}; }
    }
    __syncthreads();
}

enum { PT_PREP = 0, PT_UP, PT_DOWN, PT_LN, PT_SGUIN, PT_SPATIAL, PT_SGUOUT, PT_KV, PT_CMP1, PT_CMP2, PT_QG, PT_ATTN, PT_WO };
constexpr int N_PHASES = 44;
__device__ __forceinline__ void decode_phase(int ph, int& type, int& layer, int& sub) {
    if (ph == 0) { type = PT_PREP; layer = 0; sub = 0; return; }
    int p;
    if (ph <= 10) { layer = 0; p = ph - 1; }
    else if (ph <= 20) { layer = 1; p = ph - 11; }
    else if (ph <= 33) { layer = 2; p = ph - 21; if (p < 3) { type = PT_KV + p; sub = 0; return; } p -= 3; }
    else { layer = 3; p = ph - 34; }
    const bool A = layer < 2;
    switch (p) {
        case 0: type = PT_UP; sub = 0; break;
        case 1: type = PT_DOWN; sub = 0; break;
        case 2: type = PT_LN; sub = 0; break;
        case 3: type = A ? PT_SGUIN : PT_QG; sub = 0; break;
        case 4: type = A ? PT_SPATIAL : PT_ATTN; sub = 0; break;
        case 5: type = A ? PT_SGUOUT : PT_WO; sub = 0; break;
        case 6: type = PT_LN; sub = 1; break;
        case 7: type = PT_UP; sub = 1; break;
        case 8: type = PT_DOWN; sub = 1; break;
        default: type = PT_LN; sub = 2; break;
    }
}

__global__ void __launch_bounds__(NTHR, 2) mega_fwd(Args kargs) {
    extern __shared__ __attribute__((aligned(16))) unsigned char lds_raw[];
    LAS unsigned char* lds = (LAS unsigned char*)lds_raw;
    const int tid = threadIdx.x, wave = __builtin_amdgcn_readfirstlane(tid >> 6);
    int G = gridDim.x, bx = blockIdx.x;
    unsigned char* ws = kargs.ws; float* Y = kargs.out; const int ph_lo = kargs.ph_lo, ph_hi = kargs.ph_hi;
    LAS float* scr = (LAS float*)(lds + wave * 16384);
    using namespace pg8;

    for (int ph = ph_lo; ph < ph_hi; ++ph) {
        int type, layer, sub; decode_phase(ph, type, layer, sub);
        int cs0 = -1, cs1 = -1;
        const Args* ap = (const Args*)__builtin_amdgcn_kernarg_segment_ptr(); asm volatile("" : "+s"(ap));
        const Args& args = *ap;
        int lane = threadIdx.x & 63; asm volatile("" : "+v"(lane));
        asm volatile("" : "+s"(ws), "+s"(G), "+s"(bx), "+s"(Y));
        bf16* HB = (bf16*)(ws + WS_HB); float* STATS = (float*)(ws + WS_STATS);
        const int gw = bx * NWAVES + wave, NGW = G * NWAVES;
        switch (type) {
        case PT_PREP: {
            cs0 = 4; cs1 = 0;
            if (gw < 512) { const int s = gw >> 8, j = gw & 255; const float* pe = args.in[14] + (size_t)s * 2048; const float* w1 = args.in[15] + (size_t)s * 2048 * 256; float acc = 0.f;
                for (int k = lane; k < 2048; k += 64) acc += pe[k] * w1[(size_t)k * 256 + j];
                acc = wave_sum(acc); if (lane == 0) ((float*)(ws + WS_BIAS2))[gw] = acc + args.in[16][gw]; }
            const float* x = args.in[0];
            for (size_t i = (size_t)bx * NTHR + tid; i < (size_t)T * D / 8; i += (size_t)G * NTHR) { const f32x4 a0 = *((const f32x4*)x + 2 * i), a1 = *((const f32x4*)x + 2 * i + 1);
                *((v4u*)HB + i) = (v4u){cvt_pk_bf16(a0.x, a0.y), cvt_pk_bf16(a0.z, a0.w), cvt_pk_bf16(a1.x, a1.y), cvt_pk_bf16(a1.z, a1.w)}; }
        } break;
        case PT_UP: {
            Gemm g = make_gemm(HB, (const bf16*)(ws + (sub ? WS_WUP1 : WS_WUP0)), T, NUP, D); StaticOrder S; S.init(T, NUP, G, bx);
            EpiSwiGLU E{(bf16*)(ws + WS_U), FFN};
            gemm_phase<EpiSwiGLU, StaticOrder>(lds, g, S, E);
        } break;
        case PT_DOWN: {
            Gemm g = make_gemm((const bf16*)(ws + WS_U), (const bf16*)(ws + (sub ? WS_WDN1 : WS_WDN0)), T, D, FFN); StaticOrder S; S.init(T, D, G, bx);
            const bool first = (layer == 0 && sub == 0);
            const int pl = sub ? layer : layer - 1, pi = sub ? 1 : 2;
            EpiResid E{first ? args.in[0] : Y, Y, first ? nullptr : STATS, first ? nullptr : args.in[2] + (size_t)(pl * 3 + pi) * D, first ? nullptr : args.in[3] + (size_t)(pl * 3 + pi) * D, ALPHA, 0.5f};
            gemm_phase<EpiResid, StaticOrder>(lds, g, S, E);
        } break;
        case PT_LN: {
            const bool fin = (layer == 3 && sub == 2);
            const float* gg = args.in[2] + (size_t)(layer * 3 + sub) * D; const float* bb = args.in[3] + (size_t)(layer * 3 + sub) * D;
            for (int r = gw; r < T; r += NGW) ln_row(Y + (size_t)r * D, gg, bb, HB + (size_t)r * D, fin ? nullptr : STATS + 2 * (size_t)r, fin ? Y + (size_t)r * D : nullptr, lane);
            if (sub == 2 && layer < 3) cs0 = layer + 1;
        } break;
        case PT_SGUIN: {
            Gemm g = make_gemm(HB, (const bf16*)(ws + WS_WMIX), T, SGUH, D); StaticOrder S; S.init(T, SGUH, G, bx);
            EpiSguIn E{(bf16*)(ws + WS_UG), (bf16*)(ws + WS_VT), (float*)(ws + WS_VSTAT)};
            gemm_phase<EpiSguIn, StaticOrder>(lds, g, S, E);
        } break;
        case PT_SPATIAL: spatial_phase(args, ws, layer, lds, G, bx); break;
        case PT_SGUOUT: case PT_WO: {
            const bool sg = type == PT_SGUOUT;
            Gemm g = make_gemm((const bf16*)(ws + (sg ? WS_UG : WS_O)), (const bf16*)(ws + WS_WMIX2), T, D, sg ? SGUHALF : D); StaticOrder S; S.init(T, D, G, bx);
            EpiResid E{Y, Y, STATS, args.in[2] + (size_t)(layer * 3 + 0) * D, args.in[3] + (size_t)(layer * 3 + 0) * D, ALPHA, 1.0f};
            gemm_phase<EpiResid, StaticOrder>(lds, g, S, E);
        } break;
        case PT_KV: {
            Gemm g = make_gemm(HB, (const bf16*)(ws + WS_WKV), T, NKV, D); StaticOrder S; S.init(T, NKV, G, bx);
            EpiBf16<0> E{(bf16*)(ws + WS_KV), NKV, nullptr};
            gemm_phase<EpiBf16<0>, StaticOrder>(lds, g, S, E);
        } break;
        case PT_CMP1: {
            const int half = G / 2, s = bx >= half ? 1 : 0;
            if (bx < 2 * half) {
                Gemm g; g.A = (const bf16*)(ws + WS_KV) + s * 256; g.Bt = (const bf16*)(ws + WS_WC1) + (size_t)s * 256 * 2048; g.M = NCMPROWS; g.N = 256; g.K = 2048;
                g.lda = 16 * NKV; g.a_kstep = NKV * 2; g.a_hstep = 64 * 2; g.a_div = 2; g.a_thi = (long)SEQ * NKV * 2; g.a_tlo = 128 * 2;
                StaticOrder S; S.init(NCMPROWS, 256, half, bx - s * half);
                EpiBf16<1> E{(bf16*)(ws + WS_HID) + (size_t)s * NCMPROWS * 256, 256, (const float*)(ws + WS_BIAS2) + s * 256};
                gemm_phase<EpiBf16<1>, StaticOrder>(lds, g, S, E);
            }
        } break;
        case PT_CMP2: {
            const int half = G / 2, s = bx >= half ? 1 : 0;
            if (bx < 2 * half) {
                Gemm g = make_gemm((const bf16*)(ws + WS_HID) + (size_t)s * NCMPROWS * 256, (const bf16*)(ws + WS_WC2) + (size_t)s * 256 * 256, NCMPROWS, 256, 256);
                StaticOrder S; S.init(NCMPROWS, 256, half, bx - s * half);
                EpiCmp2 E{(bf16*)(ws + (s ? WS_VC : WS_KC))};
                gemm_phase<EpiCmp2, StaticOrder>(lds, g, S, E);
            }
        } break;
        case PT_QG: {
            Gemm g = make_gemm(HB, (const bf16*)(ws + WS_WMIX), T, NQGP, D); StaticOrder S; S.init(T, NQGP, G, bx);
            EpiQG E{(bf16*)(ws + WS_Q), (float*)(ws + WS_GATES)};
            gemm_phase<EpiQG, StaticOrder>(lds, g, S, E);
        } break;
        case PT_ATTN: attn_naive_phase(args, ws, lds, G, bx); break;
        default: break;
        }
        for (int k = 0; k < 2; ++k) { const int cs = k ? cs1 : cs0; if (cs >= 0) convert_set(args, ws, cs, scr, gw, NGW, lane); }
        if (ph + 1 < ph_hi) cg::this_grid().sync();
    }
}

extern "C" void kernel_launch(void* const* d_in, const int* in_sizes, int n_in, void* d_out, int out_size, void* d_ws, size_t ws_size, hipStream_t stream) {
    static int grid = 0;
    if (grid == 0) {
        if (n_in != 20 || in_sizes[0] != T * D || out_size != T * D || ws_size < WS_END) { fprintf(stderr, "kernel_launch: unexpected shapes: n_in %d in0 %d out %d ws %zu\n", n_in, n_in > 0 ? in_sizes[0] : -1, out_size, ws_size); grid = -1; return; }
        int dev = 0, cus = 0, per_cu = 0;
        if (hipGetDevice(&dev) != hipSuccess || hipDeviceGetAttribute(&cus, hipDeviceAttributeMultiprocessorCount, dev) != hipSuccess) { grid = -1; return; }
        if (hipFuncSetAttribute((const void*)mega_fwd, hipFuncAttributeMaxDynamicSharedMemorySize, LDS_BYTES) != hipSuccess) { fprintf(stderr, "kernel_launch: hipFuncSetAttribute failed\n"); grid = -1; return; }
        if (hipOccupancyMaxActiveBlocksPerMultiprocessor(&per_cu, (const void*)mega_fwd, NTHR, LDS_BYTES) != hipSuccess || per_cu < 1) { fprintf(stderr, "kernel_launch: occupancy query says %d\n", per_cu); per_cu = 1; }
        (void)hipGetLastError();
        grid = cus * 1;
        if (grid & 1) grid -= 1;
    }
    if (grid < 0) return;
    Args a{};
    for (int i = 0; i < 20; ++i) a.in[i] = (const float*)d_in[i];
    a.out = (float*)d_out; a.ws = (unsigned char*)d_ws;
#if MK_PER_PHASE
    for (int ph = 0; ph < N_PHASES; ++ph) { a.ph_lo = ph; a.ph_hi = ph + 1; hipLaunchKernelGGL(mega_fwd, dim3(grid), dim3(NTHR), LDS_BYTES, stream, a); }
#else
    a.ph_lo = 0; a.ph_hi = N_PHASES;
    void* kargs[] = {&a};
    hipError_t e = hipLaunchCooperativeKernel((const void*)mega_fwd, dim3(grid), dim3(NTHR), kargs, LDS_BYTES, stream);
    if (e != hipSuccess) fprintf(stderr, "kernel_launch: cooperative launch failed: %s (grid %d)\n", hipGetErrorString(e), grid);
#endif
}
```

```cpp
#include <hip/hip_runtime.h>
#include <hip/hip_cooperative_groups.h>
#include <cstdio>
#include <cstdint>
namespace cg = cooperative_groups;

#ifndef MK_PER_PHASE
#define MK_PER_PHASE 0
#endif
#ifndef NAIVE_SPATIAL
#define NAIVE_SPATIAL 1
#endif

namespace pg8 {
#define PG8_LAS __attribute__((address_space(3)))
typedef unsigned short bf16_t;
typedef short bf16x8 __attribute__((ext_vector_type(8)));
typedef float f32x4 __attribute__((ext_vector_type(4)));
typedef float f32x2 __attribute__((ext_vector_type(2)));
typedef unsigned u32x4 __attribute__((ext_vector_type(4)));
typedef unsigned u32x2 __attribute__((ext_vector_type(2)));
constexpr float QSCALE = 0.125f * 1.4426950408889634f;
constexpr int BM = 256, BK = 64, HALF = 128, HTB = HALF * BK * 2, STAGE_BYTES = 8 * HTB, NXCD = 8, WGM = 8;

__host__ __device__ __forceinline__ int lds_byte(int r, int c) { const int st = (r >> 4) * 2 + (c >> 5), rr = r & 15, cc = c & 31, ob = rr * 64 + cc * 2; return st * 1024 + (ob ^ (((ob >> 9) & 1) << 5)); }
__host__ __device__ __forceinline__ void stage_rc(int b, int& R, int& C) { const int st = b / 1024, sb = b % 1024, swz = sb ^ (((sb >> 9) & 1) << 5); R = (st >> 1) * 16 + swz / 64; C = (st & 1) * 32 + (swz % 64) / 2; }
__host__ __device__ __forceinline__ int perm32(int rho) { const int n = rho >> 4, i = rho & 15; return 8 * (i >> 2) + 4 * n + (i & 3); }

struct Unit { int pm, pn; };
struct Gemm { const bf16_t* A; const bf16_t* Bt; int M, N, K; int lda; long a_kstep, a_hstep; int a_div; long a_thi, a_tlo; };
__device__ __forceinline__ Gemm make_gemm(const bf16_t* A, const bf16_t* Bt, int M, int N, int K) {
    Gemm g; g.A = A; g.Bt = Bt; g.M = M; g.N = N; g.K = K; g.lda = K; g.a_kstep = BK * 2; g.a_hstep = (long)HALF * K * 2; g.a_div = 1; g.a_thi = (long)BM * K * 2; g.a_tlo = 0; return g;
}

struct StaticOrder {
    int nM, nN, nwg, G, c;
    __host__ __device__ void init(int M, int N, int G_, int c_) { nM = M / BM; nN = N / BM; nwg = nM * nN; G = G_; c = c_; }
    __host__ __device__ bool next(int i, Unit& u) const {
        const long L = (long)i * G + c; if (L >= nwg) return false;
        int wgid = (int)L; { const int q = nwg / NXCD, r = nwg % NXCD, xcd = wgid % NXCD, off = wgid / NXCD; wgid = (xcd < r ? xcd * (q + 1) : r * (q + 1) + (xcd - r) * q) + off; }
        const int nig = WGM * nN, gid = wgid / nig, fm = gid * WGM, gsz = (nM - fm) < WGM ? (nM - fm) : WGM;
        u.pm = fm + ((wgid % nig) % gsz); u.pn = (wgid % nig) / gsz; return true;
    }
};

__device__ __forceinline__ unsigned cvt_pk_bf16(float lo, float hi) { unsigned r; asm volatile("v_cvt_pk_bf16_f32 %0, %1, %2" : "=v"(r) : "v"(lo), "v"(hi)); return r; }
__device__ __forceinline__ f32x2 gelu_pk(f32x2 v) {
    const f32x2 av = __builtin_elementwise_abs(v), d = av * 0.2316418882f + 1.0f;
    f32x2 t; t.x = __builtin_amdgcn_rcpf(d.x); t.y = __builtin_amdgcn_rcpf(d.y);
    f32x2 q = t * 0.5307027145f + (-0.7265760135f); q = q * t + 0.7107068705f; q = q * t + (-0.142248368f); q = q * t + 0.127414796f; q = q * t;
    const f32x2 s = (v * v) * (-0.72134752044f);
    f32x2 e; e.x = __builtin_amdgcn_exp2f(s.x); e.y = __builtin_amdgcn_exp2f(s.y);
    const f32x2 m = v * (q * e), r = v - m;
    f32x2 o; o.x = v.x < 0.f ? m.x : r.x; o.y = v.y < 0.f ? m.y : r.y; return o;
}
__device__ __forceinline__ f32x4 gelu4(f32x4 v) { f32x2 a = gelu_pk((f32x2){v[0], v[1]}), b = gelu_pk((f32x2){v[2], v[3]}); return (f32x4){a.x, a.y, b.x, b.y}; }
__device__ __forceinline__ float bf2f(unsigned short b) { return __uint_as_float(((unsigned)b) << 16); }

template <int ACT> struct EpiBf16 {
    static constexpr bool PERM = true;
    bf16_t* O; int ldc; const float* bias;
    __device__ __forceinline__ void operator()(const f32x4 (&acc)[2][2][4][2], const Unit& u, int wr, int wc, int fr, int fq) const {
        const int row0 = u.pm * BM + wr * 64 + fr; const int col0 = u.pn * BM + wc * 32 + 8 * fq;
        f32x4 bv[2][2];
#pragma unroll
        for (int bj = 0; bj < 2; ++bj)
#pragma unroll
            for (int n = 0; n < 2; ++n) bv[bj][n] = bias ? *(const f32x4*)(bias + col0 + bj * HALF + 4 * n) : (f32x4){0.f, 0.f, 0.f, 0.f};
#pragma unroll
        for (int ai = 0; ai < 2; ++ai)
#pragma unroll
            for (int m = 0; m < 4; ++m) { bf16_t* rowp = O + (size_t)(row0 + ai * HALF + m * 16) * ldc + col0;
#pragma unroll
                for (int bj = 0; bj < 2; ++bj) { f32x4 v0 = acc[ai][bj][m][0] + bv[bj][0], v1 = acc[ai][bj][m][1] + bv[bj][1];
                    if (ACT == 1) { v0 = gelu4(v0); v1 = gelu4(v1); }
                    u32x4 w; w.x = cvt_pk_bf16(v0[0], v0[1]); w.y = cvt_pk_bf16(v0[2], v0[3]); w.z = cvt_pk_bf16(v1[0], v1[1]); w.w = cvt_pk_bf16(v1[2], v1[3]);
                    *(u32x4*)(rowp + bj * HALF) = w; } }
    }
};
struct EpiSwiGLU {
    static constexpr bool PERM = false;
    bf16_t* U; int ldc;
    __device__ __forceinline__ void operator()(const f32x4 (&acc)[2][2][4][2], const Unit& u, int wr, int wc, int fr, int fq) const {
        const int row0 = u.pm * BM + wr * 64 + fr;
#pragma unroll
        for (int ai = 0; ai < 2; ++ai)
#pragma unroll
            for (int m = 0; m < 4; ++m) { bf16_t* rowp = U + (size_t)(row0 + ai * HALF + m * 16) * ldc;
#pragma unroll
                for (int bj = 0; bj < 2; ++bj) { const int G32 = u.pn * 8 + bj * 4 + wc; const f32x4 a = acc[ai][bj][m][0], b = acc[ai][bj][m][1]; f32x4 o;
#pragma unroll
                    for (int j = 0; j < 4; ++j) { const float e = __builtin_amdgcn_exp2f(a[j] * -1.44269504089f); o[j] = a[j] * __builtin_amdgcn_rcpf(1.0f + e) * b[j]; }
                    u32x2 w; w.x = cvt_pk_bf16(o[0], o[1]); w.y = cvt_pk_bf16(o[2], o[3]);
                    *(u32x2*)(rowp + G32 * 16 + fq * 4) = w; } }
    }
};
struct EpiResid {
    static constexpr bool PERM = false;
    const float* Yin; float* Yout; const float* stats; const float* g; const float* b; float alpha, scale;
    __device__ __forceinline__ void operator()(const f32x4 (&acc)[2][2][4][2], const Unit& u, int wr, int wc, int fr, int fq) const {
        const int row0 = u.pm * BM + wr * 64 + fr, col0 = u.pn * BM + wc * 32 + 4 * fq;
#pragma unroll
        for (int bj = 0; bj < 2; ++bj)
#pragma unroll
            for (int n = 0; n < 2; ++n) { const int col = col0 + bj * HALF + n * 16;
                f32x4 gv = (f32x4){1.f, 1.f, 1.f, 1.f}, bv = (f32x4){0.f, 0.f, 0.f, 0.f};
                if (stats) { gv = *(const f32x4*)(g + col); bv = *(const f32x4*)(b + col); }
#pragma unroll
                for (int ai = 0; ai < 2; ++ai)
#pragma unroll
                    for (int m = 0; m < 4; ++m) { const int row = row0 + ai * HALF + m * 16; const size_t off = (size_t)row * 1024 + col;
                        f32x4 y = *(const f32x4*)(Yin + off);
                        if (stats) { const f32x2 st = *(const f32x2*)(stats + 2 * (size_t)row); y = (y - st.x) * st.y * gv + bv; }
                        *(f32x4*)(Yout + off) = y * alpha + acc[ai][bj][m][n] * scale; } }
    }
};
struct EpiSguIn {
    static constexpr bool PERM = false;
    bf16_t* UG; bf16_t* VT; float* VSTAT;
    __device__ __forceinline__ void operator()(const f32x4 (&acc)[2][2][4][2], const Unit& u, int wr, int wc, int fr, int fq) const {
        const int row0 = u.pm * BM + wr * 64 + fr, col0 = u.pn * BM + wc * 32 + 4 * fq;
        if (u.pn < 8) {
#pragma unroll
            for (int ai = 0; ai < 2; ++ai)
#pragma unroll
                for (int m = 0; m < 4; ++m) { bf16_t* rowp = UG + (size_t)(row0 + ai * HALF + m * 16) * 2048 + col0;
#pragma unroll
                    for (int bj = 0; bj < 2; ++bj)
#pragma unroll
                        for (int n = 0; n < 2; ++n) { const f32x4 v = gelu4(acc[ai][bj][m][n]); u32x2 w; w.x = cvt_pk_bf16(v[0], v[1]); w.y = cvt_pk_bf16(v[2], v[3]); *(u32x2*)(rowp + bj * HALF + n * 16) = w; } }
        } else {
            const int c0 = col0 - 2048;
#pragma unroll
            for (int ai = 0; ai < 2; ++ai)
#pragma unroll
                for (int m = 0; m < 4; ++m) { const int row = row0 + ai * HALF + m * 16; float s = 0.f, q = 0.f;
                    bf16_t* base = VT + (size_t)(row >> 7) * (2048 * 128) + (row & 127);
#pragma unroll
                    for (int bj = 0; bj < 2; ++bj)
#pragma unroll
                        for (int n = 0; n < 2; ++n) { const f32x4 v = gelu4(acc[ai][bj][m][n]); const unsigned w0 = cvt_pk_bf16(v[0], v[1]), w1 = cvt_pk_bf16(v[2], v[3]);
                            const int c = c0 + bj * HALF + n * 16; bf16_t* p = base + (size_t)c * 128;
                            const unsigned short h0 = (unsigned short)(w0 & 0xffff), h1 = (unsigned short)(w0 >> 16), h2 = (unsigned short)(w1 & 0xffff), h3 = (unsigned short)(w1 >> 16);
                            p[0] = h0; p[128] = h1; p[256] = h2; p[384] = h3;
                            const float f0 = bf2f(h0), f1 = bf2f(h1), f2 = bf2f(h2), f3 = bf2f(h3);
                            s += (f0 + f1) + (f2 + f3); q += (f0 * f0 + f1 * f1) + (f2 * f2 + f3 * f3); }
                    s += __shfl_xor(s, 16); s += __shfl_xor(s, 32); q += __shfl_xor(q, 16); q += __shfl_xor(q, 32);
                    if (fq == 0) *(f32x2*)(VSTAT + ((size_t)row * 32 + (u.pn - 8) * 4 + wc) * 2) = (f32x2){s, q}; }
        }
    }
};
struct EpiCmp2 {
    static constexpr bool PERM = false;
    bf16_t* KC; int tr;
    __device__ __forceinline__ void operator()(const f32x4 (&acc)[2][2][4][2], const Unit& u, int wr, int wc, int fr, int fq) const {
        if (u.pn != 0 || wc >= 2) return;
        const int row0 = u.pm * BM + wr * 64 + fr, col0 = wc * 32 + 4 * fq;
#pragma unroll
        for (int ai = 0; ai < 2; ++ai)
#pragma unroll
            for (int m = 0; m < 4; ++m) { const int row = row0 + ai * HALF + m * 16; const bool z = (row & 127) == 127;
#pragma unroll
                for (int n = 0; n < 2; ++n) { const f32x4 v = acc[ai][0][m][n]; u32x2 w; w.x = cvt_pk_bf16(v[0], v[1]); w.y = cvt_pk_bf16(v[2], v[3]); if (z) { w.x = 0u; w.y = 0u; }
                    if (!tr) *(u32x2*)(KC + (size_t)row * 64 + col0 + n * 16) = w;
                    else { bf16_t* p = KC + ((size_t)(row >> 7) * 64 + col0 + n * 16) * 128 + (row & 127);
                        p[0] = (bf16_t)(w.x & 0xffff); p[128] = (bf16_t)(w.x >> 16); p[256] = (bf16_t)(w.y & 0xffff); p[384] = (bf16_t)(w.y >> 16); } } }
    }
};
struct EpiKV {
    static constexpr bool PERM = false;
    bf16_t* KV; bf16_t* VT;
    __device__ __forceinline__ void operator()(const f32x4 (&acc)[2][2][4][2], const Unit& u, int wr, int wc, int fr, int fq) const {
        const int row0 = u.pm * BM + wr * 64 + fr, c0 = wc * 32 + 4 * fq;
        const bool tr = (u.pn == 3 || u.pn == 5);
#pragma unroll
        for (int ai = 0; ai < 2; ++ai)
#pragma unroll
            for (int m = 0; m < 4; ++m) { const int row = row0 + ai * HALF + m * 16;
#pragma unroll
                for (int bj = 0; bj < 2; ++bj)
#pragma unroll
                    for (int n = 0; n < 2; ++n) { const f32x4 v = acc[ai][bj][m][n]; u32x2 w; w.x = cvt_pk_bf16(v[0], v[1]); w.y = cvt_pk_bf16(v[2], v[3]); const int c = c0 + bj * HALF + n * 16;
                        if (!tr) *(u32x2*)(KV + (size_t)row * 1536 + u.pn * 256 + c) = w;
                        else { bf16_t* p = VT + (size_t)((u.pn - 3) >> 1) * ((size_t)65536 * 256) + ((size_t)((row >> 11) * 4 + (c >> 6)) * 64 + (c & 63)) * 2048 + (row & 2047);
                            p[0] = (bf16_t)(w.x & 0xffff); p[2048] = (bf16_t)(w.x >> 16); p[4096] = (bf16_t)(w.y & 0xffff); p[6144] = (bf16_t)(w.y >> 16); } } }
    }
};
struct EpiQG {
    static constexpr bool PERM = false;
    bf16_t* Q; float* GATES;
    __device__ __forceinline__ void operator()(const f32x4 (&acc)[2][2][4][2], const Unit& u, int wr, int wc, int fr, int fq) const {
        const int row0 = u.pm * BM + wr * 64 + fr, col0 = u.pn * BM + wc * 32 + 4 * fq;
#pragma unroll
        for (int ai = 0; ai < 2; ++ai)
#pragma unroll
            for (int m = 0; m < 4; ++m) { const int row = row0 + ai * HALF + m * 16;
#pragma unroll
                for (int bj = 0; bj < 2; ++bj)
#pragma unroll
                    for (int n = 0; n < 2; ++n) { const int col = col0 + bj * HALF + n * 16; const f32x4 v = acc[ai][bj][m][n];
                        if (u.pn < 4) { u32x2 w; w.x = cvt_pk_bf16(v[0] * QSCALE, v[1] * QSCALE); w.y = cvt_pk_bf16(v[2] * QSCALE, v[3] * QSCALE); *(u32x2*)(Q + (size_t)row * 1024 + col) = w; }
                        else if (col < 1072) { f32x4 o;
#pragma unroll
                            for (int j = 0; j < 4; ++j) o[j] = __builtin_amdgcn_rcpf(1.0f + __builtin_amdgcn_exp2f(v[j] * -1.44269504089f));
                            *(f32x4*)(GATES + (size_t)row * 48 + (col - 1024)) = o; } } }
    }
};

template <class Epi, class Sched, bool ALIGN_EPI = true>
__device__ __forceinline__ void gemm_phase(PG8_LAS unsigned char* lds, const Gemm g, const Sched& S, const Epi& E) {
    int tid = threadIdx.x; asm volatile("" : "+v"(tid));
    const int wid = __builtin_amdgcn_readfirstlane(tid >> 6), lane = tid & 63, wr = wid >> 2, wc = wid & 3, fr = lane & 15, fq = lane >> 4;
    const int K = g.K, nt = K / BK;
    unsigned voffA[2], voffB[2];
#pragma unroll
    for (int i = 0; i < 2; ++i) { int R, C; stage_rc(tid * 16 + i * 8192, R, C); const int Rb = Epi::PERM ? ((R & ~31) + perm32(R & 31)) : R;
        voffA[i] = (unsigned)(R * g.lda + C) * 2u; voffB[i] = (unsigned)(Rb * K + C) * 2u; }
    const size_t kstepB = (size_t)(BK * 2), hstepB = (size_t)HALF * K * 2, tstepB = 2 * hstepB;
    const size_t kstepA = (size_t)g.a_kstep, hstepA = (size_t)g.a_hstep;
    const unsigned ldsw = (unsigned)wid * 1024u;
    const int aoff = lds_byte(wr * 64 + fr, fq * 8), boff = lds_byte(wc * 32 + fr, fq * 8);
#define PG8_ABASE(pm) ((const char*)g.A + (size_t)((pm) / g.a_div) * (size_t)g.a_thi + (size_t)((pm) % g.a_div) * (size_t)g.a_tlo)
#define PG8_SA(b, h) (((b) * 2 + (h)) * HTB)
#define PG8_SB(b, h) ((4 + (b) * 2 + (h)) * HTB)
#define PG8_STAGE(bufoff, gbase, voff) do { _Pragma("unroll") for (int _i = 0; _i < 2; ++_i) \
        __builtin_amdgcn_global_load_lds((const unsigned*)((const char*)(gbase) + (voff)[_i]), (PG8_LAS unsigned*)(lds + (bufoff) + ldsw + _i * 8192), 16, 0, 0); } while (0)
#define PG8_LDA(dst, b, h) do { _Pragma("unroll") for (int m = 0; m < 4; ++m) _Pragma("unroll") for (int k = 0; k < 2; ++k) dst[m][k] = *(const PG8_LAS bf16x8*)(lds + PG8_SA(b, h) + aoff + m * 2048 + k * 1024); } while (0)
#define PG8_LDB(dst, b, h) do { _Pragma("unroll") for (int n = 0; n < 2; ++n) _Pragma("unroll") for (int k = 0; k < 2; ++k) dst[n][k] = *(const PG8_LAS bf16x8*)(lds + PG8_SB(b, h) + boff + n * 2048 + k * 1024); } while (0)
#define PG8_MMA(ai, bj, At, Bt) do { __builtin_amdgcn_s_setprio(1); _Pragma("unroll") for (int m = 0; m < 4; ++m) _Pragma("unroll") for (int n = 0; n < 2; ++n) _Pragma("unroll") for (int k = 0; k < 2; ++k) \
        acc[ai][bj][m][n] = __builtin_amdgcn_mfma_f32_16x16x32_bf16(Bt[n][k], At[m][k], acc[ai][bj][m][n], 0, 0, 0); __builtin_amdgcn_s_setprio(0); } while (0)
#define PG8_WAIT_V(n) asm volatile("s_waitcnt vmcnt(" #n ")" ::: "memory")
#define PG8_WAIT_L(n) asm volatile("s_waitcnt lgkmcnt(" #n ")" ::: "memory")
#define PG8_BAR __builtin_amdgcn_s_barrier()
#define PG8_SCHED __builtin_amdgcn_sched_barrier(0)
    Unit cur, nxt; int ui = 0;
    if (!S.next(0, cur)) return;
    f32x4 acc[2][2][4][2];
#pragma unroll
    for (int a = 0; a < 2; ++a)
#pragma unroll
        for (int b = 0; b < 2; ++b)
#pragma unroll
            for (int m = 0; m < 4; ++m)
#pragma unroll
                for (int n = 0; n < 2; ++n) acc[a][b][m][n] = (f32x4){0.f, 0.f, 0.f, 0.f};
    bf16x8 At[4][2], B0[2][2], B1[2][2];
    const char* cA = PG8_ABASE(cur.pm); const char* cB = (const char*)g.Bt + (size_t)cur.pn * tstepB;
    PG8_STAGE(PG8_SB(0, 0), cB, voffB); PG8_STAGE(PG8_SB(0, 1), cB + hstepB, voffB); PG8_STAGE(PG8_SA(0, 0), cA, voffA); PG8_STAGE(PG8_SA(0, 1), cA + hstepA, voffA);
    if (wr == 1) PG8_BAR;
    PG8_WAIT_V(2); PG8_BAR;
    PG8_STAGE(PG8_SB(1, 0), cB + kstepB, voffB); PG8_STAGE(PG8_SA(1, 0), cA + kstepA, voffA); PG8_STAGE(PG8_SB(1, 1), cB + hstepB + kstepB, voffB);
    PG8_WAIT_V(6); PG8_BAR;
    for (;;) {
        const bool has_next = S.next(ui + 1, nxt);
        const char* nA = has_next ? PG8_ABASE(nxt.pm) : cA; const char* nB = has_next ? (const char*)g.Bt + (size_t)nxt.pn * tstepB : cB;
        for (int t = 0; t < nt; t += 2) {
            const bool last = (t == nt - 2);
            const char* a1 = cA + (size_t)(t + 1) * kstepA;
            const char* a2 = last ? nA : cA + (size_t)(t + 2) * kstepA; const char* b2 = last ? nB : cB + (size_t)(t + 2) * kstepB;
            const char* a3 = a2 + kstepA; const char* b3 = b2 + kstepB;
            PG8_LDB(B0, 0, 0); PG8_LDB(B1, 0, 1); PG8_SCHED; PG8_LDA(At, 0, 0); PG8_STAGE(PG8_SA(1, 1), a1 + hstepA, voffA);
            PG8_WAIT_V(8); PG8_WAIT_L(0); PG8_BAR; PG8_MMA(0, 0, At, B0); PG8_MMA(0, 1, At, B1); PG8_BAR; PG8_SCHED;
            PG8_LDA(At, 0, 1); PG8_STAGE(PG8_SB(0, 0), b2, voffB); PG8_STAGE(PG8_SB(0, 1), b2 + hstepB, voffB); PG8_STAGE(PG8_SA(0, 0), a2, voffA);
            PG8_WAIT_V(8); PG8_WAIT_L(0); PG8_BAR; PG8_MMA(1, 0, At, B0); PG8_MMA(1, 1, At, B1); PG8_BAR; PG8_SCHED;
            PG8_LDB(B0, 1, 0); PG8_LDB(B1, 1, 1); PG8_SCHED; PG8_LDA(At, 1, 0); PG8_STAGE(PG8_SA(0, 1), a2 + hstepA, voffA);
            PG8_WAIT_V(8); PG8_WAIT_L(0); PG8_BAR; PG8_MMA(0, 0, At, B0); PG8_MMA(0, 1, At, B1); PG8_BAR; PG8_SCHED;
            PG8_LDA(At, 1, 1); PG8_STAGE(PG8_SB(1, 0), b3, voffB); PG8_STAGE(PG8_SB(1, 1), b3 + hstepB, voffB); PG8_STAGE(PG8_SA(1, 0), a3, voffA);
            PG8_WAIT_V(8); PG8_WAIT_L(0); PG8_BAR; PG8_MMA(1, 0, At, B0); PG8_MMA(1, 1, At, B1); PG8_BAR; PG8_SCHED;
        }
        if constexpr (ALIGN_EPI) { if (wr == 0) PG8_BAR; }
        E(acc, cur, wr, wc, fr, fq);
        if (!has_next) break;
#pragma unroll
        for (int a = 0; a < 2; ++a)
#pragma unroll
            for (int b = 0; b < 2; ++b)
#pragma unroll
                for (int m = 0; m < 4; ++m)
#pragma unroll
                    for (int n = 0; n < 2; ++n) acc[a][b][m][n] = (f32x4){0.f, 0.f, 0.f, 0.f};
        cur = nxt; cA = nA; cB = nB; ++ui;
        if constexpr (ALIGN_EPI) { if (wr == 1) PG8_BAR; }
    }
    PG8_WAIT_V(0);
    if constexpr (!ALIGN_EPI) { if (wr == 0) PG8_BAR; }
    PG8_BAR;
#undef PG8_ABASE
#undef PG8_SA
#undef PG8_SB
#undef PG8_STAGE
#undef PG8_LDA
#undef PG8_LDB
#undef PG8_MMA
#undef PG8_WAIT_V
#undef PG8_WAIT_L
#undef PG8_BAR
#undef PG8_SCHED
}
}

#define LAS __attribute__((address_space(3)))
typedef unsigned short bf16;
typedef unsigned v4u __attribute__((ext_vector_type(4)));
typedef unsigned v2u __attribute__((ext_vector_type(2)));
typedef float f32x4 __attribute__((ext_vector_type(4)));
typedef float f32x2 __attribute__((ext_vector_type(2)));
constexpr int NWAVES = 8, NTHR = 512;
constexpr int BATCH = 32, SEQ = 2048, D = 1024, T = BATCH * SEQ, FFN = 2816, NUP = 2 * FFN, SGUH = 4096, SGUHALF = 2048;
constexpr int NKV = 1536, NQG = 1072, NQGP = 1280, NCMPROWS = 16384;
constexpr float ALPHA = 1.681792830507429f, LN_EPS = 1e-5f, NEGF = -1e30f;
constexpr size_t MiB = 1u << 20;
constexpr size_t WS_WUP0 = 1 * MiB, WS_WUP1 = 12 * MiB, WS_WDN0 = 23 * MiB, WS_WDN1 = 29 * MiB, WS_WMIX = 35 * MiB, WS_WMIX2 = 43 * MiB;
constexpr size_t WS_WKV = 47 * MiB, WS_WC1 = 50 * MiB, WS_WC2 = 52 * MiB, WS_BIAS2 = 53 * MiB, WS_STATS = 54 * MiB, WS_VSTAT = 56 * MiB;
constexpr size_t WS_HB = 72 * MiB, WS_SCR = 200 * MiB;
constexpr size_t WS_U = WS_SCR, WS_UG = WS_SCR, WS_VT = WS_SCR + 256 * MiB, WS_Q = WS_SCR, WS_O = WS_SCR + 128 * MiB, WS_GATES = WS_SCR + 256 * MiB;
constexpr size_t WS_KV = 712 * MiB, WS_KC = 904 * MiB, WS_VC = 906 * MiB, WS_HID = 908 * MiB, WS_VTS = 924 * MiB  , WS_END = 1000 * MiB;
constexpr int LDS_BYTES = 147456;

__device__ __forceinline__ unsigned f2bf(float f) { unsigned u = __builtin_bit_cast(unsigned, f); return (u + 0x7fffu + ((u >> 16) & 1u)) >> 16; }
__device__ __forceinline__ unsigned pk2(float lo, float hi) { return f2bf(lo) | (f2bf(hi) << 16); }
__device__ __forceinline__ float bflo(unsigned w) { return __uint_as_float(w << 16); }
__device__ __forceinline__ float bfhi(unsigned w) { return __uint_as_float(w & 0xffff0000u); }
__device__ __forceinline__ float wave_sum(float v) {
#pragma unroll
    for (int o = 1; o < 64; o <<= 1) v += __shfl_xor(v, o);
    return v;
}
#define LDS_WAIT() asm volatile("s_waitcnt lgkmcnt(0)" ::: "memory")

__device__ __forceinline__ int rowmap(int n, int mode) { return mode == 0 ? n : (32 * (n >> 4) + (n & 15) + (mode == 2 ? 16 : 0)); }
__device__ __forceinline__ void transpose_item(const float* W, int K, int N, bf16* WT, int mode, LAS float* scr, int item, int lane) {
    const int nblk = (N + 31) / 32, kb = item / nblk, nb = item % nblk, k0 = 64 * kb, n0 = 32 * nb;
    const bool nok = (n0 + (lane & 31)) < N;
#pragma unroll 8
    for (int i = 0; i < 32; ++i) { const int kk = 2 * i + (lane >> 5); scr[kk * 33 + (lane & 31)] = nok ? W[(size_t)(k0 + kk) * N + n0 + (lane & 31)] : 0.f; }
    LDS_WAIT(); asm volatile("" ::: "memory");
    const int c = lane & 7;
#pragma unroll
    for (int j = 0; j < 4; ++j) { const int n = (lane >> 3) + 8 * j; const LAS float* s = scr + (8 * c) * 33 + n;
        v4u o; o.x = pk2(s[0 * 33], s[1 * 33]); o.y = pk2(s[2 * 33], s[3 * 33]); o.z = pk2(s[4 * 33], s[5 * 33]); o.w = pk2(s[6 * 33], s[7 * 33]);
        if (n0 + n < N) *(v4u*)(WT + (size_t)rowmap(n0 + n, mode) * K + k0 + 8 * c) = o; }
    LDS_WAIT(); asm volatile("" ::: "memory");
}
struct Args { const float* in[20]; float* out; unsigned char* ws; int ph_lo, ph_hi; };

__device__ __forceinline__ void get_mat(const Args& a, unsigned char* ws, int cs, int mi, const float*& W, int& K, int& N, bf16*& WT, int& mode) {
    mode = 0;
    if (cs < 4) {
        if (mi < 6) { const int s = mi / 3, k = mi % 3; const size_t wi = (size_t)(cs * 2 + s);
            if (k < 2) { W = a.in[4 + k] + wi * D * FFN; K = D; N = FFN; WT = (bf16*)(ws + (s ? WS_WUP1 : WS_WUP0)); mode = 1 + k; }
            else { W = a.in[6] + wi * FFN * D; K = FFN; N = D; WT = (bf16*)(ws + (s ? WS_WDN1 : WS_WDN0)); } }
        else if (cs < 2) { if (mi == 6) { W = a.in[7] + (size_t)cs * D * SGUH; K = D; N = SGUH; WT = (bf16*)(ws + WS_WMIX); } else { W = a.in[12] + (size_t)cs * SGUHALF * D; K = SGUHALF; N = D; WT = (bf16*)(ws + WS_WMIX2); } }
        else { if (mi == 6) { W = a.in[18] + (size_t)(cs - 2) * D * NQG; K = D; N = NQG; WT = (bf16*)(ws + WS_WMIX); } else { W = a.in[19] + (size_t)(cs - 2) * D * D; K = D; N = D; WT = (bf16*)(ws + WS_WMIX2); } }
    } else {
        if (mi == 0) { W = a.in[13]; K = D; N = NKV; WT = (bf16*)(ws + WS_WKV); }
        else if (mi < 3) { const int s = mi - 1; W = a.in[15] + (size_t)s * 2048 * 256; K = 2048; N = 256; WT = (bf16*)(ws + WS_WC1) + (size_t)s * 256 * 2048; }
        else { const int s = mi - 3; W = a.in[17] + (size_t)s * 256 * 64; K = 256; N = 64; WT = (bf16*)(ws + WS_WC2) + (size_t)s * 256 * 256; }
    }
}
__device__ __forceinline__ void convert_set(const Args& a, unsigned char* ws, int cs, LAS float* scr, int gw, int NGW, int lane) {
    const int nmat = cs < 4 ? 8 : 5;
    for (int mi = 0; mi < nmat; ++mi) { const float* W; int K, N, mode; bf16* WT; get_mat(a, ws, cs, mi, W, K, N, WT, mode);
        const int nitems = (K / 64) * ((N + 31) / 32);
        for (int it = gw; it < nitems; it += NGW) transpose_item(W, K, N, WT, mode, scr, it, lane); }
}

__device__ __forceinline__ void ln_row(const float* yrow, const float* g, const float* b, bf16* hb, float* stats, float* fout, int lane) {
    const f32x4* xr = (const f32x4*)yrow + lane;
    f32x4 v[4]; float s = 0.f;
#pragma unroll
    for (int j = 0; j < 4; ++j) { v[j] = xr[64 * j]; s += (v[j].x + v[j].y) + (v[j].z + v[j].w); }
    const float mean = wave_sum(s) * (1.f / D); float s2 = 0.f;
#pragma unroll
    for (int j = 0; j < 4; ++j) { const f32x4 d = v[j] - mean; s2 += (d.x * d.x + d.y * d.y) + (d.z * d.z + d.w * d.w); }
    const float rstd = 1.f / sqrtf(wave_sum(s2) * (1.f / D) + LN_EPS);
#pragma unroll
    for (int j = 0; j < 4; ++j) { const f32x4 gv = *((const f32x4*)g + lane + 64 * j), bv = *((const f32x4*)b + lane + 64 * j);
        const f32x4 o = (v[j] - mean) * rstd * gv + bv;
        if (fout) *((f32x4*)fout + lane + 64 * j) = o;
        else { v2u w; w.x = pg8::cvt_pk_bf16(o.x, o.y); w.y = pg8::cvt_pk_bf16(o.z, o.w); *((v2u*)hb + lane + 64 * j) = w; } }
    if (stats && lane == 0) { stats[0] = mean; stats[1] = rstd; }
}

constexpr int SP_LD = 136;
__device__ __forceinline__ void spatial_phase(const Args& a, unsigned char* ws, int layer, LAS unsigned char* lds, int G, int bx) {
    int tid = threadIdx.x; asm volatile("" : "+v"(tid));
    LAS bf16* Ws = (LAS bf16*)lds;
    LAS bf16* Vs = (LAS bf16*)(lds + 128 * SP_LD * 2);
    LAS float* MU = (LAS float*)(lds + (128 + 256) * SP_LD * 2);
    const float* w_s = a.in[10] + (size_t)layer * 8 * 128 * 128; const float* b_s = a.in[11] + (size_t)layer * 8 * 128;
    const float* lng = a.in[8] + (size_t)layer * SGUHALF; const float* lnb = a.in[9] + (size_t)layer * SGUHALF;
    bf16* UG = (bf16*)(ws + WS_UG); const bf16* VT = (const bf16*)(ws + WS_VT); const float* VSTAT = (const float*)(ws + WS_VSTAT);
    int gl = -1;
    for (int u = bx; u < 512 * 8; u += G) {
        const int g = u & 7, bn = u >> 3;
        __syncthreads();
        if (g != gl) { gl = g;
            for (int i = tid; i < 128 * 32; i += NTHR) { const int t = i >> 5, s4 = (i & 31) * 4; f32x4 w = *(const f32x4*)(w_s + ((size_t)g * 128 + t) * 128 + s4);
                if (s4 + 0 > t) w.x = 0.f; if (s4 + 1 > t) w.y = 0.f; if (s4 + 2 > t) w.z = 0.f; if (s4 + 3 > t) w.w = 0.f;
                v2u o; o.x = pk2(w.x, w.y); o.y = pk2(w.z, w.w); *(LAS v2u*)(Ws + t * SP_LD + s4) = o; } }
        if (tid < 128) { const float* p = VSTAT + ((size_t)(bn * 128 + tid) * 32) * 2; float s = 0.f, q = 0.f;
#pragma unroll
            for (int j = 0; j < 16; ++j) { const f32x4 v = *(const f32x4*)(p + 4 * j); s += v.x + v.z; q += v.y + v.w; }
            const float mean = s * (1.f / 2048.f); const float var = q * (1.f / 2048.f) - mean * mean;
            MU[tid] = mean; MU[128 + tid] = 1.f / sqrtf(fmaxf(var, 0.f) + LN_EPS); }
        __syncthreads();
        for (int i = tid; i < 256 * 16; i += NTHR) { const int c = i >> 4, s8 = (i & 15) * 8; const int cg = g * 256 + c;
            const v4u raw = *(const v4u*)(VT + ((size_t)bn * 2048 + cg) * 128 + s8); const float gg = lng[cg], bb = lnb[cg];
            const unsigned rw[4] = {raw.x, raw.y, raw.z, raw.w}; unsigned ow[4];
#pragma unroll
            for (int j = 0; j < 4; ++j) { const int s = s8 + 2 * j; const float x0 = (bflo(rw[j]) - MU[s]) * MU[128 + s] * gg + bb, x1 = (bfhi(rw[j]) - MU[s + 1]) * MU[128 + s + 1] * gg + bb; ow[j] = pk2(x0, x1); }
            *(LAS v4u*)(Vs + c * SP_LD + s8) = (v4u){ow[0], ow[1], ow[2], ow[3]}; }
        __syncthreads();
#if NAIVE_SPATIAL
        { const int c = tid & 255, th = tid >> 8;
          for (int t = th * 64; t < th * 64 + 64; ++t) { float acc = 0.f;
              for (int s8 = 0; s8 <= (t >> 3); ++s8) { const v4u wv = *(const LAS v4u*)(Ws + t * SP_LD + s8 * 8), vv = *(const LAS v4u*)(Vs + c * SP_LD + s8 * 8);
                  acc += bflo(wv.x) * bflo(vv.x) + bfhi(wv.x) * bfhi(vv.x) + bflo(wv.y) * bflo(vv.y) + bfhi(wv.y) * bfhi(vv.y)
                       + bflo(wv.z) * bflo(vv.z) + bfhi(wv.z) * bfhi(vv.z) + bflo(wv.w) * bflo(vv.w) + bfhi(wv.w) * bfhi(vv.w); }
              const size_t off = (size_t)(bn * 128 + t) * 2048 + g * 256 + c;
              const float uu = pg8::bf2f(UG[off]); UG[off] = (bf16)f2bf(uu * (acc + b_s[g * 128 + t])); } }
#endif
    }
    __syncthreads();
}

__device__ __forceinline__ int rel_bucket(int n) {
    if (n < 16) return n;
    const int large = 16 + (int)(logf((float)n / 16.0f) / 2.0794415416798357f * 16.0f);
    return large < 31 ? large : 31;
}
typedef float f32x16 __attribute__((ext_vector_type(16)));
typedef short s16x8 __attribute__((ext_vector_type(8)));
typedef short s16x4 __attribute__((ext_vector_type(4)));
typedef __bf16 bf16x2_t __attribute__((ext_vector_type(2)));
#define MFMA32(a, b, c) __builtin_amdgcn_mfma_f32_32x32x16_bf16((a), (b), (c), 0, 0, 0)
__device__ __forceinline__ unsigned pkbf(float lo, float hi) { return __builtin_bit_cast(unsigned, __builtin_convertvector((f32x2){lo, hi}, bf16x2_t)); }
__device__ __forceinline__ s16x8 pack8(const f32x16& x, int s) {
    v4u p; p.x = pkbf(x[8 * s + 0], x[8 * s + 1]); p.y = pkbf(x[8 * s + 2], x[8 * s + 3]); p.z = pkbf(x[8 * s + 4], x[8 * s + 5]); p.w = pkbf(x[8 * s + 6], x[8 * s + 7]);
    return __builtin_bit_cast(s16x8, p);
}
constexpr int AT_KLD = 72, AT_CLD = 136;
constexpr int AT_BUF = 2 * 64 * AT_KLD * 2;
constexpr int AT_BLUT = 2 * AT_BUF, AT_IMP = AT_BLUT + 2048, AT_SELM = AT_IMP + 8192;

template <bool GEN>
__device__ __forceinline__ void attn_tile(const LAS bf16* Kt, const LAS bf16* Vt, const s16x8 (&qf)[4], f32x16 (&O)[2], float& m_run, float& l_run,
                                          int r, int h, int dl, unsigned wlim, bool ok, float cb, const LAS float* blut) {
    f32x16 S0, S1;
#pragma unroll
    for (int i = 0; i < 16; ++i) { S0[i] = 0.f; S1[i] = 0.f; }
#pragma unroll
    for (int kk = 0; kk < 4; ++kk) {
        const s16x8 a0 = *(const LAS s16x8*)(Kt + r * AT_KLD + 16 * kk + 8 * h), a1 = *(const LAS s16x8*)(Kt + (32 + r) * AT_KLD + 16 * kk + 8 * h);
        S0 = MFMA32(a0, qf[kk], S0); S1 = MFMA32(a1, qf[kk], S1);
    }
    float mx = NEGF;
#pragma unroll
    for (int i = 0; i < 16; ++i) {
        const int off = (i & 3) + 8 * (i >> 2);
        if (GEN) {
            const int d0 = dl - off, d1 = dl - off - 32;
            const bool v0 = ok && ((unsigned)d0 < wlim), v1 = ok && ((unsigned)d1 < wlim);
            const float b0 = blut[min((unsigned)d0, 127u)], b1 = blut[min((unsigned)d1, 127u)];
            S0[i] = v0 ? S0[i] + b0 : NEGF; S1[i] = v1 ? S1[i] + b1 : NEGF;
        } else { S0[i] = ok ? S0[i] + cb : NEGF; S1[i] = ok ? S1[i] + cb : NEGF; }
        mx = fmaxf(mx, fmaxf(S0[i], S1[i]));
    }
    mx = fmaxf(mx, __shfl_xor(mx, 32));
    const float m_new = fmaxf(m_run, mx), m_eff = fmaxf(m_new, -1e29f);
    const float corr = __builtin_amdgcn_exp2f(m_run - m_eff);
    float ps = 0.f;
#pragma unroll
    for (int i = 0; i < 16; ++i) { S0[i] = __builtin_amdgcn_exp2f(S0[i] - m_eff); S1[i] = __builtin_amdgcn_exp2f(S1[i] - m_eff); ps += S0[i] + S1[i]; }
    ps += __shfl_xor(ps, 32);
    l_run = l_run * corr + ps; m_run = m_new;
#pragma unroll
    for (int i = 0; i < 16; ++i) { O[0][i] *= corr; O[1][i] *= corr; }
#pragma unroll
    for (int blk = 0; blk < 2; ++blk)
#pragma unroll
        for (int st = 0; st < 2; ++st) {
            const s16x8 pb = pack8(blk ? S1 : S0, st);
#pragma unroll
            for (int dt = 0; dt < 2; ++dt) {
                const LAS bf16* vp = Vt + (32 * dt + r) * AT_KLD + 32 * blk + 16 * st + 4 * h;
                const s16x4 lo = *(const LAS s16x4*)vp, hi = *(const LAS s16x4*)(vp + 8);
                O[dt] = MFMA32(__builtin_shufflevector(lo, hi, 0, 1, 2, 3, 4, 5, 6, 7), pb, O[dt]);
            }
        }
}

__device__ __forceinline__ void attn_mfma_phase(const Args& a, unsigned char* ws, LAS unsigned char* lds, int G, int bx) {
    int tid = threadIdx.x; asm volatile("" : "+v"(tid));
    const int lane = tid & 63, w = __builtin_amdgcn_readfirstlane(tid >> 6), r = lane & 31, h = lane >> 5, hd = r >> 3, ql = r & 7;
    LAS float* BLUT = (LAS float*)(lds + AT_BLUT); LAS float* IMP = (LAS float*)(lds + AT_IMP); LAS unsigned* SELM = (LAS unsigned*)(lds + AT_SELM);
    const bf16* Q = (const bf16*)(ws + WS_Q); bf16* Og = (bf16*)(ws + WS_O); const float* GATES = (const float*)(ws + WS_GATES);
    const bf16* KV = (const bf16*)(ws + WS_KV); const bf16* KC = (const bf16*)(ws + WS_KC); const bf16* VCT = (const bf16*)(ws + WS_VC); const bf16* VTS = (const bf16*)(ws + WS_VTS);
    const float* rel = a.in[1];
    const LAS float* blut = BLUT + hd * 128;
    const int srow = tid >> 3, sch = tid & 7;
    for (int item = bx; item < BATCH * 4 * 32; item += G) {
        const int qb = item & 31, g = (item >> 5) & 3, b = item >> 7;
        const int q0 = qb * 64, tq = q0 + 8 * w + ql, head = g * 4 + hd;
        const size_t row = (size_t)b * SEQ + tq;
        const int bg = b * 4 + g;
        __syncthreads();
#pragma unroll
        for (int j = 0; j < 2; ++j) { const int i = tid + 512 * j;
            { const int rr = i >> 3, ch = i & 7; *(LAS v4u*)((LAS bf16*)lds + rr * AT_KLD + ch * 8) = *(const v4u*)(KC + ((size_t)bg * 128 + rr) * 64 + ch * 8); }
            { const int rr = i >> 4, ch = i & 15; *(LAS v4u*)((LAS bf16*)(lds + AT_BUF) + rr * AT_CLD + ch * 8) = *(const v4u*)(VCT + ((size_t)bg * 64 + rr) * 128 + ch * 8); } }
        { const int hh = tid >> 7, dd = tid & 127; BLUT[hh * 128 + dd] = rel[rel_bucket(dd) * 16 + g * 4 + hh] * 1.4426950408889634f; }
        s16x8 qf[4];
#pragma unroll
        for (int kk = 0; kk < 4; ++kk) qf[kk] = *(const s16x8*)(Q + row * 1024 + head * 64 + 16 * kk + 8 * h);
        const float g0 = GATES[row * 48 + head * 3 + 0], g1 = GATES[row * 48 + head * 3 + 1], g2 = GATES[row * 48 + head * 3 + 2];
        f32x16 Ot[2], O[2];
        __syncthreads();
        {
            const LAS bf16* Kc = (const LAS bf16*)lds; const LAS bf16* Vc = (const LAS bf16*)(lds + AT_BUF);
            f32x16 S[4];
#pragma unroll
            for (int kb = 0; kb < 4; ++kb) {
#pragma unroll
                for (int i = 0; i < 16; ++i) S[kb][i] = 0.f;
#pragma unroll
                for (int kk = 0; kk < 4; ++kk) S[kb] = MFMA32(*(const LAS s16x8*)(Kc + (32 * kb + r) * AT_KLD + 16 * kk + 8 * h), qf[kk], S[kb]);
            }
            float mx = NEGF;
#pragma unroll
            for (int kb = 0; kb < 4; ++kb)
#pragma unroll
                for (int i = 0; i < 16; ++i) { const int ic = 32 * kb + (i & 3) + 8 * (i >> 2) + 4 * h; const int dist = tq - (16 * ic + 31);
                    const float bb = blut[min((unsigned)dist, 127u)]; S[kb][i] = dist >= 0 ? S[kb][i] + bb : NEGF; mx = fmaxf(mx, S[kb][i]); }
            mx = fmaxf(mx, __shfl_xor(mx, 32));
            const float m_eff = fmaxf(mx, -1e29f); float ps = 0.f;
#pragma unroll
            for (int kb = 0; kb < 4; ++kb)
#pragma unroll
                for (int i = 0; i < 16; ++i) { S[kb][i] = __builtin_amdgcn_exp2f(S[kb][i] - m_eff); ps += S[kb][i]; }
            ps += __shfl_xor(ps, 32);
            const float linv = ps > 0.f ? 1.f / ps : 0.f;
#pragma unroll
            for (int kb = 0; kb < 4; ++kb)
#pragma unroll
                for (int i = 0; i < 16; ++i) S[kb][i] *= linv;
            float Lprev = 0.f;
#pragma unroll
            for (int kk = 0; kk < 16; ++kk) { const int kb = kk >> 2, gq = kk & 3;
                const float Gs = (S[kb][4 * gq] + S[kb][4 * gq + 1]) + (S[kb][4 * gq + 2] + S[kb][4 * gq + 3]);
                const float Lo = __shfl_xor(S[kb][4 * gq + 3], 32);
                float v = Gs + (h ? Lo : Lprev); Lprev = Lo;
                v += __shfl_xor(v, 8); v += __shfl_xor(v, 16);
                if (hd == 0) IMP[(8 * w + ql) * 32 + 2 * kk + h] = v; }
#pragma unroll
            for (int i = 0; i < 16; ++i) { O[0][i] = 0.f; O[1][i] = 0.f; }
#pragma unroll
            for (int kb = 0; kb < 4; ++kb)
#pragma unroll
                for (int st = 0; st < 2; ++st) { const s16x8 pb = pack8(S[kb], st);
#pragma unroll
                    for (int dt = 0; dt < 2; ++dt) { const LAS bf16* vp = Vc + (32 * dt + r) * AT_CLD + 32 * kb + 16 * st + 4 * h;
                        const s16x4 lo = *(const LAS s16x4*)vp, hi = *(const LAS s16x4*)(vp + 8);
                        O[dt] = MFMA32(__builtin_shufflevector(lo, hi, 0, 1, 2, 3, 4, 5, 6, 7), pb, O[dt]); } }
#pragma unroll
            for (int i = 0; i < 16; ++i) { Ot[0][i] = g0 * O[0][i]; Ot[1][i] = g0 * O[1][i]; }
        }
        __syncthreads();
        { const int q = tid >> 3, cur = (q0 + q) >> 6; unsigned mbits = 0u;
          for (int jj = 0; jj < 4; ++jj) { const int j = (tid & 7) * 4 + jj;
              const bool vj = j <= cur, fj = vj && (j == 0 || j > cur - 2); const float valj = fj ? 1e30f : (vj ? IMP[q * 32 + j] : -1e30f);
              int rank = 0;
              for (int k = 0; k < 32; ++k) { const bool vk = k <= cur, fk = vk && (k == 0 || k > cur - 2); const float valk = fk ? 1e30f : (vk ? IMP[q * 32 + k] : -1e30f);
                  rank += (valk > valj || (valk == valj && k < j)) ? 1 : 0; }
              if (rank < 8) mbits |= 1u << j; }
          mbits |= __shfl_xor(mbits, 1); mbits |= __shfl_xor(mbits, 2); mbits |= __shfl_xor(mbits, 4);
          if ((tid & 7) == 0) SELM[q] = mbits; }
        const int nsel = qb + 1, pw0 = q0 >= 512 ? q0 - 512 : 0, nwin = ((q0 - pw0) >> 6) + 1, ntile = nsel + nwin;
        const bf16* Ks = KV + (size_t)b * SEQ * NKV + 2 * 256 + g * 64; const bf16* Kw = KV + (size_t)b * SEQ * NKV + 4 * 256 + g * 64;
        const bf16* Vs = VTS + (size_t)bg * 64 * 2048; const bf16* Vw = VTS + (size_t)65536 * 256 + (size_t)bg * 64 * 2048;
        v4u kreg, vreg;
#define AT_LOAD(k) do { const bool sl = (k) < nsel; const int pb_ = sl ? 64 * (k) : pw0 + 64 * ((k) - nsel); \
            kreg = *(const v4u*)((sl ? Ks : Kw) + (size_t)(pb_ + srow) * NKV + sch * 8); vreg = *(const v4u*)((sl ? Vs : Vw) + (size_t)srow * 2048 + pb_ + sch * 8); } while (0)
#define AT_STORE(bufi) do { *(LAS v4u*)((LAS bf16*)(lds + (bufi) * AT_BUF) + srow * AT_KLD + sch * 8) = kreg; *(LAS v4u*)((LAS bf16*)(lds + (bufi) * AT_BUF + 64 * AT_KLD * 2) + srow * AT_KLD + sch * 8) = vreg; } while (0)
        AT_LOAD(0); AT_STORE(0);
        __syncthreads();
        const unsigned selm = SELM[8 * w + ql];
        float m_run = NEGF, l_run = 0.f;
#pragma unroll
        for (int i = 0; i < 16; ++i) { O[0][i] = 0.f; O[1][i] = 0.f; }
        const int tmin = q0 + 8 * w, tmax = tmin + 7;
        const float cbfar = blut[127];
        for (int k = 0; k < ntile; ++k) {
            if (k + 1 < ntile) AT_LOAD(k + 1);
            const bool sl = k < nsel; const int pbase = sl ? 64 * k : pw0 + 64 * (k - nsel);
            const LAS bf16* Kt = (const LAS bf16*)(lds + (k & 1) * AT_BUF); const LAS bf16* Vt = (const LAS bf16*)(lds + (k & 1) * AT_BUF + 64 * AT_KLD * 2);
            const bool ok = sl ? ((selm >> k) & 1u) != 0u : true;
            const bool fast = (tmin - (pbase + 63) >= 127) && (sl || (tmax - pbase < 512));
            if (fast) attn_tile<false>(Kt, Vt, qf, O, m_run, l_run, r, h, 0, 0u, ok, cbfar, blut);
            else attn_tile<true>(Kt, Vt, qf, O, m_run, l_run, r, h, tq - pbase - 4 * h, sl ? 0x7fffffffu : 512u, ok, 0.f, blut);
            if (k + 1 < ntile) AT_STORE((k + 1) & 1);
            __syncthreads();
            if (k == nsel - 1 || k == ntile - 1) {
                const float sc = l_run > 0.f ? (sl ? g1 : g2) / l_run : 0.f;
#pragma unroll
                for (int i = 0; i < 16; ++i) { Ot[0][i] += sc * O[0][i]; Ot[1][i] += sc * O[1][i]; O[0][i] = 0.f; O[1][i] = 0.f; }
                m_run = NEGF; l_run = 0.f;
            }
        }
#undef AT_LOAD
#undef AT_STORE
#pragma unroll
        for (int dt = 0; dt < 2; ++dt)
#pragma unroll
            for (int gq = 0; gq < 4; ++gq) { v2u wv; wv.x = pkbf(Ot[dt][4 * gq], Ot[dt][4 * gq + 1]); wv.y = pkbf(Ot[dt][4 * gq + 2], Ot[dt][4 * gq + 3]);
                *(v2u*)(Og + row * 1024 + head * 64 + 32 * dt + 8 * gq + 4 * h) = wv; }
    }
    __syncthreads();
}

enum { PT_PREP = 0, PT_UP, PT_DOWN, PT_LN, PT_SGUIN, PT_SPATIAL, PT_SGUOUT, PT_KV, PT_CMP1, PT_CMP2, PT_QG, PT_ATTN, PT_WO };
constexpr int N_PHASES = 44;
__device__ __forceinline__ void decode_phase(int ph, int& type, int& layer, int& sub) {
    if (ph == 0) { type = PT_PREP; layer = 0; sub = 0; return; }
    int p;
    if (ph <= 10) { layer = 0; p = ph - 1; }
    else if (ph <= 20) { layer = 1; p = ph - 11; }
    else if (ph <= 33) { layer = 2; p = ph - 21; if (p < 3) { type = PT_KV + p; sub = 0; return; } p -= 3; }
    else { layer = 3; p = ph - 34; }
    const bool A = layer < 2;
    switch (p) {
        case 0: type = PT_UP; sub = 0; break;
        case 1: type = PT_DOWN; sub = 0; break;
        case 2: type = PT_LN; sub = 0; break;
        case 3: type = A ? PT_SGUIN : PT_QG; sub = 0; break;
        case 4: type = A ? PT_SPATIAL : PT_ATTN; sub = 0; break;
        case 5: type = A ? PT_SGUOUT : PT_WO; sub = 0; break;
        case 6: type = PT_LN; sub = 1; break;
        case 7: type = PT_UP; sub = 1; break;
        case 8: type = PT_DOWN; sub = 1; break;
        default: type = PT_LN; sub = 2; break;
    }
}

__global__ void __launch_bounds__(NTHR, 2) mega_fwd(Args kargs) {
    extern __shared__ __attribute__((aligned(16))) unsigned char lds_raw[];
    LAS unsigned char* lds = (LAS unsigned char*)lds_raw;
    const int tid = threadIdx.x, wave = __builtin_amdgcn_readfirstlane(tid >> 6);
    int G = gridDim.x, bx = blockIdx.x;
    unsigned char* ws = kargs.ws; float* Y = kargs.out; const int ph_lo = kargs.ph_lo, ph_hi = kargs.ph_hi;
    LAS float* scr = (LAS float*)(lds + wave * 16384);
    using namespace pg8;

    for (int ph = ph_lo; ph < ph_hi; ++ph) {
        int type, layer, sub; decode_phase(ph, type, layer, sub);
        int cs0 = -1, cs1 = -1;
        const Args* ap = (const Args*)__builtin_amdgcn_kernarg_segment_ptr(); asm volatile("" : "+s"(ap));
        const Args& args = *ap;
        int lane = threadIdx.x & 63; asm volatile("" : "+v"(lane));
        asm volatile("" : "+s"(ws), "+s"(G), "+s"(bx), "+s"(Y));
        bf16* HB = (bf16*)(ws + WS_HB); float* STATS = (float*)(ws + WS_STATS);
        const int gw = bx * NWAVES + wave, NGW = G * NWAVES;
        switch (type) {
        case PT_PREP: {
            cs0 = 4; cs1 = 0;
            if (gw < 512) { const int s = gw >> 8, j = gw & 255; const float* pe = args.in[14] + (size_t)s * 2048; const float* w1 = args.in[15] + (size_t)s * 2048 * 256; float acc = 0.f;
                for (int k = lane; k < 2048; k += 64) acc += pe[k] * w1[(size_t)k * 256 + j];
                acc = wave_sum(acc); if (lane == 0) ((float*)(ws + WS_BIAS2))[gw] = acc + args.in[16][gw]; }
            const float* x = args.in[0];
            for (size_t i = (size_t)bx * NTHR + tid; i < (size_t)T * D / 8; i += (size_t)G * NTHR) { const f32x4 a0 = *((const f32x4*)x + 2 * i), a1 = *((const f32x4*)x + 2 * i + 1);
                *((v4u*)HB + i) = (v4u){cvt_pk_bf16(a0.x, a0.y), cvt_pk_bf16(a0.z, a0.w), cvt_pk_bf16(a1.x, a1.y), cvt_pk_bf16(a1.z, a1.w)}; }
        } break;
        case PT_UP: {
            Gemm g = make_gemm(HB, (const bf16*)(ws + (sub ? WS_WUP1 : WS_WUP0)), T, NUP, D); StaticOrder S; S.init(T, NUP, G, bx);
            EpiSwiGLU E{(bf16*)(ws + WS_U), FFN};
            gemm_phase<EpiSwiGLU, StaticOrder>(lds, g, S, E);
        } break;
        case PT_DOWN: {
            Gemm g = make_gemm((const bf16*)(ws + WS_U), (const bf16*)(ws + (sub ? WS_WDN1 : WS_WDN0)), T, D, FFN); StaticOrder S; S.init(T, D, G, bx);
            const bool first = (layer == 0 && sub == 0);
            const int pl = sub ? layer : layer - 1, pi = sub ? 1 : 2;
            EpiResid E{first ? args.in[0] : Y, Y, first ? nullptr : STATS, first ? nullptr : args.in[2] + (size_t)(pl * 3 + pi) * D, first ? nullptr : args.in[3] + (size_t)(pl * 3 + pi) * D, ALPHA, 0.5f};
            gemm_phase<EpiResid, StaticOrder>(lds, g, S, E);
        } break;
        case PT_LN: {
            const bool fin = (layer == 3 && sub == 2);
            const float* gg = args.in[2] + (size_t)(layer * 3 + sub) * D; const float* bb = args.in[3] + (size_t)(layer * 3 + sub) * D;
            for (int r = gw; r < T; r += NGW) ln_row(Y + (size_t)r * D, gg, bb, HB + (size_t)r * D, fin ? nullptr : STATS + 2 * (size_t)r, fin ? Y + (size_t)r * D : nullptr, lane);
            if (sub == 2 && layer < 3) cs0 = layer + 1;
        } break;
        case PT_SGUIN: {
            Gemm g = make_gemm(HB, (const bf16*)(ws + WS_WMIX), T, SGUH, D); StaticOrder S; S.init(T, SGUH, G, bx);
            EpiSguIn E{(bf16*)(ws + WS_UG), (bf16*)(ws + WS_VT), (float*)(ws + WS_VSTAT)};
            gemm_phase<EpiSguIn, StaticOrder>(lds, g, S, E);
        } break;
        case PT_SPATIAL: spatial_phase(args, ws, layer, lds, G, bx); break;
        case PT_SGUOUT: case PT_WO: {
            const bool sg = type == PT_SGUOUT;
            Gemm g = make_gemm((const bf16*)(ws + (sg ? WS_UG : WS_O)), (const bf16*)(ws + WS_WMIX2), T, D, sg ? SGUHALF : D); StaticOrder S; S.init(T, D, G, bx);
            EpiResid E{Y, Y, STATS, args.in[2] + (size_t)(layer * 3 + 0) * D, args.in[3] + (size_t)(layer * 3 + 0) * D, ALPHA, 1.0f};
            gemm_phase<EpiResid, StaticOrder>(lds, g, S, E);
        } break;
        case PT_KV: {
            Gemm g = make_gemm(HB, (const bf16*)(ws + WS_WKV), T, NKV, D); StaticOrder S; S.init(T, NKV, G, bx);
            EpiKV E{(bf16*)(ws + WS_KV), (bf16*)(ws + WS_VTS)};
            gemm_phase<EpiKV, StaticOrder>(lds, g, S, E);
        } break;
        case PT_CMP1: {
            const int half = G / 2, s = bx >= half ? 1 : 0;
            if (bx < 2 * half) {
                Gemm g; g.A = (const bf16*)(ws + WS_KV) + s * 256; g.Bt = (const bf16*)(ws + WS_WC1) + (size_t)s * 256 * 2048; g.M = NCMPROWS; g.N = 256; g.K = 2048;
                g.lda = 16 * NKV; g.a_kstep = NKV * 2; g.a_hstep = 64 * 2; g.a_div = 2; g.a_thi = (long)SEQ * NKV * 2; g.a_tlo = 128 * 2;
                StaticOrder S; S.init(NCMPROWS, 256, half, bx - s * half);
                EpiBf16<1> E{(bf16*)(ws + WS_HID) + (size_t)s * NCMPROWS * 256, 256, (const float*)(ws + WS_BIAS2) + s * 256};
                gemm_phase<EpiBf16<1>, StaticOrder>(lds, g, S, E);
            }
        } break;
        case PT_CMP2: {
            const int half = G / 2, s = bx >= half ? 1 : 0;
            if (bx < 2 * half) {
                Gemm g = make_gemm((const bf16*)(ws + WS_HID) + (size_t)s * NCMPROWS * 256, (const bf16*)(ws + WS_WC2) + (size_t)s * 256 * 256, NCMPROWS, 256, 256);
                StaticOrder S; S.init(NCMPROWS, 256, half, bx - s * half);
                EpiCmp2 E{(bf16*)(ws + (s ? WS_VC : WS_KC)), s};
                gemm_phase<EpiCmp2, StaticOrder>(lds, g, S, E);
            }
        } break;
        case PT_QG: {
            Gemm g = make_gemm(HB, (const bf16*)(ws + WS_WMIX), T, NQGP, D); StaticOrder S; S.init(T, NQGP, G, bx);
            EpiQG E{(bf16*)(ws + WS_Q), (float*)(ws + WS_GATES)};
            gemm_phase<EpiQG, StaticOrder>(lds, g, S, E);
        } break;
        case PT_ATTN: attn_mfma_phase(args, ws, lds, G, bx); break;
        default: break;
        }
        for (int k = 0; k < 2; ++k) { const int cs = k ? cs1 : cs0; if (cs >= 0) convert_set(args, ws, cs, scr, gw, NGW, lane); }
        if (ph + 1 < ph_hi) cg::this_grid().sync();
    }
}

extern "C" void kernel_launch(void* const* d_in, const int* in_sizes, int n_in, void* d_out, int out_size, void* d_ws, size_t ws_size, hipStream_t stream) {
    static int grid = 0;
    if (grid == 0) {
        if (n_in != 20 || in_sizes[0] != T * D || out_size != T * D || ws_size < WS_END) { fprintf(stderr, "kernel_launch: unexpected shapes: n_in %d in0 %d out %d ws %zu\n", n_in, n_in > 0 ? in_sizes[0] : -1, out_size, ws_size); grid = -1; return; }
        int dev = 0, cus = 0, per_cu = 0;
        if (hipGetDevice(&dev) != hipSuccess || hipDeviceGetAttribute(&cus, hipDeviceAttributeMultiprocessorCount, dev) != hipSuccess) { grid = -1; return; }
        if (hipFuncSetAttribute((const void*)mega_fwd, hipFuncAttributeMaxDynamicSharedMemorySize, LDS_BYTES) != hipSuccess) { fprintf(stderr, "kernel_launch: hipFuncSetAttribute failed\n"); grid = -1; return; }
        if (hipOccupancyMaxActiveBlocksPerMultiprocessor(&per_cu, (const void*)mega_fwd, NTHR, LDS_BYTES) != hipSuccess || per_cu < 1) { fprintf(stderr, "kernel_launch: occupancy query says %d\n", per_cu); per_cu = 1; }
        (void)hipGetLastError();
        grid = cus * 1;
        if (grid & 1) grid -= 1;
    }
    if (grid < 0) return;
    Args a{};
    for (int i = 0; i < 20; ++i) a.in[i] = (const float*)d_in[i];
    a.out = (float*)d_out; a.ws = (unsigned char*)d_ws;
#if MK_PER_PHASE
    for (int ph = 0; ph < N_PHASES; ++ph) { a.ph_lo = ph; a.ph_hi = ph + 1; hipLaunchKernelGGL(mega_fwd, dim3(grid), dim3(NTHR), LDS_BYTES, stream, a); }
#else
    a.ph_lo = 0; a.ph_hi = N_PHASES;
    void* kargs[] = {&a};
    hipError_t e = hipLaunchCooperativeKernel((const void*)mega_fwd, dim3(grid), dim3(NTHR), kargs, LDS_BYTES, stream);
    if (e != hipSuccess) fprintf(stderr, "kernel_launch: cooperative launch failed: %s (grid %d)\n", hipGetErrorString(e), grid);
#endif
}
```

```cpp
#include <hip/hip_runtime.h>
#include <hip/hip_cooperative_groups.h>
#include <cstdio>
#include <cstdint>
namespace cg = cooperative_groups;

#ifndef MK_PER_PHASE
#define MK_PER_PHASE 0
#endif
#ifndef NAIVE_SPATIAL
#define NAIVE_SPATIAL 1
#endif

namespace pg8 {
#define PG8_LAS __attribute__((address_space(3)))
typedef unsigned short bf16_t;
typedef short bf16x8 __attribute__((ext_vector_type(8)));
typedef float f32x4 __attribute__((ext_vector_type(4)));
typedef float f32x2 __attribute__((ext_vector_type(2)));
typedef unsigned u32x4 __attribute__((ext_vector_type(4)));
typedef unsigned u32x2 __attribute__((ext_vector_type(2)));
constexpr float QSCALE = 0.125f * 1.4426950408889634f;
constexpr int BM = 256, BK = 64, HALF = 128, HTB = HALF * BK * 2, STAGE_BYTES = 8 * HTB, NXCD = 8, WGM = 8;

__host__ __device__ __forceinline__ int lds_byte(int r, int c) { const int st = (r >> 4) * 2 + (c >> 5), rr = r & 15, cc = c & 31, ob = rr * 64 + cc * 2; return st * 1024 + (ob ^ (((ob >> 9) & 1) << 5)); }
__host__ __device__ __forceinline__ void stage_rc(int b, int& R, int& C) { const int st = b / 1024, sb = b % 1024, swz = sb ^ (((sb >> 9) & 1) << 5); R = (st >> 1) * 16 + swz / 64; C = (st & 1) * 32 + (swz % 64) / 2; }
__host__ __device__ __forceinline__ int perm32(int rho) { const int n = rho >> 4, i = rho & 15; return 8 * (i >> 2) + 4 * n + (i & 3); }

struct Unit { int pm, pn; };
struct Gemm { const bf16_t* A; const bf16_t* Bt; int M, N, K; int lda; long a_kstep, a_hstep; int a_div; long a_thi, a_tlo; };
__device__ __forceinline__ Gemm make_gemm(const bf16_t* A, const bf16_t* Bt, int M, int N, int K) {
    Gemm g; g.A = A; g.Bt = Bt; g.M = M; g.N = N; g.K = K; g.lda = K; g.a_kstep = BK * 2; g.a_hstep = (long)HALF * K * 2; g.a_div = 1; g.a_thi = (long)BM * K * 2; g.a_tlo = 0; return g;
}

struct StaticOrder {
    int nM, nN, nwg, G, c;
    __host__ __device__ void init(int M, int N, int G_, int c_) { nM = M / BM; nN = N / BM; nwg = nM * nN; G = G_; c = c_; }
    __host__ __device__ bool next(int i, Unit& u) const {
        const long L = (long)i * G + c; if (L >= nwg) return false;
        int wgid = (int)L; { const int q = nwg / NXCD, r = nwg % NXCD, xcd = wgid % NXCD, off = wgid / NXCD; wgid = (xcd < r ? xcd * (q + 1) : r * (q + 1) + (xcd - r) * q) + off; }
        const int nig = WGM * nN, gid = wgid / nig, fm = gid * WGM, gsz = (nM - fm) < WGM ? (nM - fm) : WGM;
        u.pm = fm + ((wgid % nig) % gsz); u.pn = (wgid % nig) / gsz; return true;
    }
};

__device__ __forceinline__ unsigned cvt_pk_bf16(float lo, float hi) { unsigned r; asm volatile("v_cvt_pk_bf16_f32 %0, %1, %2" : "=v"(r) : "v"(lo), "v"(hi)); return r; }
__device__ __forceinline__ f32x2 gelu_pk(f32x2 v) {
    const f32x2 av = __builtin_elementwise_abs(v), d = av * 0.2316418882f + 1.0f;
    f32x2 t; t.x = __builtin_amdgcn_rcpf(d.x); t.y = __builtin_amdgcn_rcpf(d.y);
    f32x2 q = t * 0.5307027145f + (-0.7265760135f); q = q * t + 0.7107068705f; q = q * t + (-0.142248368f); q = q * t + 0.127414796f; q = q * t;
    const f32x2 s = (v * v) * (-0.72134752044f);
    f32x2 e; e.x = __builtin_amdgcn_exp2f(s.x); e.y = __builtin_amdgcn_exp2f(s.y);
    const f32x2 m = v * (q * e), r = v - m;
    f32x2 o; o.x = v.x < 0.f ? m.x : r.x; o.y = v.y < 0.f ? m.y : r.y; return o;
}
__device__ __forceinline__ f32x4 gelu4(f32x4 v) { f32x2 a = gelu_pk((f32x2){v[0], v[1]}), b = gelu_pk((f32x2){v[2], v[3]}); return (f32x4){a.x, a.y, b.x, b.y}; }
__device__ __forceinline__ float bf2f(unsigned short b) { return __uint_as_float(((unsigned)b) << 16); }

template <int ACT> struct EpiBf16 {
    static constexpr bool PERM = true;
    bf16_t* O; int ldc; const float* bias;
    __device__ __forceinline__ void operator()(const f32x4 (&acc)[2][2][4][2], const Unit& u, int wr, int wc, int fr, int fq) const {
        const int row0 = u.pm * BM + wr * 64 + fr; const int col0 = u.pn * BM + wc * 32 + 8 * fq;
        f32x4 bv[2][2];
#pragma unroll
        for (int bj = 0; bj < 2; ++bj)
#pragma unroll
            for (int n = 0; n < 2; ++n) bv[bj][n] = bias ? *(const f32x4*)(bias + col0 + bj * HALF + 4 * n) : (f32x4){0.f, 0.f, 0.f, 0.f};
#pragma unroll
        for (int ai = 0; ai < 2; ++ai)
#pragma unroll
            for (int m = 0; m < 4; ++m) { bf16_t* rowp = O + (size_t)(row0 + ai * HALF + m * 16) * ldc + col0;
#pragma unroll
                for (int bj = 0; bj < 2; ++bj) { f32x4 v0 = acc[ai][bj][m][0] + bv[bj][0], v1 = acc[ai][bj][m][1] + bv[bj][1];
                    if (ACT == 1) { v0 = gelu4(v0); v1 = gelu4(v1); }
                    u32x4 w; w.x = cvt_pk_bf16(v0[0], v0[1]); w.y = cvt_pk_bf16(v0[2], v0[3]); w.z = cvt_pk_bf16(v1[0], v1[1]); w.w = cvt_pk_bf16(v1[2], v1[3]);
                    *(u32x4*)(rowp + bj * HALF) = w; } }
    }
};
struct EpiSwiGLU {
    static constexpr bool PERM = false;
    bf16_t* U; int ldc;
    __device__ __forceinline__ void operator()(const f32x4 (&acc)[2][2][4][2], const Unit& u, int wr, int wc, int fr, int fq) const {
        const int row0 = u.pm * BM + wr * 64 + fr;
#pragma unroll
        for (int ai = 0; ai < 2; ++ai)
#pragma unroll
            for (int m = 0; m < 4; ++m) { bf16_t* rowp = U + (size_t)(row0 + ai * HALF + m * 16) * ldc;
#pragma unroll
                for (int bj = 0; bj < 2; ++bj) { const int G32 = u.pn * 8 + bj * 4 + wc; const f32x4 a = acc[ai][bj][m][0], b = acc[ai][bj][m][1]; f32x4 o;
#pragma unroll
                    for (int j = 0; j < 4; ++j) { const float e = __builtin_amdgcn_exp2f(a[j] * -1.44269504089f); o[j] = a[j] * __builtin_amdgcn_rcpf(1.0f + e) * b[j]; }
                    u32x2 w; w.x = cvt_pk_bf16(o[0], o[1]); w.y = cvt_pk_bf16(o[2], o[3]);
                    *(u32x2*)(rowp + G32 * 16 + fq * 4) = w; } }
    }
};
struct EpiResid {
    static constexpr bool PERM = false;
    const float* Yin; float* Yout; const float* stats; const float* g; const float* b; float alpha, scale;
    __device__ __forceinline__ void operator()(const f32x4 (&acc)[2][2][4][2], const Unit& u, int wr, int wc, int fr, int fq) const {
        const int row0 = u.pm * BM + wr * 64 + fr, col0 = u.pn * BM + wc * 32 + 4 * fq;
#pragma unroll
        for (int bj = 0; bj < 2; ++bj)
#pragma unroll
            for (int n = 0; n < 2; ++n) { const int col = col0 + bj * HALF + n * 16;
                f32x4 gv = (f32x4){1.f, 1.f, 1.f, 1.f}, bv = (f32x4){0.f, 0.f, 0.f, 0.f};
                if (stats) { gv = *(const f32x4*)(g + col); bv = *(const f32x4*)(b + col); }
#pragma unroll
                for (int ai = 0; ai < 2; ++ai)
#pragma unroll
                    for (int m = 0; m < 4; ++m) { const int row = row0 + ai * HALF + m * 16; const size_t off = (size_t)row * 1024 + col;
                        f32x4 y = *(const f32x4*)(Yin + off);
                        if (stats) { const f32x2 st = *(const f32x2*)(stats + 2 * (size_t)row); y = (y - st.x) * st.y * gv + bv; }
                        *(f32x4*)(Yout + off) = y * alpha + acc[ai][bj][m][n] * scale; } }
    }
};
struct EpiSguIn {
    static constexpr bool PERM = false;
    bf16_t* UG; bf16_t* VT; float* VSTAT;
    __device__ __forceinline__ void operator()(const f32x4 (&acc)[2][2][4][2], const Unit& u, int wr, int wc, int fr, int fq) const {
        const int row0 = u.pm * BM + wr * 64 + fr, col0 = u.pn * BM + wc * 32 + 4 * fq;
        if (u.pn < 8) {
#pragma unroll
            for (int ai = 0; ai < 2; ++ai)
#pragma unroll
                for (int m = 0; m < 4; ++m) { bf16_t* rowp = UG + (size_t)(row0 + ai * HALF + m * 16) * 2048 + col0;
#pragma unroll
                    for (int bj = 0; bj < 2; ++bj)
#pragma unroll
                        for (int n = 0; n < 2; ++n) { const f32x4 v = gelu4(acc[ai][bj][m][n]); u32x2 w; w.x = cvt_pk_bf16(v[0], v[1]); w.y = cvt_pk_bf16(v[2], v[3]); *(u32x2*)(rowp + bj * HALF + n * 16) = w; } }
        } else {
            const int c0 = col0 - 2048;
#pragma unroll
            for (int ai = 0; ai < 2; ++ai)
#pragma unroll
                for (int m = 0; m < 4; ++m) { const int row = row0 + ai * HALF + m * 16; float s = 0.f, q = 0.f;
                    bf16_t* base = VT + (size_t)(row >> 7) * (2048 * 128) + (row & 127);
#pragma unroll
                    for (int bj = 0; bj < 2; ++bj)
#pragma unroll
                        for (int n = 0; n < 2; ++n) { const f32x4 v = gelu4(acc[ai][bj][m][n]); const unsigned w0 = cvt_pk_bf16(v[0], v[1]), w1 = cvt_pk_bf16(v[2], v[3]);
                            const int c = c0 + bj * HALF + n * 16; bf16_t* p = base + (size_t)c * 128;
                            const unsigned short h0 = (unsigned short)(w0 & 0xffff), h1 = (unsigned short)(w0 >> 16), h2 = (unsigned short)(w1 & 0xffff), h3 = (unsigned short)(w1 >> 16);
                            p[0] = h0; p[128] = h1; p[256] = h2; p[384] = h3;
                            const float f0 = bf2f(h0), f1 = bf2f(h1), f2 = bf2f(h2), f3 = bf2f(h3);
                            s += (f0 + f1) + (f2 + f3); q += (f0 * f0 + f1 * f1) + (f2 * f2 + f3 * f3); }
                    s += __shfl_xor(s, 16); s += __shfl_xor(s, 32); q += __shfl_xor(q, 16); q += __shfl_xor(q, 32);
                    if (fq == 0) *(f32x2*)(VSTAT + ((size_t)row * 32 + (u.pn - 8) * 4 + wc) * 2) = (f32x2){s, q}; }
        }
    }
};
struct EpiCmp2 {
    static constexpr bool PERM = false;
    bf16_t* KC; int tr;
    __device__ __forceinline__ void operator()(const f32x4 (&acc)[2][2][4][2], const Unit& u, int wr, int wc, int fr, int fq) const {
        if (u.pn != 0 || wc >= 2) return;
        const int row0 = u.pm * BM + wr * 64 + fr, col0 = wc * 32 + 4 * fq;
#pragma unroll
        for (int ai = 0; ai < 2; ++ai)
#pragma unroll
            for (int m = 0; m < 4; ++m) { const int row = row0 + ai * HALF + m * 16; const bool z = (row & 127) == 127;
#pragma unroll
                for (int n = 0; n < 2; ++n) { const f32x4 v = acc[ai][0][m][n]; u32x2 w; w.x = cvt_pk_bf16(v[0], v[1]); w.y = cvt_pk_bf16(v[2], v[3]); if (z) { w.x = 0u; w.y = 0u; }
                    if (!tr) *(u32x2*)(KC + (size_t)row * 64 + col0 + n * 16) = w;
                    else { bf16_t* p = KC + ((size_t)(row >> 7) * 64 + col0 + n * 16) * 128 + (row & 127);
                        p[0] = (bf16_t)(w.x & 0xffff); p[128] = (bf16_t)(w.x >> 16); p[256] = (bf16_t)(w.y & 0xffff); p[384] = (bf16_t)(w.y >> 16); } } }
    }
};
struct EpiKV {
    static constexpr bool PERM = false;
    bf16_t* KV; bf16_t* VT;
    __device__ __forceinline__ void operator()(const f32x4 (&acc)[2][2][4][2], const Unit& u, int wr, int wc, int fr, int fq) const {
        const int row0 = u.pm * BM + wr * 64 + fr, c0 = wc * 32 + 4 * fq;
        const bool tr = (u.pn == 3 || u.pn == 5);
#pragma unroll
        for (int ai = 0; ai < 2; ++ai)
#pragma unroll
            for (int m = 0; m < 4; ++m) { const int row = row0 + ai * HALF + m * 16;
#pragma unroll
                for (int bj = 0; bj < 2; ++bj)
#pragma unroll
                    for (int n = 0; n < 2; ++n) { const f32x4 v = acc[ai][bj][m][n]; u32x2 w; w.x = cvt_pk_bf16(v[0], v[1]); w.y = cvt_pk_bf16(v[2], v[3]); const int c = c0 + bj * HALF + n * 16;
                        if (!tr) *(u32x2*)(KV + (size_t)row * 1536 + u.pn * 256 + c) = w;
                        else { bf16_t* p = VT + (size_t)((u.pn - 3) >> 1) * ((size_t)65536 * 256) + ((size_t)((row >> 11) * 4 + (c >> 6)) * 64 + (c & 63)) * 2048 + (row & 2047);
                            p[0] = (bf16_t)(w.x & 0xffff); p[2048] = (bf16_t)(w.x >> 16); p[4096] = (bf16_t)(w.y & 0xffff); p[6144] = (bf16_t)(w.y >> 16); } } }
    }
};
struct EpiQG {
    static constexpr bool PERM = false;
    bf16_t* Q; float* GATES;
    __device__ __forceinline__ void operator()(const f32x4 (&acc)[2][2][4][2], const Unit& u, int wr, int wc, int fr, int fq) const {
        const int row0 = u.pm * BM + wr * 64 + fr, col0 = u.pn * BM + wc * 32 + 4 * fq;
#pragma unroll
        for (int ai = 0; ai < 2; ++ai)
#pragma unroll
            for (int m = 0; m < 4; ++m) { const int row = row0 + ai * HALF + m * 16;
#pragma unroll
                for (int bj = 0; bj < 2; ++bj)
#pragma unroll
                    for (int n = 0; n < 2; ++n) { const int col = col0 + bj * HALF + n * 16; const f32x4 v = acc[ai][bj][m][n];
                        if (u.pn < 4) { u32x2 w; w.x = cvt_pk_bf16(v[0] * QSCALE, v[1] * QSCALE); w.y = cvt_pk_bf16(v[2] * QSCALE, v[3] * QSCALE); *(u32x2*)(Q + (size_t)row * 1024 + col) = w; }
                        else if (col < 1072) { f32x4 o;
#pragma unroll
                            for (int j = 0; j < 4; ++j) o[j] = __builtin_amdgcn_rcpf(1.0f + __builtin_amdgcn_exp2f(v[j] * -1.44269504089f));
                            *(f32x4*)(GATES + (size_t)row * 48 + (col - 1024)) = o; } } }
    }
};

template <class Epi, class Sched, bool ALIGN_EPI = true>
__device__ __forceinline__ void gemm_phase(PG8_LAS unsigned char* lds, const Gemm g, const Sched& S, const Epi& E) {
    int tid = threadIdx.x; asm volatile("" : "+v"(tid));
    const int wid = __builtin_amdgcn_readfirstlane(tid >> 6), lane = tid & 63, wr = wid >> 2, wc = wid & 3, fr = lane & 15, fq = lane >> 4;
    const int K = g.K, nt = K / BK;
    unsigned voffA[2], voffB[2];
#pragma unroll
    for (int i = 0; i < 2; ++i) { int R, C; stage_rc(tid * 16 + i * 8192, R, C); const int Rb = Epi::PERM ? ((R & ~31) + perm32(R & 31)) : R;
        voffA[i] = (unsigned)(R * g.lda + C) * 2u; voffB[i] = (unsigned)(Rb * K + C) * 2u; }
    const size_t kstepB = (size_t)(BK * 2), hstepB = (size_t)HALF * K * 2, tstepB = 2 * hstepB;
    const size_t kstepA = (size_t)g.a_kstep, hstepA = (size_t)g.a_hstep;
    const unsigned ldsw = (unsigned)wid * 1024u;
    const int aoff = lds_byte(wr * 64 + fr, fq * 8), boff = lds_byte(wc * 32 + fr, fq * 8);
#define PG8_ABASE(pm) ((const char*)g.A + (size_t)((pm) / g.a_div) * (size_t)g.a_thi + (size_t)((pm) % g.a_div) * (size_t)g.a_tlo)
#define PG8_SA(b, h) (((b) * 2 + (h)) * HTB)
#define PG8_SB(b, h) ((4 + (b) * 2 + (h)) * HTB)
#define PG8_STAGE(bufoff, gbase, voff) do { _Pragma("unroll") for (int _i = 0; _i < 2; ++_i) \
        __builtin_amdgcn_global_load_lds((const unsigned*)((const char*)(gbase) + (voff)[_i]), (PG8_LAS unsigned*)(lds + (bufoff) + ldsw + _i * 8192), 16, 0, 0); } while (0)
#define PG8_LDA(dst, b, h) do { _Pragma("unroll") for (int m = 0; m < 4; ++m) _Pragma("unroll") for (int k = 0; k < 2; ++k) dst[m][k] = *(const PG8_LAS bf16x8*)(lds + PG8_SA(b, h) + aoff + m * 2048 + k * 1024); } while (0)
#define PG8_LDB(dst, b, h) do { _Pragma("unroll") for (int n = 0; n < 2; ++n) _Pragma("unroll") for (int k = 0; k < 2; ++k) dst[n][k] = *(const PG8_LAS bf16x8*)(lds + PG8_SB(b, h) + boff + n * 2048 + k * 1024); } while (0)
#define PG8_MMA(ai, bj, At, Bt) do { __builtin_amdgcn_s_setprio(1); _Pragma("unroll") for (int m = 0; m < 4; ++m) _Pragma("unroll") for (int n = 0; n < 2; ++n) _Pragma("unroll") for (int k = 0; k < 2; ++k) \
        acc[ai][bj][m][n] = __builtin_amdgcn_mfma_f32_16x16x32_bf16(Bt[n][k], At[m][k], acc[ai][bj][m][n], 0, 0, 0); __builtin_amdgcn_s_setprio(0); } while (0)
#define PG8_WAIT_V(n) asm volatile("s_waitcnt vmcnt(" #n ")" ::: "memory")
#define PG8_WAIT_L(n) asm volatile("s_waitcnt lgkmcnt(" #n ")" ::: "memory")
#define PG8_BAR __builtin_amdgcn_s_barrier()
#define PG8_SCHED __builtin_amdgcn_sched_barrier(0)
    Unit cur, nxt; int ui = 0;
    if (!S.next(0, cur)) return;
    f32x4 acc[2][2][4][2];
#pragma unroll
    for (int a = 0; a < 2; ++a)
#pragma unroll
        for (int b = 0; b < 2; ++b)
#pragma unroll
            for (int m = 0; m < 4; ++m)
#pragma unroll
                for (int n = 0; n < 2; ++n) acc[a][b][m][n] = (f32x4){0.f, 0.f, 0.f, 0.f};
    bf16x8 At[4][2], B0[2][2], B1[2][2];
    const char* cA = PG8_ABASE(cur.pm); const char* cB = (const char*)g.Bt + (size_t)cur.pn * tstepB;
    PG8_STAGE(PG8_SB(0, 0), cB, voffB); PG8_STAGE(PG8_SB(0, 1), cB + hstepB, voffB); PG8_STAGE(PG8_SA(0, 0), cA, voffA); PG8_STAGE(PG8_SA(0, 1), cA + hstepA, voffA);
    if (wr == 1) PG8_BAR;
    PG8_WAIT_V(2); PG8_BAR;
    PG8_STAGE(PG8_SB(1, 0), cB + kstepB, voffB); PG8_STAGE(PG8_SA(1, 0), cA + kstepA, voffA); PG8_STAGE(PG8_SB(1, 1), cB + hstepB + kstepB, voffB);
    PG8_WAIT_V(6); PG8_BAR;
    for (;;) {
        const bool has_next = S.next(ui + 1, nxt);
        const char* nA = has_next ? PG8_ABASE(nxt.pm) : cA; const char* nB = has_next ? (const char*)g.Bt + (size_t)nxt.pn * tstepB : cB;
        for (int t = 0; t < nt; t += 2) {
            const bool last = (t == nt - 2);
            const char* a1 = cA + (size_t)(t + 1) * kstepA;
            const char* a2 = last ? nA : cA + (size_t)(t + 2) * kstepA; const char* b2 = last ? nB : cB + (size_t)(t + 2) * kstepB;
            const char* a3 = a2 + kstepA; const char* b3 = b2 + kstepB;
            PG8_LDB(B0, 0, 0); PG8_LDB(B1, 0, 1); PG8_SCHED; PG8_LDA(At, 0, 0); PG8_STAGE(PG8_SA(1, 1), a1 + hstepA, voffA);
            PG8_WAIT_V(8); PG8_WAIT_L(0); PG8_BAR; PG8_MMA(0, 0, At, B0); PG8_MMA(0, 1, At, B1); PG8_BAR; PG8_SCHED;
            PG8_LDA(At, 0, 1); PG8_STAGE(PG8_SB(0, 0), b2, voffB); PG8_STAGE(PG8_SB(0, 1), b2 + hstepB, voffB); PG8_STAGE(PG8_SA(0, 0), a2, voffA);
            PG8_WAIT_V(8); PG8_WAIT_L(0); PG8_BAR; PG8_MMA(1, 0, At, B0); PG8_MMA(1, 1, At, B1); PG8_BAR; PG8_SCHED;
            PG8_LDB(B0, 1, 0); PG8_LDB(B1, 1, 1); PG8_SCHED; PG8_LDA(At, 1, 0); PG8_STAGE(PG8_SA(0, 1), a2 + hstepA, voffA);
            PG8_WAIT_V(8); PG8_WAIT_L(0); PG8_BAR; PG8_MMA(0, 0, At, B0); PG8_MMA(0, 1, At, B1); PG8_BAR; PG8_SCHED;
            PG8_LDA(At, 1, 1); PG8_STAGE(PG8_SB(1, 0), b3, voffB); PG8_STAGE(PG8_SB(1, 1), b3 + hstepB, voffB); PG8_STAGE(PG8_SA(1, 0), a3, voffA);
            PG8_WAIT_V(8); PG8_WAIT_L(0); PG8_BAR; PG8_MMA(1, 0, At, B0); PG8_MMA(1, 1, At, B1); PG8_BAR; PG8_SCHED;
        }
        if constexpr (ALIGN_EPI) { if (wr == 0) PG8_BAR; }
        E(acc, cur, wr, wc, fr, fq);
        if (!has_next) break;
#pragma unroll
        for (int a = 0; a < 2; ++a)
#pragma unroll
            for (int b = 0; b < 2; ++b)
#pragma unroll
                for (int m = 0; m < 4; ++m)
#pragma unroll
                    for (int n = 0; n < 2; ++n) acc[a][b][m][n] = (f32x4){0.f, 0.f, 0.f, 0.f};
        cur = nxt; cA = nA; cB = nB; ++ui;
        if constexpr (ALIGN_EPI) { if (wr == 1) PG8_BAR; }
    }
    PG8_WAIT_V(0);
    if constexpr (!ALIGN_EPI) { if (wr == 0) PG8_BAR; }
    PG8_BAR;
#undef PG8_ABASE
#undef PG8_SA
#undef PG8_SB
#undef PG8_STAGE
#undef PG8_LDA
#undef PG8_LDB
#undef PG8_MMA
#undef PG8_WAIT_V
#undef PG8_WAIT_L
#undef PG8_BAR
#undef PG8_SCHED
}
}

#define LAS __attribute__((address_space(3)))
typedef unsigned short bf16;
typedef unsigned v4u __attribute__((ext_vector_type(4)));
typedef unsigned v2u __attribute__((ext_vector_type(2)));
typedef float f32x4 __attribute__((ext_vector_type(4)));
typedef float f32x2 __attribute__((ext_vector_type(2)));
constexpr int NWAVES = 8, NTHR = 512;
constexpr int BATCH = 32, SEQ = 2048, D = 1024, T = BATCH * SEQ, FFN = 2816, NUP = 2 * FFN, SGUH = 4096, SGUHALF = 2048;
constexpr int NKV = 1536, NQG = 1072, NQGP = 1280, NCMPROWS = 16384;
constexpr float ALPHA = 1.681792830507429f, LN_EPS = 1e-5f, NEGF = -1e30f;
constexpr size_t MiB = 1u << 20;
constexpr size_t WS_WUP0 = 1 * MiB, WS_WUP1 = 12 * MiB, WS_WDN0 = 23 * MiB, WS_WDN1 = 29 * MiB, WS_WMIX = 35 * MiB, WS_WMIX2 = 43 * MiB;
constexpr size_t WS_WKV = 47 * MiB, WS_WC1 = 50 * MiB, WS_WC2 = 52 * MiB, WS_BIAS2 = 53 * MiB, WS_STATS = 54 * MiB, WS_VSTAT = 56 * MiB;
constexpr size_t WS_HB = 72 * MiB, WS_SCR = 200 * MiB;
constexpr size_t WS_U = WS_SCR, WS_UG = WS_SCR, WS_VT = WS_SCR + 256 * MiB, WS_Q = WS_SCR, WS_O = WS_SCR + 128 * MiB, WS_GATES = WS_SCR + 256 * MiB;
constexpr size_t WS_KV = 712 * MiB, WS_KC = 904 * MiB, WS_VC = 906 * MiB, WS_HID = 908 * MiB, WS_VTS = 924 * MiB  , WS_END = 1000 * MiB;
constexpr int LDS_BYTES = 147456;

__device__ __forceinline__ unsigned f2bf(float f) { unsigned u = __builtin_bit_cast(unsigned, f); return (u + 0x7fffu + ((u >> 16) & 1u)) >> 16; }
__device__ __forceinline__ unsigned pk2(float lo, float hi) { return f2bf(lo) | (f2bf(hi) << 16); }
__device__ __forceinline__ float bflo(unsigned w) { return __uint_as_float(w << 16); }
__device__ __forceinline__ float bfhi(unsigned w) { return __uint_as_float(w & 0xffff0000u); }
__device__ __forceinline__ float wave_sum(float v) {
#pragma unroll
    for (int o = 1; o < 64; o <<= 1) v += __shfl_xor(v, o);
    return v;
}
#define LDS_WAIT() asm volatile("s_waitcnt lgkmcnt(0)" ::: "memory")

__device__ __forceinline__ int rowmap(int n, int mode) { return mode == 0 ? n : (32 * (n >> 4) + (n & 15) + (mode == 2 ? 16 : 0)); }
__device__ __forceinline__ void transpose_item(const float* W, int K, int N, bf16* WT, int mode, LAS float* scr, int item, int lane) {
    const int nblk = (N + 31) / 32, kb = item / nblk, nb = item % nblk, k0 = 64 * kb, n0 = 32 * nb;
    const bool nok = (n0 + (lane & 31)) < N;
#pragma unroll 8
    for (int i = 0; i < 32; ++i) { const int kk = 2 * i + (lane >> 5); scr[kk * 33 + (lane & 31)] = nok ? W[(size_t)(k0 + kk) * N + n0 + (lane & 31)] : 0.f; }
    LDS_WAIT(); asm volatile("" ::: "memory");
    const int c = lane & 7;
#pragma unroll
    for (int j = 0; j < 4; ++j) { const int n = (lane >> 3) + 8 * j; const LAS float* s = scr + (8 * c) * 33 + n;
        v4u o; o.x = pk2(s[0 * 33], s[1 * 33]); o.y = pk2(s[2 * 33], s[3 * 33]); o.z = pk2(s[4 * 33], s[5 * 33]); o.w = pk2(s[6 * 33], s[7 * 33]);
        if (n0 + n < N) *(v4u*)(WT + (size_t)rowmap(n0 + n, mode) * K + k0 + 8 * c) = o; }
    LDS_WAIT(); asm volatile("" ::: "memory");
}
struct Args { const float* in[20]; float* out; unsigned char* ws; int ph_lo, ph_hi; };

__device__ __forceinline__ void get_mat(const Args& a, unsigned char* ws, int cs, int mi, const float*& W, int& K, int& N, bf16*& WT, int& mode) {
    mode = 0;
    if (cs < 4) {
        if (mi < 6) { const int s = mi / 3, k = mi % 3; const size_t wi = (size_t)(cs * 2 + s);
            if (k < 2) { W = a.in[4 + k] + wi * D * FFN; K = D; N = FFN; WT = (bf16*)(ws + (s ? WS_WUP1 : WS_WUP0)); mode = 1 + k; }
            else { W = a.in[6] + wi * FFN * D; K = FFN; N = D; WT = (bf16*)(ws + (s ? WS_WDN1 : WS_WDN0)); } }
        else if (cs < 2) { if (mi == 6) { W = a.in[7] + (size_t)cs * D * SGUH; K = D; N = SGUH; WT = (bf16*)(ws + WS_WMIX); } else { W = a.in[12] + (size_t)cs * SGUHALF * D; K = SGUHALF; N = D; WT = (bf16*)(ws + WS_WMIX2); } }
        else { if (mi == 6) { W = a.in[18] + (size_t)(cs - 2) * D * NQG; K = D; N = NQG; WT = (bf16*)(ws + WS_WMIX); } else { W = a.in[19] + (size_t)(cs - 2) * D * D; K = D; N = D; WT = (bf16*)(ws + WS_WMIX2); } }
    } else {
        if (mi == 0) { W = a.in[13]; K = D; N = NKV; WT = (bf16*)(ws + WS_WKV); }
        else if (mi < 3) { const int s = mi - 1; W = a.in[15] + (size_t)s * 2048 * 256; K = 2048; N = 256; WT = (bf16*)(ws + WS_WC1) + (size_t)s * 256 * 2048; }
        else { const int s = mi - 3; W = a.in[17] + (size_t)s * 256 * 64; K = 256; N = 64; WT = (bf16*)(ws + WS_WC2) + (size_t)s * 256 * 256; }
    }
}
__device__ __forceinline__ void convert_set(const Args& a, unsigned char* ws, int cs, LAS float* scr, int gw, int NGW, int lane) {
    const int nmat = cs < 4 ? 8 : 5;
    for (int mi = 0; mi < nmat; ++mi) { const float* W; int K, N, mode; bf16* WT; get_mat(a, ws, cs, mi, W, K, N, WT, mode);
        const int nitems = (K / 64) * ((N + 31) / 32);
        for (int it = gw; it < nitems; it += NGW) transpose_item(W, K, N, WT, mode, scr, it, lane); }
}

__device__ __forceinline__ void ln_row(const float* yrow, const float* g, const float* b, bf16* hb, float* stats, float* fout, int lane) {
    const f32x4* xr = (const f32x4*)yrow + lane;
    f32x4 v[4]; float s = 0.f;
#pragma unroll
    for (int j = 0; j < 4; ++j) { v[j] = xr[64 * j]; s += (v[j].x + v[j].y) + (v[j].z + v[j].w); }
    const float mean = wave_sum(s) * (1.f / D); float s2 = 0.f;
#pragma unroll
    for (int j = 0; j < 4; ++j) { const f32x4 d = v[j] - mean; s2 += (d.x * d.x + d.y * d.y) + (d.z * d.z + d.w * d.w); }
    const float rstd = 1.f / sqrtf(wave_sum(s2) * (1.f / D) + LN_EPS);
#pragma unroll
    for (int j = 0; j < 4; ++j) { const f32x4 gv = *((const f32x4*)g + lane + 64 * j), bv = *((const f32x4*)b + lane + 64 * j);
        const f32x4 o = (v[j] - mean) * rstd * gv + bv;
        if (fout) *((f32x4*)fout + lane + 64 * j) = o;
        else { v2u w; w.x = pg8::cvt_pk_bf16(o.x, o.y); w.y = pg8::cvt_pk_bf16(o.z, o.w); *((v2u*)hb + lane + 64 * j) = w; } }
    if (stats && lane == 0) { stats[0] = mean; stats[1] = rstd; }
}

typedef float f32x16 __attribute__((ext_vector_type(16)));
typedef short s16x8 __attribute__((ext_vector_type(8)));
typedef short s16x4 __attribute__((ext_vector_type(4)));
typedef __bf16 bf16x2_t __attribute__((ext_vector_type(2)));
#define MFMA32(a, b, c) __builtin_amdgcn_mfma_f32_32x32x16_bf16((a), (b), (c), 0, 0, 0)
__device__ __forceinline__ unsigned pkbf(float lo, float hi) { return __builtin_bit_cast(unsigned, __builtin_convertvector((f32x2){lo, hi}, bf16x2_t)); }
constexpr int SP_LD = 136;
__device__ __forceinline__ void spatial_phase(const Args& a, unsigned char* ws, int layer, LAS unsigned char* lds, int G, int bx) {
    int tid = threadIdx.x; asm volatile("" : "+v"(tid));
    LAS bf16* Ws = (LAS bf16*)lds;
    LAS bf16* Vs = (LAS bf16*)(lds + 128 * SP_LD * 2);
    LAS float* MU = (LAS float*)(lds + (128 + 256) * SP_LD * 2);
    const float* w_s = a.in[10] + (size_t)layer * 8 * 128 * 128; const float* b_s = a.in[11] + (size_t)layer * 8 * 128;
    const float* lng = a.in[8] + (size_t)layer * SGUHALF; const float* lnb = a.in[9] + (size_t)layer * SGUHALF;
    bf16* UG = (bf16*)(ws + WS_UG); const bf16* VT = (const bf16*)(ws + WS_VT); const float* VSTAT = (const float*)(ws + WS_VSTAT);
    int gl = -1;
    for (int u = bx; u < 512 * 8; u += G) {
        const int g = u & 7, bn = u >> 3;
        __syncthreads();
        if (g != gl) { gl = g;
            for (int i = tid; i < 128 * 32; i += NTHR) { const int t = i >> 5, s4 = (i & 31) * 4; f32x4 w = *(const f32x4*)(w_s + ((size_t)g * 128 + t) * 128 + s4);
                if (s4 + 0 > t) w.x = 0.f; if (s4 + 1 > t) w.y = 0.f; if (s4 + 2 > t) w.z = 0.f; if (s4 + 3 > t) w.w = 0.f;
                v2u o; o.x = pk2(w.x, w.y); o.y = pk2(w.z, w.w); *(LAS v2u*)(Ws + t * SP_LD + s4) = o; } }
        if (tid < 128) { const float* p = VSTAT + ((size_t)(bn * 128 + tid) * 32) * 2; float s = 0.f, q = 0.f;
#pragma unroll
            for (int j = 0; j < 16; ++j) { const f32x4 v = *(const f32x4*)(p + 4 * j); s += v.x + v.z; q += v.y + v.w; }
            const float mean = s * (1.f / 2048.f); const float var = q * (1.f / 2048.f) - mean * mean;
            MU[tid] = mean; MU[128 + tid] = 1.f / sqrtf(fmaxf(var, 0.f) + LN_EPS); }
        __syncthreads();
        for (int i = tid; i < 256 * 16; i += NTHR) { const int c = i >> 4, s8 = (i & 15) * 8; const int cg = g * 256 + c;
            const v4u raw = *(const v4u*)(VT + ((size_t)bn * 2048 + cg) * 128 + s8); const float gg = lng[cg], bb = lnb[cg];
            const unsigned rw[4] = {raw.x, raw.y, raw.z, raw.w}; unsigned ow[4];
#pragma unroll
            for (int j = 0; j < 4; ++j) { const int s = s8 + 2 * j; const float x0 = (bflo(rw[j]) - MU[s]) * MU[128 + s] * gg + bb, x1 = (bfhi(rw[j]) - MU[s + 1]) * MU[128 + s + 1] * gg + bb; ow[j] = pk2(x0, x1); }
            *(LAS v4u*)(Vs + c * SP_LD + s8) = (v4u){ow[0], ow[1], ow[2], ow[3]}; }
        __syncthreads();
        {
            const int lane = tid & 63, w = __builtin_amdgcn_readfirstlane(tid >> 6), r = lane & 31, h = lane >> 5, wr = w >> 2, wc = w & 3;
            f32x16 acc[2][2];
#pragma unroll
            for (int ti = 0; ti < 2; ++ti)
#pragma unroll
                for (int ci = 0; ci < 2; ++ci)
#pragma unroll
                    for (int i = 0; i < 16; ++i) acc[ti][ci][i] = 0.f;
#pragma unroll
            for (int ks = 0; ks < 8; ++ks) {
                if (16 * ks <= 64 * wr + 63) {
                    const s16x8 a0 = *(const LAS s16x8*)(Vs + (64 * wc + r) * SP_LD + 16 * ks + 8 * h), a1 = *(const LAS s16x8*)(Vs + (64 * wc + 32 + r) * SP_LD + 16 * ks + 8 * h);
                    const s16x8 b0 = *(const LAS s16x8*)(Ws + (64 * wr + r) * SP_LD + 16 * ks + 8 * h), b1 = *(const LAS s16x8*)(Ws + (64 * wr + 32 + r) * SP_LD + 16 * ks + 8 * h);
                    if (16 * ks <= 64 * wr + 31) { acc[0][0] = MFMA32(a0, b0, acc[0][0]); acc[0][1] = MFMA32(a1, b0, acc[0][1]); }
                    acc[1][0] = MFMA32(a0, b1, acc[1][0]); acc[1][1] = MFMA32(a1, b1, acc[1][1]);
                }
            }
#pragma unroll
            for (int ti = 0; ti < 2; ++ti) { const int t = 64 * wr + 32 * ti + r; const float bst = b_s[g * 128 + t];
#pragma unroll
                for (int ci = 0; ci < 2; ++ci)
#pragma unroll
                    for (int gq = 0; gq < 4; ++gq) { const size_t off = (size_t)(bn * 128 + t) * 2048 + g * 256 + 64 * wc + 32 * ci + 8 * gq + 4 * h;
                        const v2u uu = *(const v2u*)(UG + off); v2u o;
                        o.x = pkbf(bflo(uu.x) * (acc[ti][ci][4 * gq] + bst), bfhi(uu.x) * (acc[ti][ci][4 * gq + 1] + bst));
                        o.y = pkbf(bflo(uu.y) * (acc[ti][ci][4 * gq + 2] + bst), bfhi(uu.y) * (acc[ti][ci][4 * gq + 3] + bst));
                        *(v2u*)(UG + off) = o; } }
        }
    }
    __syncthreads();
}

__device__ __forceinline__ int rel_bucket(int n) {
    if (n < 16) return n;
    const int large = 16 + (int)(logf((float)n / 16.0f) / 2.0794415416798357f * 16.0f);
    return large < 31 ? large : 31;
}
__device__ __forceinline__ s16x8 pack8(const f32x16& x, int s) {
    v4u p; p.x = pkbf(x[8 * s + 0], x[8 * s + 1]); p.y = pkbf(x[8 * s + 2], x[8 * s + 3]); p.z = pkbf(x[8 * s + 4], x[8 * s + 5]); p.w = pkbf(x[8 * s + 6], x[8 * s + 7]);
    return __builtin_bit_cast(s16x8, p);
}
constexpr int AT_KLD = 72, AT_CLD = 136;
constexpr int AT_BUF = 2 * 64 * AT_KLD * 2;
constexpr int AT_BLUT = 2 * AT_BUF, AT_IMP = AT_BLUT + 2048, AT_SELM = AT_IMP + 8192;

template <bool GEN>
__device__ __forceinline__ void attn_tile(const LAS bf16* Kt, const LAS bf16* Vt, const s16x8 (&qf)[4], f32x16 (&O)[2], float& m_run, float& l_run,
                                          int r, int h, int dl, unsigned wlim, bool ok, float cb, const LAS float* blut) {
    f32x16 S0, S1;
#pragma unroll
    for (int i = 0; i < 16; ++i) { S0[i] = 0.f; S1[i] = 0.f; }
#pragma unroll
    for (int kk = 0; kk < 4; ++kk) {
        const s16x8 a0 = *(const LAS s16x8*)(Kt + r * AT_KLD + 16 * kk + 8 * h), a1 = *(const LAS s16x8*)(Kt + (32 + r) * AT_KLD + 16 * kk + 8 * h);
        S0 = MFMA32(a0, qf[kk], S0); S1 = MFMA32(a1, qf[kk], S1);
    }
    float mx = NEGF;
#pragma unroll
    for (int i = 0; i < 16; ++i) {
        const int off = (i & 3) + 8 * (i >> 2);
        if (GEN) {
            const int d0 = dl - off, d1 = dl - off - 32;
            const bool v0 = ok && ((unsigned)d0 < wlim), v1 = ok && ((unsigned)d1 < wlim);
            const float b0 = blut[min((unsigned)d0, 127u)], b1 = blut[min((unsigned)d1, 127u)];
            S0[i] = v0 ? S0[i] + b0 : NEGF; S1[i] = v1 ? S1[i] + b1 : NEGF;
        } else { S0[i] = ok ? S0[i] + cb : NEGF; S1[i] = ok ? S1[i] + cb : NEGF; }
        mx = fmaxf(mx, fmaxf(S0[i], S1[i]));
    }
    mx = fmaxf(mx, __shfl_xor(mx, 32));
    const float m_new = fmaxf(m_run, mx), m_eff = fmaxf(m_new, -1e29f);
    const float corr = __builtin_amdgcn_exp2f(m_run - m_eff);
    float ps = 0.f;
#pragma unroll
    for (int i = 0; i < 16; ++i) { S0[i] = __builtin_amdgcn_exp2f(S0[i] - m_eff); S1[i] = __builtin_amdgcn_exp2f(S1[i] - m_eff); ps += S0[i] + S1[i]; }
    ps += __shfl_xor(ps, 32);
    l_run = l_run * corr + ps; m_run = m_new;
#pragma unroll
    for (int i = 0; i < 16; ++i) { O[0][i] *= corr; O[1][i] *= corr; }
#pragma unroll
    for (int blk = 0; blk < 2; ++blk)
#pragma unroll
        for (int st = 0; st < 2; ++st) {
            const s16x8 pb = pack8(blk ? S1 : S0, st);
#pragma unroll
            for (int dt = 0; dt < 2; ++dt) {
                const LAS bf16* vp = Vt + (32 * dt + r) * AT_KLD + 32 * blk + 16 * st + 4 * h;
                const s16x4 lo = *(const LAS s16x4*)vp, hi = *(const LAS s16x4*)(vp + 8);
                O[dt] = MFMA32(__builtin_shufflevector(lo, hi, 0, 1, 2, 3, 4, 5, 6, 7), pb, O[dt]);
            }
        }
}

__device__ __forceinline__ void attn_mfma_phase(const Args& a, unsigned char* ws, LAS unsigned char* lds, int G, int bx) {
    int tid = threadIdx.x; asm volatile("" : "+v"(tid));
    const int lane = tid & 63, w = __builtin_amdgcn_readfirstlane(tid >> 6), r = lane & 31, h = lane >> 5, hd = r >> 3, ql = r & 7;
    LAS float* BLUT = (LAS float*)(lds + AT_BLUT); LAS float* IMP = (LAS float*)(lds + AT_IMP); LAS unsigned* SELM = (LAS unsigned*)(lds + AT_SELM);
    const bf16* Q = (const bf16*)(ws + WS_Q); bf16* Og = (bf16*)(ws + WS_O); const float* GATES = (const float*)(ws + WS_GATES);
    const bf16* KV = (const bf16*)(ws + WS_KV); const bf16* KC = (const bf16*)(ws + WS_KC); const bf16* VCT = (const bf16*)(ws + WS_VC); const bf16* VTS = (const bf16*)(ws + WS_VTS);
    const float* rel = a.in[1];
    const LAS float* blut = BLUT + hd * 128;
    const int srow = tid >> 3, sch = tid & 7;
    for (int item = bx; item < BATCH * 4 * 32; item += G) {
        const int qb = item & 31, g = (item >> 5) & 3, b = item >> 7;
        const int q0 = qb * 64, tq = q0 + 8 * w + ql, head = g * 4 + hd;
        const size_t row = (size_t)b * SEQ + tq;
        const int bg = b * 4 + g;
        __syncthreads();
#pragma unroll
        for (int j = 0; j < 2; ++j) { const int i = tid + 512 * j;
            { const int rr = i >> 3, ch = i & 7; *(LAS v4u*)((LAS bf16*)lds + rr * AT_KLD + ch * 8) = *(const v4u*)(KC + ((size_t)bg * 128 + rr) * 64 + ch * 8); }
            { const int rr = i >> 4, ch = i & 15; *(LAS v4u*)((LAS bf16*)(lds + AT_BUF) + rr * AT_CLD + ch * 8) = *(const v4u*)(VCT + ((size_t)bg * 64 + rr) * 128 + ch * 8); } }
        { const int hh = tid >> 7, dd = tid & 127; BLUT[hh * 128 + dd] = rel[rel_bucket(dd) * 16 + g * 4 + hh] * 1.4426950408889634f; }
        s16x8 qf[4];
#pragma unroll
        for (int kk = 0; kk < 4; ++kk) qf[kk] = *(const s16x8*)(Q + row * 1024 + head * 64 + 16 * kk + 8 * h);
        const float g0 = GATES[row * 48 + head * 3 + 0], g1 = GATES[row * 48 + head * 3 + 1], g2 = GATES[row * 48 + head * 3 + 2];
        f32x16 Ot[2], O[2];
        __syncthreads();
        {
            const LAS bf16* Kc = (const LAS bf16*)lds; const LAS bf16* Vc = (const LAS bf16*)(lds + AT_BUF);
            f32x16 S[4];
#pragma unroll
            for (int kb = 0; kb < 4; ++kb) {
#pragma unroll
                for (int i = 0; i < 16; ++i) S[kb][i] = 0.f;
#pragma unroll
                for (int kk = 0; kk < 4; ++kk) S[kb] = MFMA32(*(const LAS s16x8*)(Kc + (32 * kb + r) * AT_KLD + 16 * kk + 8 * h), qf[kk], S[kb]);
            }
            float mx = NEGF;
#pragma unroll
            for (int kb = 0; kb < 4; ++kb)
#pragma unroll
                for (int i = 0; i < 16; ++i) { const int ic = 32 * kb + (i & 3) + 8 * (i >> 2) + 4 * h; const int dist = tq - (16 * ic + 31);
                    const float bb = blut[min((unsigned)dist, 127u)]; S[kb][i] = dist >= 0 ? S[kb][i] + bb : NEGF; mx = fmaxf(mx, S[kb][i]); }
            mx = fmaxf(mx, __shfl_xor(mx, 32));
            const float m_eff = fmaxf(mx, -1e29f); float ps = 0.f;
#pragma unroll
            for (int kb = 0; kb < 4; ++kb)
#pragma unroll
                for (int i = 0; i < 16; ++i) { S[kb][i] = __builtin_amdgcn_exp2f(S[kb][i] - m_eff); ps += S[kb][i]; }
            ps += __shfl_xor(ps, 32);
            const float linv = ps > 0.f ? 1.f / ps : 0.f;
#pragma unroll
            for (int kb = 0; kb < 4; ++kb)
#pragma unroll
                for (int i = 0; i < 16; ++i) S[kb][i] *= linv;
            float Lprev = 0.f;
#pragma unroll
            for (int kk = 0; kk < 16; ++kk) { const int kb = kk >> 2, gq = kk & 3;
                const float Gs = (S[kb][4 * gq] + S[kb][4 * gq + 1]) + (S[kb][4 * gq + 2] + S[kb][4 * gq + 3]);
                const float Lo = __shfl_xor(S[kb][4 * gq + 3], 32);
                float v = Gs + (h ? Lo : Lprev); Lprev = Lo;
                v += __shfl_xor(v, 8); v += __shfl_xor(v, 16);
                if (hd == 0) IMP[(8 * w + ql) * 32 + 2 * kk + h] = v; }
#pragma unroll
            for (int i = 0; i < 16; ++i) { O[0][i] = 0.f; O[1][i] = 0.f; }
#pragma unroll
            for (int kb = 0; kb < 4; ++kb)
#pragma unroll
                for (int st = 0; st < 2; ++st) { const s16x8 pb = pack8(S[kb], st);
#pragma unroll
                    for (int dt = 0; dt < 2; ++dt) { const LAS bf16* vp = Vc + (32 * dt + r) * AT_CLD + 32 * kb + 16 * st + 4 * h;
                        const s16x4 lo = *(const LAS s16x4*)vp, hi = *(const LAS s16x4*)(vp + 8);
                        O[dt] = MFMA32(__builtin_shufflevector(lo, hi, 0, 1, 2, 3, 4, 5, 6, 7), pb, O[dt]); } }
#pragma unroll
            for (int i = 0; i < 16; ++i) { Ot[0][i] = g0 * O[0][i]; Ot[1][i] = g0 * O[1][i]; }
        }
        __syncthreads();
        { const int q = tid >> 3, cur = (q0 + q) >> 6; unsigned mbits = 0u;
          for (int jj = 0; jj < 4; ++jj) { const int j = (tid & 7) * 4 + jj;
              const bool vj = j <= cur, fj = vj && (j == 0 || j > cur - 2); const float valj = fj ? 1e30f : (vj ? IMP[q * 32 + j] : -1e30f);
              int rank = 0;
              for (int k = 0; k < 32; ++k) { const bool vk = k <= cur, fk = vk && (k == 0 || k > cur - 2); const float valk = fk ? 1e30f : (vk ? IMP[q * 32 + k] : -1e30f);
                  rank += (valk > valj || (valk == valj && k < j)) ? 1 : 0; }
              if (rank < 8) mbits |= 1u << j; }
          mbits |= __shfl_xor(mbits, 1); mbits |= __shfl_xor(mbits, 2); mbits |= __shfl_xor(mbits, 4);
          if ((tid & 7) == 0) SELM[q] = mbits; }
        const int nsel = qb + 1, pw0 = q0 >= 512 ? q0 - 512 : 0, nwin = ((q0 - pw0) >> 6) + 1, ntile = nsel + nwin;
        const bf16* Ks = KV + (size_t)b * SEQ * NKV + 2 * 256 + g * 64; const bf16* Kw = KV + (size_t)b * SEQ * NKV + 4 * 256 + g * 64;
        const bf16* Vs = VTS + (size_t)bg * 64 * 2048; const bf16* Vw = VTS + (size_t)65536 * 256 + (size_t)bg * 64 * 2048;
        v4u kreg, vreg;
#define AT_LOAD(k) do { const bool sl = (k) < nsel; const int pb_ = sl ? 64 * (k) : pw0 + 64 * ((k) - nsel); \
            kreg = *(const v4u*)((sl ? Ks : Kw) + (size_t)(pb_ + srow) * NKV + sch * 8); vreg = *(const v4u*)((sl ? Vs : Vw) + (size_t)srow * 2048 + pb_ + sch * 8); } while (0)
#define AT_STORE(bufi) do { *(LAS v4u*)((LAS bf16*)(lds + (bufi) * AT_BUF) + srow * AT_KLD + sch * 8) = kreg; *(LAS v4u*)((LAS bf16*)(lds + (bufi) * AT_BUF + 64 * AT_KLD * 2) + srow * AT_KLD + sch * 8) = vreg; } while (0)
        AT_LOAD(0); AT_STORE(0);
        __syncthreads();
        const unsigned selm = SELM[8 * w + ql];
        float m_run = NEGF, l_run = 0.f;
#pragma unroll
        for (int i = 0; i < 16; ++i) { O[0][i] = 0.f; O[1][i] = 0.f; }
        const int tmin = q0 + 8 * w, tmax = tmin + 7;
        const float cbfar = blut[127];
        for (int k = 0; k < ntile; ++k) {
            if (k + 1 < ntile) AT_LOAD(k + 1);
            const bool sl = k < nsel; const int pbase = sl ? 64 * k : pw0 + 64 * (k - nsel);
            const LAS bf16* Kt = (const LAS bf16*)(lds + (k & 1) * AT_BUF); const LAS bf16* Vt = (const LAS bf16*)(lds + (k & 1) * AT_BUF + 64 * AT_KLD * 2);
            const bool ok = sl ? ((selm >> k) & 1u) != 0u : true;
            const bool fast = (tmin - (pbase + 63) >= 127) && (sl || (tmax - pbase < 512));
            if (fast) attn_tile<false>(Kt, Vt, qf, O, m_run, l_run, r, h, 0, 0u, ok, cbfar, blut);
            else attn_tile<true>(Kt, Vt, qf, O, m_run, l_run, r, h, tq - pbase - 4 * h, sl ? 0x7fffffffu : 512u, ok, 0.f, blut);
            if (k + 1 < ntile) AT_STORE((k + 1) & 1);
            __syncthreads();
            if (k == nsel - 1 || k == ntile - 1) {
                const float sc = l_run > 0.f ? (sl ? g1 : g2) / l_run : 0.f;
#pragma unroll
                for (int i = 0; i < 16; ++i) { Ot[0][i] += sc * O[0][i]; Ot[1][i] += sc * O[1][i]; O[0][i] = 0.f; O[1][i] = 0.f; }
                m_run = NEGF; l_run = 0.f;
            }
        }
#undef AT_LOAD
#undef AT_STORE
#pragma unroll
        for (int dt = 0; dt < 2; ++dt)
#pragma unroll
            for (int gq = 0; gq < 4; ++gq) { v2u wv; wv.x = pkbf(Ot[dt][4 * gq], Ot[dt][4 * gq + 1]); wv.y = pkbf(Ot[dt][4 * gq + 2], Ot[dt][4 * gq + 3]);
                *(v2u*)(Og + row * 1024 + head * 64 + 32 * dt + 8 * gq + 4 * h) = wv; }
    }
    __syncthreads();
}

enum { PT_PREP = 0, PT_UP, PT_DOWN, PT_LN, PT_SGUIN, PT_SPATIAL, PT_SGUOUT, PT_KV, PT_CMP1, PT_CMP2, PT_QG, PT_ATTN, PT_WO };
constexpr int N_PHASES = 44;
__device__ __forceinline__ void decode_phase(int ph, int& type, int& layer, int& sub) {
    if (ph == 0) { type = PT_PREP; layer = 0; sub = 0; return; }
    int p;
    if (ph <= 10) { layer = 0; p = ph - 1; }
    else if (ph <= 20) { layer = 1; p = ph - 11; }
    else if (ph <= 33) { layer = 2; p = ph - 21; if (p < 3) { type = PT_KV + p; sub = 0; return; } p -= 3; }
    else { layer = 3; p = ph - 34; }
    const bool A = layer < 2;
    switch (p) {
        case 0: type = PT_UP; sub = 0; break;
        case 1: type = PT_DOWN; sub = 0; break;
        case 2: type = PT_LN; sub = 0; break;
        case 3: type = A ? PT_SGUIN : PT_QG; sub = 0; break;
        case 4: type = A ? PT_SPATIAL : PT_ATTN; sub = 0; break;
        case 5: type = A ? PT_SGUOUT : PT_WO; sub = 0; break;
        case 6: type = PT_LN; sub = 1; break;
        case 7: type = PT_UP; sub = 1; break;
        case 8: type = PT_DOWN; sub = 1; break;
        default: type = PT_LN; sub = 2; break;
    }
}

__global__ void __launch_bounds__(NTHR, 2) mega_fwd(Args kargs) {
    extern __shared__ __attribute__((aligned(16))) unsigned char lds_raw[];
    LAS unsigned char* lds = (LAS unsigned char*)lds_raw;
    const int tid = threadIdx.x, wave = __builtin_amdgcn_readfirstlane(tid >> 6);
    int G = gridDim.x, bx = blockIdx.x;
    unsigned char* ws = kargs.ws; float* Y = kargs.out; const int ph_lo = kargs.ph_lo, ph_hi = kargs.ph_hi;
    LAS float* scr = (LAS float*)(lds + wave * 16384);
    using namespace pg8;

    for (int ph = ph_lo; ph < ph_hi; ++ph) {
        int type, layer, sub; decode_phase(ph, type, layer, sub);
        int cs0 = -1, cs1 = -1;
        const Args* ap = (const Args*)__builtin_amdgcn_kernarg_segment_ptr(); asm volatile("" : "+s"(ap));
        const Args& args = *ap;
        int lane = threadIdx.x & 63; asm volatile("" : "+v"(lane));
        asm volatile("" : "+s"(ws), "+s"(G), "+s"(bx), "+s"(Y));
        bf16* HB = (bf16*)(ws + WS_HB); float* STATS = (float*)(ws + WS_STATS);
        const int gw = bx * NWAVES + wave, NGW = G * NWAVES;
        switch (type) {
        case PT_PREP: {
            cs0 = 4; cs1 = 0;
            if (gw < 512) { const int s = gw >> 8, j = gw & 255; const float* pe = args.in[14] + (size_t)s * 2048; const float* w1 = args.in[15] + (size_t)s * 2048 * 256; float acc = 0.f;
                for (int k = lane; k < 2048; k += 64) acc += pe[k] * w1[(size_t)k * 256 + j];
                acc = wave_sum(acc); if (lane == 0) ((float*)(ws + WS_BIAS2))[gw] = acc + args.in[16][gw]; }
            const float* x = args.in[0];
            for (size_t i = (size_t)bx * NTHR + tid; i < (size_t)T * D / 8; i += (size_t)G * NTHR) { const f32x4 a0 = *((const f32x4*)x + 2 * i), a1 = *((const f32x4*)x + 2 * i + 1);
                *((v4u*)HB + i) = (v4u){cvt_pk_bf16(a0.x, a0.y), cvt_pk_bf16(a0.z, a0.w), cvt_pk_bf16(a1.x, a1.y), cvt_pk_bf16(a1.z, a1.w)}; }
        } break;
        case PT_UP: {
            Gemm g = make_gemm(HB, (const bf16*)(ws + (sub ? WS_WUP1 : WS_WUP0)), T, NUP, D); StaticOrder S; S.init(T, NUP, G, bx);
            EpiSwiGLU E{(bf16*)(ws + WS_U), FFN};
            gemm_phase<EpiSwiGLU, StaticOrder>(lds, g, S, E);
        } break;
        case PT_DOWN: {
            Gemm g = make_gemm((const bf16*)(ws + WS_U), (const bf16*)(ws + (sub ? WS_WDN1 : WS_WDN0)), T, D, FFN); StaticOrder S; S.init(T, D, G, bx);
            const bool first = (layer == 0 && sub == 0);
            const int pl = sub ? layer : layer - 1, pi = sub ? 1 : 2;
            EpiResid E{first ? args.in[0] : Y, Y, first ? nullptr : STATS, first ? nullptr : args.in[2] + (size_t)(pl * 3 + pi) * D, first ? nullptr : args.in[3] + (size_t)(pl * 3 + pi) * D, ALPHA, 0.5f};
            gemm_phase<EpiResid, StaticOrder>(lds, g, S, E);
        } break;
        case PT_LN: {
            const bool fin = (layer == 3 && sub == 2);
            const float* gg = args.in[2] + (size_t)(layer * 3 + sub) * D; const float* bb = args.in[3] + (size_t)(layer * 3 + sub) * D;
            for (int r = gw; r < T; r += NGW) ln_row(Y + (size_t)r * D, gg, bb, HB + (size_t)r * D, fin ? nullptr : STATS + 2 * (size_t)r, fin ? Y + (size_t)r * D : nullptr, lane);
            if (sub == 2 && layer < 3) cs0 = layer + 1;
        } break;
        case PT_SGUIN: {
            Gemm g = make_gemm(HB, (const bf16*)(ws + WS_WMIX), T, SGUH, D); StaticOrder S; S.init(T, SGUH, G, bx);
            EpiSguIn E{(bf16*)(ws + WS_UG), (bf16*)(ws + WS_VT), (float*)(ws + WS_VSTAT)};
            gemm_phase<EpiSguIn, StaticOrder>(lds, g, S, E);
        } break;
        case PT_SPATIAL: spatial_phase(args, ws, layer, lds, G, bx); break;
        case PT_SGUOUT: case PT_WO: {
            const bool sg = type == PT_SGUOUT;
            Gemm g = make_gemm((const bf16*)(ws + (sg ? WS_UG : WS_O)), (const bf16*)(ws + WS_WMIX2), T, D, sg ? SGUHALF : D); StaticOrder S; S.init(T, D, G, bx);
            EpiResid E{Y, Y, STATS, args.in[2] + (size_t)(layer * 3 + 0) * D, args.in[3] + (size_t)(layer * 3 + 0) * D, ALPHA, 1.0f};
            gemm_phase<EpiResid, StaticOrder>(lds, g, S, E);
        } break;
        case PT_KV: {
            Gemm g = make_gemm(HB, (const bf16*)(ws + WS_WKV), T, NKV, D); StaticOrder S; S.init(T, NKV, G, bx);
            EpiKV E{(bf16*)(ws + WS_KV), (bf16*)(ws + WS_VTS)};
            gemm_phase<EpiKV, StaticOrder>(lds, g, S, E);
        } break;
        case PT_CMP1: {
            const int half = G / 2, s = bx >= half ? 1 : 0;
            if (bx < 2 * half) {
                Gemm g; g.A = (const bf16*)(ws + WS_KV) + s * 256; g.Bt = (const bf16*)(ws + WS_WC1) + (size_t)s * 256 * 2048; g.M = NCMPROWS; g.N = 256; g.K = 2048;
                g.lda = 16 * NKV; g.a_kstep = NKV * 2; g.a_hstep = 64 * 2; g.a_div = 2; g.a_thi = (long)SEQ * NKV * 2; g.a_tlo = 128 * 2;
                StaticOrder S; S.init(NCMPROWS, 256, half, bx - s * half);
                EpiBf16<1> E{(bf16*)(ws + WS_HID) + (size_t)s * NCMPROWS * 256, 256, (const float*)(ws + WS_BIAS2) + s * 256};
                gemm_phase<EpiBf16<1>, StaticOrder>(lds, g, S, E);
            }
        } break;
        case PT_CMP2: {
            const int half = G / 2, s = bx >= half ? 1 : 0;
            if (bx < 2 * half) {
                Gemm g = make_gemm((const bf16*)(ws + WS_HID) + (size_t)s * NCMPROWS * 256, (const bf16*)(ws + WS_WC2) + (size_t)s * 256 * 256, NCMPROWS, 256, 256);
                StaticOrder S; S.init(NCMPROWS, 256, half, bx - s * half);
                EpiCmp2 E{(bf16*)(ws + (s ? WS_VC : WS_KC)), s};
                gemm_phase<EpiCmp2, StaticOrder>(lds, g, S, E);
            }
        } break;
        case PT_QG: {
            Gemm g = make_gemm(HB, (const bf16*)(ws + WS_WMIX), T, NQGP, D); StaticOrder S; S.init(T, NQGP, G, bx);
            EpiQG E{(bf16*)(ws + WS_Q), (float*)(ws + WS_GATES)};
            gemm_phase<EpiQG, StaticOrder>(lds, g, S, E);
        } break;
        case PT_ATTN: attn_mfma_phase(args, ws, lds, G, bx); break;
        default: break;
        }
        for (int k = 0; k < 2; ++k) { const int cs = k ? cs1 : cs0; if (cs >= 0) convert_set(args, ws, cs, scr, gw, NGW, lane); }
        if (ph + 1 < ph_hi) cg::this_grid().sync();
    }
}

extern "C" void kernel_launch(void* const* d_in, const int* in_sizes, int n_in, void* d_out, int out_size, void* d_ws, size_t ws_size, hipStream_t stream) {
    static int grid = 0;
    if (grid == 0) {
        if (n_in != 20 || in_sizes[0] != T * D || out_size != T * D || ws_size < WS_END) { fprintf(stderr, "kernel_launch: unexpected shapes: n_in %d in0 %d out %d ws %zu\n", n_in, n_in > 0 ? in_sizes[0] : -1, out_size, ws_size); grid = -1; return; }
        int dev = 0, cus = 0, per_cu = 0;
        if (hipGetDevice(&dev) != hipSuccess || hipDeviceGetAttribute(&cus, hipDeviceAttributeMultiprocessorCount, dev) != hipSuccess) { grid = -1; return; }
        if (hipFuncSetAttribute((const void*)mega_fwd, hipFuncAttributeMaxDynamicSharedMemorySize, LDS_BYTES) != hipSuccess) { fprintf(stderr, "kernel_launch: hipFuncSetAttribute failed\n"); grid = -1; return; }
        if (hipOccupancyMaxActiveBlocksPerMultiprocessor(&per_cu, (const void*)mega_fwd, NTHR, LDS_BYTES) != hipSuccess || per_cu < 1) { fprintf(stderr, "kernel_launch: occupancy query says %d\n", per_cu); per_cu = 1; }
        (void)hipGetLastError();
        grid = cus * 1;
        if (grid & 1) grid -= 1;
    }
    if (grid < 0) return;
    Args a{};
    for (int i = 0; i < 20; ++i) a.in[i] = (const float*)d_in[i];
    a.out = (float*)d_out; a.ws = (unsigned char*)d_ws;
#if MK_PER_PHASE
    for (int ph = 0; ph < N_PHASES; ++ph) { a.ph_lo = ph; a.ph_hi = ph + 1; hipLaunchKernelGGL(mega_fwd, dim3(grid), dim3(NTHR), LDS_BYTES, stream, a); }
#else
    a.ph_lo = 0; a.ph_hi = N_PHASES;
    void* kargs[] = {&a};
    hipError_t e = hipLaunchCooperativeKernel((const void*)mega_fwd, dim3(grid), dim3(NTHR), kargs, LDS_BYTES, stream);
    if (e != hipSuccess) fprintf(stderr, "kernel_launch: cooperative launch failed: %s (grid %d)\n", hipGetErrorString(e), grid);
#endif
}
```

```cpp
#include <hip/hip_runtime.h>
#include <hip/hip_cooperative_groups.h>
#include <cstdio>
#include <cstdint>
namespace cg = cooperative_groups;

#ifndef MK_PER_PHASE
#define MK_PER_PHASE 0
#endif
#ifndef RESID_ROWS
#define RESID_ROWS 1
#endif
#ifndef SGUIN_VARIANT
#define SGUIN_VARIANT 0
#endif
#ifndef DUP_A
#define DUP_A -1
#define DUP_B -1
#endif
#ifndef PROBE_MASK
#define PROBE_MASK 0
#endif

__device__ __forceinline__ int cur_tid(int wave) { int l = (int)__builtin_amdgcn_mbcnt_hi(~0u, __builtin_amdgcn_mbcnt_lo(~0u, 0u)); asm volatile("" : "+v"(l)); return l + 64 * wave; }
namespace pg8 {
#define PG8_LAS __attribute__((address_space(3)))
typedef unsigned short bf16_t;
typedef short bf16x8 __attribute__((ext_vector_type(8)));
typedef float f32x4 __attribute__((ext_vector_type(4)));
typedef float f32x2 __attribute__((ext_vector_type(2)));
typedef unsigned u32x4 __attribute__((ext_vector_type(4)));
typedef unsigned u32x2 __attribute__((ext_vector_type(2)));
constexpr float QSCALE = 0.125f * 1.4426950408889634f;
constexpr int BM = 256, BK = 64, HALF = 128, HTB = HALF * BK * 2, STAGE_BYTES = 8 * HTB, NXCD = 8, WGM = 4;

__host__ __device__ __forceinline__ int lds_byte(int r, int c) { const int st = (r >> 4) * 2 + (c >> 5), rr = r & 15, cc = c & 31, ob = rr * 64 + cc * 2; return st * 1024 + (ob ^ (((ob >> 9) & 1) << 5)); }
__host__ __device__ __forceinline__ void stage_rc(int b, int& R, int& C) { const int st = b / 1024, sb = b % 1024, swz = sb ^ (((sb >> 9) & 1) << 5); R = (st >> 1) * 16 + swz / 64; C = (st & 1) * 32 + (swz % 64) / 2; }
__host__ __device__ __forceinline__ int perm32(int rho) { const int n = rho >> 4, i = rho & 15; return 8 * (i >> 2) + 4 * n + (i & 3); }

struct Unit { int pm, pn; };
struct Gemm { const bf16_t* A; const bf16_t* Bt; int M, N, K; int lda; long a_kstep, a_hstep; int a_div; long a_thi, a_tlo; };
__device__ __forceinline__ Gemm make_gemm(const bf16_t* A, const bf16_t* Bt, int M, int N, int K) {
    Gemm g; g.A = A; g.Bt = Bt; g.M = M; g.N = N; g.K = K; g.lda = K; g.a_kstep = BK * 2; g.a_hstep = (long)HALF * K * 2; g.a_div = 1; g.a_thi = (long)BM * K * 2; g.a_tlo = 0; return g;
}

struct StaticOrder {
    int nM, nN, nwg, G, c;
    __host__ __device__ void init(int M, int N, int G_, int c_) { nM = M / BM; nN = N / BM; nwg = nM * nN; G = G_; c = c_; }
    __host__ __device__ bool next(int i, Unit& u) const {
        const long L = (long)i * G + c; if (L >= nwg) return false;
        int wgid = (int)L; { const int q = nwg / NXCD, r = nwg % NXCD, xcd = wgid % NXCD, off = wgid / NXCD; wgid = (xcd < r ? xcd * (q + 1) : r * (q + 1) + (xcd - r) * q) + off; }
        const int nig = WGM * nN, gid = wgid / nig, fm = gid * WGM, gsz = (nM - fm) < WGM ? (nM - fm) : WGM;
        u.pm = fm + ((wgid % nig) % gsz); u.pn = (wgid % nig) / gsz; return true;
    }
};

__device__ __forceinline__ unsigned cvt_pk_bf16(float lo, float hi) { unsigned r; asm volatile("v_cvt_pk_bf16_f32 %0, %1, %2" : "=v"(r) : "v"(lo), "v"(hi)); return r; }
__device__ __forceinline__ f32x2 gelu_pk(f32x2 v) {
    const f32x2 av = __builtin_elementwise_abs(v), d = av * 0.2316418882f + 1.0f;
    f32x2 t; t.x = __builtin_amdgcn_rcpf(d.x); t.y = __builtin_amdgcn_rcpf(d.y);
    f32x2 q = t * 0.5307027145f + (-0.7265760135f); q = q * t + 0.7107068705f; q = q * t + (-0.142248368f); q = q * t + 0.127414796f; q = q * t;
    const f32x2 s = (v * v) * (-0.72134752044f);
    f32x2 e; e.x = __builtin_amdgcn_exp2f(s.x); e.y = __builtin_amdgcn_exp2f(s.y);
    const f32x2 m = v * (q * e), r = v - m;
    f32x2 o; o.x = v.x < 0.f ? m.x : r.x; o.y = v.y < 0.f ? m.y : r.y; return o;
}
__device__ __forceinline__ f32x4 gelu4(f32x4 v) { f32x2 a = gelu_pk((f32x2){v[0], v[1]}), b = gelu_pk((f32x2){v[2], v[3]}); return (f32x4){a.x, a.y, b.x, b.y}; }
__device__ __forceinline__ float bf2f(unsigned short b) { return __uint_as_float(((unsigned)b) << 16); }

#define EPI_ZERO_INIT __device__ __forceinline__ void init(f32x4 (&iv)[2][2], const Unit&, int, int, int, int) const { iv[0][0] = iv[0][1] = iv[1][0] = iv[1][1] = (f32x4){0.f, 0.f, 0.f, 0.f}; }
template <int ACT> struct EpiBf16 {
    static constexpr bool PERM = true;
    EPI_ZERO_INIT
    bf16_t* O; int ldc; const float* bias;
    __device__ __forceinline__ void operator()(const f32x4 (&acc)[2][2][4][2], const Unit& u, int wr, int wc, int fr, int fq) const {
        const int row0 = u.pm * BM + wr * 64 + fr; const int col0 = u.pn * BM + wc * 32 + 8 * fq;
        f32x4 bv[2][2];
#pragma unroll
        for (int bj = 0; bj < 2; ++bj)
#pragma unroll
            for (int n = 0; n < 2; ++n) bv[bj][n] = bias ? *(const f32x4*)(bias + col0 + bj * HALF + 4 * n) : (f32x4){0.f, 0.f, 0.f, 0.f};
#pragma unroll
        for (int ai = 0; ai < 2; ++ai)
#pragma unroll
            for (int m = 0; m < 4; ++m) { bf16_t* rowp = O + (size_t)(row0 + ai * HALF + m * 16) * ldc + col0;
#pragma unroll
                for (int bj = 0; bj < 2; ++bj) { f32x4 v0 = acc[ai][bj][m][0] + bv[bj][0], v1 = acc[ai][bj][m][1] + bv[bj][1];
                    if (ACT == 1) { v0 = gelu4(v0); v1 = gelu4(v1); }
                    u32x4 w; w.x = cvt_pk_bf16(v0[0], v0[1]); w.y = cvt_pk_bf16(v0[2], v0[3]); w.z = cvt_pk_bf16(v1[0], v1[1]); w.w = cvt_pk_bf16(v1[2], v1[3]);
                    *(u32x4*)(rowp + bj * HALF) = w; } }
    }
};
__device__ __forceinline__ void row_stats4(const float* PS, int rowa, int fq, float (&mu)[4], float (&rs)[4]) {
    f32x4 a[4], b[4];
#pragma unroll
    for (int r = 0; r < 4; ++r) { const f32x4* p = (const f32x4*)(PS + (size_t)(rowa + r * 16) * 32 + fq * 8); a[r] = p[0]; b[r] = p[1]; }
#pragma unroll
    for (int r = 0; r < 4; ++r) { float s = (a[r].x + a[r].z) + (b[r].x + b[r].z), q = (a[r].y + a[r].w) + (b[r].y + b[r].w);
        s += __shfl_xor(s, 16); s += __shfl_xor(s, 32); q += __shfl_xor(q, 16); q += __shfl_xor(q, 32);
        mu[r] = s * (1.f / 1024.f); rs[r] = __builtin_amdgcn_rsqf(fmaxf(q * (1.f / 1024.f) - mu[r] * mu[r], 0.f) + 1e-5f); }
}
__device__ __forceinline__ void row_stats8(const float* PS, int row0, int fq, float (&mu)[8], float (&rs)[8]) {
    float m0[4], r0[4], m1[4], r1[4]; row_stats4(PS, row0, fq, m0, r0); row_stats4(PS, row0 + HALF, fq, m1, r1);
#pragma unroll
    for (int r = 0; r < 4; ++r) { mu[r] = m0[r]; rs[r] = r0[r]; mu[4 + r] = m1[r]; rs[4 + r] = r1[r]; }
}
struct EpiSwiGLU {
    static constexpr bool PERM = false;
    EPI_ZERO_INIT
    bf16_t* U; int ldc; const float* PS; const float* GW; const float* BW;
    __device__ __forceinline__ void operator()(const f32x4 (&acc)[2][2][4][2], const Unit& u, int wr, int wc, int fr, int fq) const {
        const int row0 = u.pm * BM + wr * 64 + fr;
        float mu[8], rs[8]; f32x4 gwa[2], gwb[2], bwa[2], bwb[2];
        if (PS) { row_stats8(PS, row0, fq, mu, rs);
#pragma unroll
            for (int bj = 0; bj < 2; ++bj) { const int c = (u.pn * 8 + bj * 4 + wc) * 32 + 4 * fq; gwa[bj] = *(const f32x4*)(GW + c); gwb[bj] = *(const f32x4*)(GW + c + 16); bwa[bj] = *(const f32x4*)(BW + c); bwb[bj] = *(const f32x4*)(BW + c + 16); } }
#pragma unroll
        for (int ai = 0; ai < 2; ++ai)
#pragma unroll
            for (int m = 0; m < 4; ++m) { const int row = row0 + ai * HALF + m * 16; bf16_t* rowp = U + (size_t)row * ldc;
#pragma unroll
                for (int bj = 0; bj < 2; ++bj) { const int G32 = u.pn * 8 + bj * 4 + wc; f32x4 a = acc[ai][bj][m][0], b = acc[ai][bj][m][1]; f32x4 o;
                    if (PS) { a = (a - mu[ai * 4 + m] * gwa[bj]) * rs[ai * 4 + m] + bwa[bj]; b = (b - mu[ai * 4 + m] * gwb[bj]) * rs[ai * 4 + m] + bwb[bj]; }
#pragma unroll
                    for (int j = 0; j < 4; ++j) { const float e = __builtin_amdgcn_exp2f(a[j] * -1.44269504089f); o[j] = a[j] * __builtin_amdgcn_rcpf(1.0f + e) * b[j]; }
                    u32x2 w; w.x = cvt_pk_bf16(o[0], o[1]); w.y = cvt_pk_bf16(o[2], o[3]);
                    *(u32x2*)(rowp + G32 * 16 + fq * 4) = w; } }
    }
};
struct EpiResid {
    static constexpr bool PERM = false;
    const float* Yin; float* Yout; bf16_t* YB; const float* PSin; float* PSout; const float* g; const float* b; float alpha, scale; int last;
    __device__ __forceinline__ void init(f32x4 (&iv)[2][2], const Unit& u, int wr, int wc, int fr, int fq) const {
        const int col0 = u.pn * BM + wc * 32 + 4 * fq; const float k = alpha / scale;
#pragma unroll
        for (int bj = 0; bj < 2; ++bj)
#pragma unroll
            for (int n = 0; n < 2; ++n) iv[bj][n] = PSin ? *(const f32x4*)(b + col0 + bj * HALF + n * 16) * k : (f32x4){0.f, 0.f, 0.f, 0.f};
    }
    __device__ __forceinline__ void operator()(const f32x4 (&acc)[2][2][4][2], const Unit& u, int wr, int wc, int fr, int fq) const {
        const int row0 = u.pm * BM + wr * 64 + fr, col0 = u.pn * BM + wc * 32 + 4 * fq;
        f32x4 gv[2][2];
#pragma unroll
        for (int bj = 0; bj < 2; ++bj)
#pragma unroll
            for (int n = 0; n < 2; ++n) gv[bj][n] = PSin ? *(const f32x4*)(g + col0 + bj * HALF + n * 16) : (f32x4){1.f, 1.f, 1.f, 1.f};
        const unsigned e0 = (unsigned)row0 * 1024u + (unsigned)col0;
#pragma unroll
        for (int ai = 0; ai < 2; ++ai) {
#pragma unroll
            for (int mp = 0; mp < 2; ++mp) {
                f32x4 y[2][2][2]; f32x4 sa[2], sb[2];
                if (PSin) {
#pragma unroll
                    for (int mm = 0; mm < 2; ++mm) { const f32x4* p = (const f32x4*)(PSin + (size_t)(row0 + ai * HALF + (mp * 2 + mm) * 16) * 32 + fq * 8); sa[mm] = p[0]; sb[mm] = p[1]; } }
#pragma unroll
                for (int mm = 0; mm < 2; ++mm)
#pragma unroll
                    for (int bj = 0; bj < 2; ++bj)
#pragma unroll
                        for (int n = 0; n < 2; ++n) y[mm][bj][n] = *(const f32x4*)((const char*)Yin + (size_t)((e0 + (unsigned)(ai * HALF + (mp * 2 + mm) * 16) * 1024u + bj * HALF + n * 16) * 4u));
#pragma unroll
                for (int mm = 0; mm < 2; ++mm) { const int m = mp * 2 + mm; const unsigned er = e0 + (unsigned)(ai * HALF + m * 16) * 1024u;
                    float mu_ = 0.f, rs_ = 1.f;
                    if (PSin) { float s1 = (sa[mm].x + sa[mm].z) + (sb[mm].x + sb[mm].z), q1 = (sa[mm].y + sa[mm].w) + (sb[mm].y + sb[mm].w);
                        s1 += __shfl_xor(s1, 16); s1 += __shfl_xor(s1, 32); q1 += __shfl_xor(q1, 16); q1 += __shfl_xor(q1, 32);
                        mu_ = s1 * (1.f / 1024.f); rs_ = __builtin_amdgcn_rsqf(fmaxf(q1 * (1.f / 1024.f) - mu_ * mu_, 0.f) + 1e-5f); }
                    float s = 0.f, q = 0.f;
#pragma unroll
                    for (int bj = 0; bj < 2; ++bj)
#pragma unroll
                        for (int n = 0; n < 2; ++n) { const unsigned e = er + bj * HALF + n * 16; f32x4 v = y[mm][bj][n];
                            if (PSin) v = (v - mu_) * rs_ * gv[bj][n];
                            v = v * alpha + acc[ai][bj][m][n] * scale;
                            *(f32x4*)((char*)Yout + (size_t)(e * 4u)) = v;
                            if (!last) { u32x2 w; w.x = cvt_pk_bf16(v[0], v[1]); w.y = cvt_pk_bf16(v[2], v[3]); *(u32x2*)((char*)YB + (size_t)(e * 2u)) = w; }
                            s += (v[0] + v[1]) + (v[2] + v[3]); q += (v[0] * v[0] + v[1] * v[1]) + (v[2] * v[2] + v[3] * v[3]); }
                    s += __shfl_xor(s, 16); s += __shfl_xor(s, 32); q += __shfl_xor(q, 16); q += __shfl_xor(q, 32);
                    if (fq == 0 && !last) *(f32x2*)(PSout + (size_t)(row0 + ai * HALF + m * 16) * 32 + (u.pn * 4 + wc) * 2) = (f32x2){s, q}; }
                } }
    }
};
struct EpiSguIn {
    static constexpr bool PERM = false;
    EPI_ZERO_INIT
    bf16_t* UG; bf16_t* VT; float* VSTAT; const float* PS; const float* GW; const float* BW; PG8_LAS unsigned char* xscr;
    __device__ __forceinline__ void operator()(const f32x4 (&acc)[2][2][4][2], const Unit& u, int wr, int wc, int fr, int fq) const {
        const int row0 = u.pm * BM + wr * 64 + fr, col0 = u.pn * BM + wc * 32 + 4 * fq;
        PG8_LAS bf16_t* xs = (PG8_LAS bf16_t*)(xscr + (wr * 4 + wc) * 2048);
        const int lane = fq * 16 + fr;
#pragma unroll
        for (int ai = 0; ai < 2; ++ai) {
            float mu[4], rs[4], sa[4], qa[4];
#pragma unroll
            for (int r = 0; r < 4; ++r) { sa[r] = 0.f; qa[r] = 0.f; }
            row_stats4(PS, row0 + ai * HALF, fq, mu, rs);
            f32x4 gnx = *(const f32x4*)(GW + col0), bnx = *(const f32x4*)(BW + col0);
#pragma unroll
            for (int bj = 0; bj < 2; ++bj)
#pragma unroll
                for (int n = 0; n < 2; ++n) { const int col = col0 + bj * HALF + n * 16;
                    const f32x4 gv = gnx, bv = bnx;
                    if (bj * 2 + n < 3) { const int cn = col0 + ((bj * 2 + n + 1) >> 1) * HALF + ((bj * 2 + n + 1) & 1) * 16; gnx = *(const f32x4*)(GW + cn); bnx = *(const f32x4*)(BW + cn); }
#pragma unroll
                    for (int m = 0; m < 4; ++m) { const int row = row0 + ai * HALF + m * 16;
                        const f32x4 v = gelu4((acc[ai][bj][m][n] - mu[m] * gv) * rs[m] + bv);
                        const unsigned w0 = cvt_pk_bf16(v[0], v[1]), w1 = cvt_pk_bf16(v[2], v[3]);
                        if (u.pn < 8) { u32x2 w; w.x = w0; w.y = w1; *(u32x2*)(UG + (size_t)row * 2048 + col) = w; }
                        else { const unsigned short h0 = (unsigned short)(w0 & 0xffff), h1 = (unsigned short)(w0 >> 16), h2 = (unsigned short)(w1 & 0xffff), h3 = (unsigned short)(w1 >> 16);
                            PG8_LAS bf16_t* p = xs + (4 * fq) * 64 + m * 16 + fr; p[0] = h0; p[64] = h1; p[128] = h2; p[192] = h3;
                            const float f0 = bf2f(h0), f1 = bf2f(h1), f2 = bf2f(h2), f3 = bf2f(h3);
                            sa[m] += (f0 + f1) + (f2 + f3); qa[m] += (f0 * f0 + f1 * f1) + (f2 * f2 + f3 * f3); } }
                    if (u.pn >= 8) {
                        const int rowbase = u.pm * BM + ai * HALF + wr * 64, cvb = (u.pn - 8) * BM + bj * HALF + wc * 32 + n * 16;
#pragma unroll
                        for (int k = 0; k < 2; ++k) { const int ch = lane + 64 * k, cc = ch >> 3, part = ch & 7;
                            const u32x4 d = *(const PG8_LAS u32x4*)(xs + cc * 64 + part * 8);
                            *(u32x4*)(VT + (size_t)(rowbase >> 7) * (2048 * 128) + (size_t)(cvb + cc) * 128 + (rowbase & 127) + part * 8) = d; } }
                    }
            if (u.pn >= 8) {
#pragma unroll
                for (int r = 0; r < 4; ++r) { float s = sa[r], q = qa[r];
                    s += __shfl_xor(s, 16); s += __shfl_xor(s, 32); q += __shfl_xor(q, 16); q += __shfl_xor(q, 32);
                    if (fq == 0) *(f32x2*)(VSTAT + ((size_t)(row0 + ai * HALF + r * 16) * 32 + (u.pn - 8) * 4 + wc) * 2) = (f32x2){s, q}; } }
        }
    }
};
struct EpiCmp2 {
    static constexpr bool PERM = false;
    EPI_ZERO_INIT
    bf16_t* KC; int tr;
    __device__ __forceinline__ void operator()(const f32x4 (&acc)[2][2][4][2], const Unit& u, int wr, int wc, int fr, int fq) const {
        if (u.pn != 0 || wc >= 2) return;
        const int row0 = u.pm * BM + wr * 64 + fr, col0 = wc * 32 + 4 * fq;
#pragma unroll
        for (int ai = 0; ai < 2; ++ai)
#pragma unroll
            for (int m = 0; m < 4; ++m) { const int row = row0 + ai * HALF + m * 16; const bool z = (row & 127) == 127;
#pragma unroll
                for (int n = 0; n < 2; ++n) { const f32x4 v = acc[ai][0][m][n]; u32x2 w; w.x = cvt_pk_bf16(v[0], v[1]); w.y = cvt_pk_bf16(v[2], v[3]); if (z) { w.x = 0u; w.y = 0u; }
                    if (!tr) *(u32x2*)(KC + (size_t)row * 64 + col0 + n * 16) = w;
                    else { bf16_t* p = KC + ((size_t)(row >> 7) * 64 + col0 + n * 16) * 128 + (row & 127);
                        p[0] = (bf16_t)(w.x & 0xffff); p[128] = (bf16_t)(w.x >> 16); p[256] = (bf16_t)(w.y & 0xffff); p[384] = (bf16_t)(w.y >> 16); } } }
    }
};
struct EpiKV {
    static constexpr bool PERM = false;
    EPI_ZERO_INIT
    bf16_t* KV; bf16_t* VT; const float* PS; const float* GW; const float* BW;
    __device__ __forceinline__ void operator()(const f32x4 (&acc)[2][2][4][2], const Unit& u, int wr, int wc, int fr, int fq) const {
        const int row0 = u.pm * BM + wr * 64 + fr, c0 = wc * 32 + 4 * fq;
        const bool tr = (u.pn == 3 || u.pn == 5);
        float mu[8], rs[8]; f32x4 gv[2][2], bv[2][2];
        row_stats8(PS, row0, fq, mu, rs);
#pragma unroll
        for (int bj = 0; bj < 2; ++bj)
#pragma unroll
            for (int n = 0; n < 2; ++n) { gv[bj][n] = *(const f32x4*)(GW + u.pn * 256 + c0 + bj * HALF + n * 16); bv[bj][n] = *(const f32x4*)(BW + u.pn * 256 + c0 + bj * HALF + n * 16); }
#pragma unroll
        for (int ai = 0; ai < 2; ++ai)
#pragma unroll
            for (int m = 0; m < 4; ++m) { const int row = row0 + ai * HALF + m * 16;
#pragma unroll
                for (int bj = 0; bj < 2; ++bj)
#pragma unroll
                    for (int n = 0; n < 2; ++n) { const int c = c0 + bj * HALF + n * 16;
                        const f32x4 v = (acc[ai][bj][m][n] - mu[ai * 4 + m] * gv[bj][n]) * rs[ai * 4 + m] + bv[bj][n];
                        u32x2 w; w.x = cvt_pk_bf16(v[0], v[1]); w.y = cvt_pk_bf16(v[2], v[3]);
                        if (!tr) *(u32x2*)(KV + (size_t)row * 1536 + u.pn * 256 + c) = w;
                        else { bf16_t* p = VT + (size_t)((u.pn - 3) >> 1) * ((size_t)65536 * 256) + ((size_t)((row >> 11) * 4 + (c >> 6)) * 64 + (c & 63)) * 2048 + (row & 2047);
                            p[0] = (bf16_t)(w.x & 0xffff); p[2048] = (bf16_t)(w.x >> 16); p[4096] = (bf16_t)(w.y & 0xffff); p[6144] = (bf16_t)(w.y >> 16); } } }
    }
};
struct EpiQG {
    static constexpr bool PERM = false;
    EPI_ZERO_INIT
    bf16_t* Q; float* GATES; const float* PS; const float* GW; const float* BW;
    __device__ __forceinline__ void operator()(const f32x4 (&acc)[2][2][4][2], const Unit& u, int wr, int wc, int fr, int fq) const {
        const int row0 = u.pm * BM + wr * 64 + fr, col0 = u.pn * BM + wc * 32 + 4 * fq;
        float mu[8], rs[8]; f32x4 gv[2][2], bv[2][2];
        row_stats8(PS, row0, fq, mu, rs);
#pragma unroll
        for (int bj = 0; bj < 2; ++bj)
#pragma unroll
            for (int n = 0; n < 2; ++n) { gv[bj][n] = *(const f32x4*)(GW + col0 + bj * HALF + n * 16); bv[bj][n] = *(const f32x4*)(BW + col0 + bj * HALF + n * 16); }
#pragma unroll
        for (int ai = 0; ai < 2; ++ai)
#pragma unroll
            for (int m = 0; m < 4; ++m) { const int row = row0 + ai * HALF + m * 16;
#pragma unroll
                for (int bj = 0; bj < 2; ++bj)
#pragma unroll
                    for (int n = 0; n < 2; ++n) { const int col = col0 + bj * HALF + n * 16; const f32x4 v = (acc[ai][bj][m][n] - mu[ai * 4 + m] * gv[bj][n]) * rs[ai * 4 + m] + bv[bj][n];
                        if (u.pn < 4) { u32x2 w; w.x = cvt_pk_bf16(v[0] * QSCALE, v[1] * QSCALE); w.y = cvt_pk_bf16(v[2] * QSCALE, v[3] * QSCALE); *(u32x2*)(Q + (size_t)row * 1024 + col) = w; }
                        else if (col < 1072) { f32x4 o;
#pragma unroll
                            for (int j = 0; j < 4; ++j) o[j] = __builtin_amdgcn_rcpf(1.0f + __builtin_amdgcn_exp2f(v[j] * -1.44269504089f));
                            *(f32x4*)(GATES + (size_t)row * 48 + (col - 1024)) = o; } } }
    }
};

template <class Epi, class Sched, bool ALIGN_EPI = true>
__device__ __forceinline__ void gemm_phase(PG8_LAS unsigned char* lds, const Gemm g, const Sched& S, const Epi& E, int wave_id) {
    const int tid = cur_tid(wave_id);
    const int wid = wave_id, lane = tid & 63, wr = wid >> 2, wc = wid & 3, fr = lane & 15, fq = lane >> 4;
    const int K = g.K, nt = K / BK;
    unsigned voffA[2], voffB[2];
#pragma unroll
    for (int i = 0; i < 2; ++i) { int R, C; stage_rc(tid * 16 + i * 8192, R, C); const int Rb = Epi::PERM ? ((R & ~31) + perm32(R & 31)) : R;
        voffA[i] = (unsigned)(R * g.lda + C) * 2u; voffB[i] = (unsigned)(Rb * K + C) * 2u; }
    const size_t kstepB = (size_t)(BK * 2), hstepB = (size_t)HALF * K * 2, tstepB = 2 * hstepB;
    const size_t kstepA = (size_t)g.a_kstep, hstepA = (size_t)g.a_hstep;
    const unsigned ldsw = (unsigned)wid * 1024u;
    const int aoff = lds_byte(wr * 64 + fr, fq * 8), boff = lds_byte(wc * 32 + fr, fq * 8);
#define PG8_ABASE(pm) ((const char*)g.A + (size_t)((pm) / g.a_div) * (size_t)g.a_thi + (size_t)((pm) % g.a_div) * (size_t)g.a_tlo)
#define PG8_SA(b, h) (((b) * 2 + (h)) * HTB)
#define PG8_SB(b, h) ((4 + (b) * 2 + (h)) * HTB)
#define PG8_STAGE(bufoff, gbase, voff) do { _Pragma("unroll") for (int _i = 0; _i < 2; ++_i) \
        __builtin_amdgcn_global_load_lds((const unsigned*)((const char*)(gbase) + (voff)[_i]), (PG8_LAS unsigned*)(lds + (bufoff) + ldsw + _i * 8192), 16, 0, 0); } while (0)
#define PG8_LDA(dst, b, h) do { _Pragma("unroll") for (int m = 0; m < 4; ++m) _Pragma("unroll") for (int k = 0; k < 2; ++k) dst[m][k] = *(const PG8_LAS bf16x8*)(lds + PG8_SA(b, h) + aoff + m * 2048 + k * 1024); } while (0)
#define PG8_LDB(dst, b, h) do { _Pragma("unroll") for (int n = 0; n < 2; ++n) _Pragma("unroll") for (int k = 0; k < 2; ++k) dst[n][k] = *(const PG8_LAS bf16x8*)(lds + PG8_SB(b, h) + boff + n * 2048 + k * 1024); } while (0)
#define PG8_MMA(ai, bj, At, Bt) do { __builtin_amdgcn_s_setprio(1); _Pragma("unroll") for (int m = 0; m < 4; ++m) _Pragma("unroll") for (int n = 0; n < 2; ++n) _Pragma("unroll") for (int k = 0; k < 2; ++k) \
        acc[ai][bj][m][n] = __builtin_amdgcn_mfma_f32_16x16x32_bf16(Bt[n][k], At[m][k], acc[ai][bj][m][n], 0, 0, 0); __builtin_amdgcn_s_setprio(0); } while (0)
#define PG8_WAIT_V(n) asm volatile("s_waitcnt vmcnt(" #n ")" ::: "memory")
#define PG8_WAIT_L(n) asm volatile("s_waitcnt lgkmcnt(" #n ")" ::: "memory")
#define PG8_BAR __builtin_amdgcn_s_barrier()
#define PG8_SCHED __builtin_amdgcn_sched_barrier(0)
    Unit cur, nxt; int ui = 0;
    if (!S.next(0, cur)) return;
    f32x4 acc[2][2][4][2];
#define PG8_ACC_INIT(un) do { f32x4 iv_[2][2]; E.init(iv_, un, wr, wc, fr, fq); _Pragma("unroll") for (int a = 0; a < 2; ++a) _Pragma("unroll") for (int b = 0; b < 2; ++b) _Pragma("unroll") for (int m = 0; m < 4; ++m) _Pragma("unroll") for (int n = 0; n < 2; ++n) acc[a][b][m][n] = iv_[b][n]; } while (0)
    PG8_ACC_INIT(cur);
    bf16x8 At[4][2], B0[2][2], B1[2][2];
    const char* cA = PG8_ABASE(cur.pm); const char* cB = (const char*)g.Bt + (size_t)cur.pn * tstepB;
    PG8_STAGE(PG8_SB(0, 0), cB, voffB); PG8_STAGE(PG8_SB(0, 1), cB + hstepB, voffB); PG8_STAGE(PG8_SA(0, 0), cA, voffA); PG8_STAGE(PG8_SA(0, 1), cA + hstepA, voffA);
    if (wr == 1) PG8_BAR;
    PG8_WAIT_V(2); PG8_BAR;
    PG8_STAGE(PG8_SB(1, 0), cB + kstepB, voffB); PG8_STAGE(PG8_SA(1, 0), cA + kstepA, voffA); PG8_STAGE(PG8_SB(1, 1), cB + hstepB + kstepB, voffB);
    PG8_WAIT_V(6); PG8_BAR;
    for (;;) {
        const bool has_next = S.next(ui + 1, nxt);
        const char* nA = has_next ? PG8_ABASE(nxt.pm) : cA; const char* nB = has_next ? (const char*)g.Bt + (size_t)nxt.pn * tstepB : cB;
        for (int t = 0; t < nt; t += 2) {
            const bool last = (t == nt - 2);
            const char* a1 = cA + (size_t)(t + 1) * kstepA;
            const char* a2 = last ? nA : cA + (size_t)(t + 2) * kstepA; const char* b2 = last ? nB : cB + (size_t)(t + 2) * kstepB;
            const char* a3 = a2 + kstepA; const char* b3 = b2 + kstepB;
            PG8_LDB(B0, 0, 0); PG8_LDB(B1, 0, 1); PG8_SCHED; PG8_LDA(At, 0, 0); PG8_STAGE(PG8_SA(1, 1), a1 + hstepA, voffA);
            PG8_WAIT_V(8); PG8_WAIT_L(0); PG8_BAR; PG8_MMA(0, 0, At, B0); PG8_MMA(0, 1, At, B1); PG8_BAR; PG8_SCHED;
            PG8_LDA(At, 0, 1); PG8_STAGE(PG8_SB(0, 0), b2, voffB); PG8_STAGE(PG8_SB(0, 1), b2 + hstepB, voffB); PG8_STAGE(PG8_SA(0, 0), a2, voffA);
            PG8_WAIT_V(8); PG8_WAIT_L(0); PG8_BAR; PG8_MMA(1, 0, At, B0); PG8_MMA(1, 1, At, B1); PG8_BAR; PG8_SCHED;
            PG8_LDB(B0, 1, 0); PG8_LDB(B1, 1, 1); PG8_SCHED; PG8_LDA(At, 1, 0); PG8_STAGE(PG8_SA(0, 1), a2 + hstepA, voffA);
            PG8_WAIT_V(8); PG8_WAIT_L(0); PG8_BAR; PG8_MMA(0, 0, At, B0); PG8_MMA(0, 1, At, B1); PG8_BAR; PG8_SCHED;
            PG8_LDA(At, 1, 1); PG8_STAGE(PG8_SB(1, 0), b3, voffB); PG8_STAGE(PG8_SB(1, 1), b3 + hstepB, voffB); PG8_STAGE(PG8_SA(1, 0), a3, voffA);
            PG8_WAIT_V(8); PG8_WAIT_L(0); PG8_BAR; PG8_MMA(1, 0, At, B0); PG8_MMA(1, 1, At, B1); PG8_BAR; PG8_SCHED;
        }
        if constexpr (ALIGN_EPI) { if (wr == 0) PG8_BAR; }
        E(acc, cur, wr, wc, fr, fq);
        if (!has_next) break;
        cur = nxt; cA = nA; cB = nB; ++ui;
        PG8_ACC_INIT(cur);
        if constexpr (ALIGN_EPI) { if (wr == 1) PG8_BAR; }
    }
    PG8_WAIT_V(0);
    if constexpr (!ALIGN_EPI) { if (wr == 0) PG8_BAR; }
    PG8_BAR;
#undef PG8_ACC_INIT
#undef PG8_ABASE
#undef PG8_SA
#undef PG8_SB
#undef PG8_STAGE
#undef PG8_LDA
#undef PG8_LDB
#undef PG8_MMA
#undef PG8_WAIT_V
#undef PG8_WAIT_L
#undef PG8_BAR
#undef PG8_SCHED
}
}

#define LAS __attribute__((address_space(3)))
typedef unsigned short bf16;
typedef unsigned v4u __attribute__((ext_vector_type(4)));
typedef unsigned v2u __attribute__((ext_vector_type(2)));
typedef float f32x4 __attribute__((ext_vector_type(4)));
typedef float f32x2 __attribute__((ext_vector_type(2)));
constexpr int NWAVES = 8, NTHR = 512;
constexpr int BATCH = 32, SEQ = 2048, D = 1024, T = BATCH * SEQ, FFN = 2816, NUP = 2 * FFN, SGUH = 4096, SGUHALF = 2048;
constexpr int NKV = 1536, NQG = 1072, NQGP = 1280, NCMPROWS = 16384;
constexpr float ALPHA = 1.681792830507429f, LN_EPS = 1e-5f, NEGF = -1e30f;
constexpr size_t MiB = 1u << 20;
constexpr size_t WS_VEC = 0, WS_WUP = 1 * MiB  , WS_WDN = 89 * MiB  , WS_WMIXL = 133 * MiB  , WS_WMIX2L = 165 * MiB  ;
constexpr size_t WS_WKV = 181 * MiB, WS_WC1 = 184 * MiB, WS_WC2 = 186 * MiB, WS_BIAS2 = 187 * MiB, WS_PS = 188 * MiB  , WS_VSTAT = 204 * MiB;
constexpr size_t WS_HB = 220 * MiB  , WS_SCR = 348 * MiB;
constexpr size_t WS_U = WS_SCR, WS_UG = WS_SCR, WS_VT = WS_SCR + 256 * MiB, WS_Q = WS_SCR, WS_O = WS_SCR + 128 * MiB, WS_GATES = WS_SCR + 256 * MiB;
constexpr size_t WS_KV = 700 * MiB, WS_KC = 892 * MiB, WS_VC = 894 * MiB, WS_HID = 896 * MiB, WS_VTS = 912 * MiB  , WS_END = 976 * MiB;
constexpr size_t UPW_BYTES = 11 * MiB, DNW_BYTES = (size_t)D * FFN * 2, PS_BYTES = 8 * MiB;
constexpr int VEC_UP = 0  , VEC_MIX = 8 * 11264  , VEC_KV = VEC_MIX + 4 * 8192  ;
constexpr int LDS_BYTES = 147456 + 64;
constexpr size_t WS_CTL = 187 * MiB + 512 * 1024, CTL_BYTES = 16384;

__device__ __forceinline__ unsigned f2bf(float f) { unsigned u = __builtin_bit_cast(unsigned, f); return (u + 0x7fffu + ((u >> 16) & 1u)) >> 16; }
__device__ __forceinline__ unsigned pk2(float lo, float hi) { return f2bf(lo) | (f2bf(hi) << 16); }
__device__ __forceinline__ float bflo(unsigned w) { return __uint_as_float(w << 16); }
__device__ __forceinline__ float bfhi(unsigned w) { return __uint_as_float(w & 0xffff0000u); }
__device__ __forceinline__ float wave_sum(float v) {
#pragma unroll
    for (int o = 1; o < 64; o <<= 1) v += __shfl_xor(v, o);
    return v;
}
#define LDS_WAIT() asm volatile("s_waitcnt lgkmcnt(0)" ::: "memory")

__device__ __forceinline__ int rowmap(int n, int mode) { return mode == 0 ? n : (32 * (n >> 4) + (n & 15) + (mode == 2 ? 16 : 0)); }
__device__ __forceinline__ void transpose_item(const float* W, int K, int N, bf16* WT, int mode, LAS float* scr, int item, int lane) {
    const int nblk = (N + 31) / 32, kb = item / nblk, nb = item % nblk, k0 = 64 * kb, n0 = 32 * nb;
    const bool nok = (n0 + (lane & 31)) < N;
    { const int nn = (lane & 7) * 4; const bool ok4 = (n0 + nn) < N;
#pragma unroll
      for (int i = 0; i < 8; ++i) { const int kk = 8 * i + (lane >> 3); f32x4 v = (f32x4){0.f, 0.f, 0.f, 0.f}; if (ok4) v = *(const f32x4*)(W + (size_t)(k0 + kk) * N + n0 + nn);
          LAS float* d = scr + kk * 33 + nn; d[0] = v.x; d[1] = v.y; d[2] = v.z; d[3] = v.w; } }
    LDS_WAIT(); asm volatile("" ::: "memory");
    const int c = lane & 7;
#pragma unroll
    for (int j = 0; j < 4; ++j) { const int n = (lane >> 3) + 8 * j; const LAS float* s = scr + (8 * c) * 33 + n;
        v4u o; o.x = pk2(s[0 * 33], s[1 * 33]); o.y = pk2(s[2 * 33], s[3 * 33]); o.z = pk2(s[4 * 33], s[5 * 33]); o.w = pk2(s[6 * 33], s[7 * 33]);
        if (n0 + n < N) *(v4u*)(WT + (size_t)rowmap(n0 + n, mode) * K + k0 + 8 * c) = o; }
    LDS_WAIT(); asm volatile("" ::: "memory");
}
struct Args { const float* in[20]; float* out; unsigned char* ws; int ph_lo, ph_hi; };
typedef const __attribute__((address_space(4))) unsigned long long* ArgP;
#define AIN(a, i) ((const float*)(const __attribute__((address_space(1))) float*)(a)[(i)])

__device__ __forceinline__ void fold_item(const float* W, int K, int N, bf16* WT, int mode, const float* g, const float* b, float* GW, float* BW, LAS float* scr, int nb, int lane) {
    const int n0 = 32 * nb; const bool nok = (n0 + (lane & 31)) < N; const int c = lane & 7;
    float gs[4] = {0.f, 0.f, 0.f, 0.f}, bs[4] = {0.f, 0.f, 0.f, 0.f};
    for (int k0 = 0; k0 < K; k0 += 64) {
        { const int nn = (lane & 7) * 4; const bool ok4 = (n0 + nn) < N;
#pragma unroll
          for (int i = 0; i < 8; ++i) { const int kk = 8 * i + (lane >> 3); f32x4 v = (f32x4){0.f, 0.f, 0.f, 0.f}; if (ok4) v = *(const f32x4*)(W + (size_t)(k0 + kk) * N + n0 + nn);
              LAS float* d = scr + kk * 33 + nn; d[0] = v.x; d[1] = v.y; d[2] = v.z; d[3] = v.w; } }
        LDS_WAIT(); asm volatile("" ::: "memory");
        f32x4 g0 = (f32x4){1.f, 1.f, 1.f, 1.f}, g1 = g0, b0 = (f32x4){0.f, 0.f, 0.f, 0.f}, b1 = b0;
        if (g) { g0 = *(const f32x4*)(g + k0 + 8 * c); g1 = *(const f32x4*)(g + k0 + 8 * c + 4); b0 = *(const f32x4*)(b + k0 + 8 * c); b1 = *(const f32x4*)(b + k0 + 8 * c + 4); }
#pragma unroll
        for (int j = 0; j < 4; ++j) { const int n = (lane >> 3) + 8 * j; const LAS float* sp = scr + (8 * c) * 33 + n;
            const float w0 = sp[0 * 33], w1 = sp[1 * 33], w2 = sp[2 * 33], w3 = sp[3 * 33], w4 = sp[4 * 33], w5 = sp[5 * 33], w6 = sp[6 * 33], w7 = sp[7 * 33];
            v4u o; o.x = pk2(w0 * g0.x, w1 * g0.y); o.y = pk2(w2 * g0.z, w3 * g0.w); o.z = pk2(w4 * g1.x, w5 * g1.y); o.w = pk2(w6 * g1.z, w7 * g1.w);
            gs[j] += ((bflo(o.x) + bfhi(o.x)) + (bflo(o.y) + bfhi(o.y))) + ((bflo(o.z) + bfhi(o.z)) + (bflo(o.w) + bfhi(o.w)));
            bs[j] += ((w0 * b0.x + w1 * b0.y) + (w2 * b0.z + w3 * b0.w)) + ((w4 * b1.x + w5 * b1.y) + (w6 * b1.z + w7 * b1.w));
            if (n0 + n < N) *(v4u*)(WT + (size_t)rowmap(n0 + n, mode) * K + k0 + 8 * c) = o; }
        LDS_WAIT(); asm volatile("" ::: "memory");
    }
#pragma unroll
    for (int j = 0; j < 4; ++j) { float x = gs[j], y = bs[j];
        x += __shfl_xor(x, 1); x += __shfl_xor(x, 2); x += __shfl_xor(x, 4); y += __shfl_xor(y, 1); y += __shfl_xor(y, 2); y += __shfl_xor(y, 4);
        const int n = (lane >> 3) + 8 * j; if (c == 0 && n0 + n < N) { GW[rowmap(n0 + n, mode)] = x; BW[rowmap(n0 + n, mode)] = y; } }
}
__device__ __forceinline__ void get_mat(ArgP a, unsigned char* ws, int cs, int mi, const float*& W, int& K, int& N, bf16*& WT, int& mode, int& fold, const float*& gam, const float*& bet, float*& GW, float*& BW) {
    mode = 0; fold = 0; gam = nullptr; bet = nullptr; GW = nullptr; BW = nullptr; float* vec = (float*)(ws + WS_VEC);
    if (cs < 4) {
        if (mi < 6) { const int sb = mi / 3, k = mi % 3; const size_t wi = (size_t)(cs * 2 + sb);
            if (k < 2) { W = AIN(a, 4 + k) + wi * D * FFN; K = D; N = FFN; WT = (bf16*)(ws + WS_WUP + wi * UPW_BYTES); mode = 1 + k; fold = 1;
                const int li = sb ? cs * 3 + 1 : cs * 3 - 1;
                if (li >= 0) { gam = AIN(a, 2) + (size_t)li * D; bet = AIN(a, 3) + (size_t)li * D; }
                GW = vec + VEC_UP + wi * 11264; BW = GW + 5632; }
            else { W = AIN(a, 6) + wi * FFN * D; K = FFN; N = D; WT = (bf16*)(ws + WS_WDN + wi * DNW_BYTES); } }
        else if (mi == 6) { fold = 1; gam = AIN(a, 2) + (size_t)(cs * 3) * D; bet = AIN(a, 3) + (size_t)(cs * 3) * D; GW = vec + VEC_MIX + cs * 8192; BW = GW + 4096; K = D; WT = (bf16*)(ws + WS_WMIXL + (size_t)cs * 8 * MiB);
            if (cs < 2) { W = AIN(a, 7) + (size_t)cs * D * SGUH; N = SGUH; } else { W = AIN(a, 18) + (size_t)(cs - 2) * D * NQG; N = NQG; } }
        else { N = D; WT = (bf16*)(ws + WS_WMIX2L + (size_t)cs * 4 * MiB);
            if (cs < 2) { W = AIN(a, 12) + (size_t)cs * SGUHALF * D; K = SGUHALF; } else { W = AIN(a, 19) + (size_t)(cs - 2) * D * D; K = D; } }
    } else {
        if (mi == 0) { W = AIN(a, 13); K = D; N = NKV; WT = (bf16*)(ws + WS_WKV); fold = 1; gam = AIN(a, 2) + (size_t)5 * D; bet = AIN(a, 3) + (size_t)5 * D; GW = vec + VEC_KV; BW = GW + 1536; }
        else if (mi < 3) { const int sl = mi - 1; W = AIN(a, 15) + (size_t)sl * 2048 * 256; K = 2048; N = 256; WT = (bf16*)(ws + WS_WC1) + (size_t)sl * 256 * 2048; }
        else { const int sl = mi - 3; W = AIN(a, 17) + (size_t)sl * 256 * 64; K = 256; N = 64; WT = (bf16*)(ws + WS_WC2) + (size_t)sl * 256 * 256; }
    }
}
__device__ __forceinline__ void convert_set(ArgP a, unsigned char* ws, int cs, LAS float* scr, int gw, int NGW, int lane) {
    const int nmat = cs < 4 ? 8 : 5;
    for (int mi = 0; mi < nmat; ++mi) { const float* W; int K, N, mode, fold; bf16* WT; const float* gam; const float* bet; float* GW; float* BW;
        get_mat(a, ws, cs, mi, W, K, N, WT, mode, fold, gam, bet, GW, BW);
        if (fold) { const int nitems = (N + 31) / 32; const int rot = (gw + 97 * (cs * 8 + mi)) % NGW;
            for (int it = rot; it < nitems; it += NGW) fold_item(W, K, N, WT, mode, gam, bet, GW, BW, scr, it, lane); }
        else { const int nitems = (K / 64) * ((N + 31) / 32);
            for (int it = gw; it < nitems; it += NGW) transpose_item(W, K, N, WT, mode, scr, it, lane); } }
}

__device__ __forceinline__ void ln_row(const float* yrow, const float* g, const float* b, bf16* hb, float* stats, float* fout, int lane) {
    const f32x4* xr = (const f32x4*)yrow + lane;
    f32x4 v[4]; float s = 0.f;
#pragma unroll
    for (int j = 0; j < 4; ++j) { v[j] = xr[64 * j]; s += (v[j].x + v[j].y) + (v[j].z + v[j].w); }
    const float mean = wave_sum(s) * (1.f / D); float s2 = 0.f;
#pragma unroll
    for (int j = 0; j < 4; ++j) { const f32x4 d = v[j] - mean; s2 += (d.x * d.x + d.y * d.y) + (d.z * d.z + d.w * d.w); }
    const float rstd = 1.f / sqrtf(wave_sum(s2) * (1.f / D) + LN_EPS);
#pragma unroll
    for (int j = 0; j < 4; ++j) { const f32x4 gv = *((const f32x4*)g + lane + 64 * j), bv = *((const f32x4*)b + lane + 64 * j);
        const f32x4 o = (v[j] - mean) * rstd * gv + bv;
        if (fout) *((f32x4*)fout + lane + 64 * j) = o;
        else { v2u w; w.x = pg8::cvt_pk_bf16(o.x, o.y); w.y = pg8::cvt_pk_bf16(o.z, o.w); *((v2u*)hb + lane + 64 * j) = w; } }
    if (stats && lane == 0) { stats[0] = mean; stats[1] = rstd; }
}

typedef float f32x16 __attribute__((ext_vector_type(16)));
typedef short s16x8 __attribute__((ext_vector_type(8)));
typedef short s16x4 __attribute__((ext_vector_type(4)));
typedef __bf16 bf16x2_t __attribute__((ext_vector_type(2)));
#define MFMA32(a, b, c) __builtin_amdgcn_mfma_f32_32x32x16_bf16((a), (b), (c), 0, 0, 0)
__device__ __forceinline__ unsigned pkbf(float lo, float hi) { return __builtin_bit_cast(unsigned, __builtin_convertvector((f32x2){lo, hi}, bf16x2_t)); }
constexpr int SP_LD = 136;
__device__ __forceinline__ void spatial_phase(ArgP a, unsigned char* ws, int layer, LAS unsigned char* lds, int G, int bx, int wave_id, int variant) {
    const int tid = cur_tid(wave_id);
    LAS bf16* Ws = (LAS bf16*)lds;
    LAS bf16* Vs = (LAS bf16*)(lds + 128 * SP_LD * 2);
    LAS float* MU = (LAS float*)(lds + (128 + 256) * SP_LD * 2);
    const float* w_s = AIN(a, 10) + (size_t)layer * 8 * 128 * 128; const float* b_s = AIN(a, 11) + (size_t)layer * 8 * 128;
    const float* lng = AIN(a, 8) + (size_t)layer * SGUHALF; const float* lnb = AIN(a, 9) + (size_t)layer * SGUHALF;
    bf16* UG = (bf16*)(ws + WS_UG); const bf16* VT = (const bf16*)(ws + WS_VT); const float* VSTAT = (const float*)(ws + WS_VSTAT);
    int gl = -1;
    for (int u = bx; u < 512 * 8; u += G) {
        const int g = u & 7, bn = u >> 3;
        __syncthreads();
        const int lane = tid & 63, w = wave_id, r = lane & 31, h = lane >> 5, wr = w >> 2, wc = w & 3;
        v2u uv[2][2][4]; float bst[2];
#pragma unroll
        for (int ti = 0; ti < 2; ++ti) { const int t = 64 * wr + 32 * ti + r; bst[ti] = b_s[g * 128 + t];
#pragma unroll
                for (int ci = 0; ci < 2; ++ci)
#pragma unroll
                    for (int gq = 0; gq < 4; ++gq) uv[ti][ci][gq] = *(const v2u*)(UG + (size_t)(bn * 128 + t) * 2048 + g * 256 + 64 * wc + 32 * ci + 8 * gq + 4 * h); }
        if (g != gl) { gl = g;
            for (int i = tid; i < 128 * 32; i += NTHR) { const int t = i >> 5, s4 = (i & 31) * 4; f32x4 w = *(const f32x4*)(w_s + ((size_t)g * 128 + t) * 128 + s4);
                if (s4 + 0 > t) w.x = 0.f; if (s4 + 1 > t) w.y = 0.f; if (s4 + 2 > t) w.z = 0.f; if (s4 + 3 > t) w.w = 0.f;
                v2u o; o.x = pk2(w.x, w.y); o.y = pk2(w.z, w.w); *(LAS v2u*)(Ws + t * SP_LD + s4) = o; } }
        if (tid < 128) { const float* p = VSTAT + ((size_t)(bn * 128 + tid) * 32) * 2; float s = 0.f, q = 0.f;
#pragma unroll
            for (int j = 0; j < 16; ++j) { const f32x4 v = *(const f32x4*)(p + 4 * j); s += v.x + v.z; q += v.y + v.w; }
            const float mean = s * (1.f / 2048.f); const float var = q * (1.f / 2048.f) - mean * mean;
            MU[tid] = mean; MU[128 + tid] = 1.f / sqrtf(fmaxf(var, 0.f) + LN_EPS); }
        __syncthreads();
        for (int i = tid; i < 256 * 16; i += NTHR) { const int c = i >> 4, s8 = (i & 15) * 8; const int cg = g * 256 + c;
            const v4u raw = *(const v4u*)(VT + ((size_t)bn * 2048 + cg) * 128 + s8); const float gg = lng[cg], bb = lnb[cg];
            const unsigned rw[4] = {raw.x, raw.y, raw.z, raw.w}; unsigned ow[4];
#pragma unroll
            for (int j = 0; j < 4; ++j) { const int s = s8 + 2 * j; const float x0 = (bflo(rw[j]) - MU[s]) * MU[128 + s] * gg + bb, x1 = (bfhi(rw[j]) - MU[s + 1]) * MU[128 + s + 1] * gg + bb; ow[j] = pk2(x0, x1); }
            *(LAS v4u*)(Vs + c * SP_LD + s8) = (v4u){ow[0], ow[1], ow[2], ow[3]}; }
        __syncthreads();
        {
            f32x16 acc[2][2];
#pragma unroll
            for (int ti = 0; ti < 2; ++ti)
#pragma unroll
                for (int ci = 0; ci < 2; ++ci)
#pragma unroll
                    for (int i = 0; i < 16; ++i) acc[ti][ci][i] = 0.f;
            __builtin_amdgcn_s_setprio(1);
#pragma unroll
            for (int ks = 0; ks < 8; ++ks) {
                if (16 * ks <= 64 * wr + 63) {
                    const s16x8 a0 = *(const LAS s16x8*)(Vs + (64 * wc + r) * SP_LD + 16 * ks + 8 * h), a1 = *(const LAS s16x8*)(Vs + (64 * wc + 32 + r) * SP_LD + 16 * ks + 8 * h);
                    const s16x8 b0 = *(const LAS s16x8*)(Ws + (64 * wr + r) * SP_LD + 16 * ks + 8 * h), b1 = *(const LAS s16x8*)(Ws + (64 * wr + 32 + r) * SP_LD + 16 * ks + 8 * h);
                    if (16 * ks <= 64 * wr + 31) { acc[0][0] = MFMA32(a0, b0, acc[0][0]); acc[0][1] = MFMA32(a1, b0, acc[0][1]); }
                    acc[1][0] = MFMA32(a0, b1, acc[1][0]); acc[1][1] = MFMA32(a1, b1, acc[1][1]);
                }
            }
            __builtin_amdgcn_s_setprio(0);
#pragma unroll
            for (int ti = 0; ti < 2; ++ti) { const int t = 64 * wr + 32 * ti + r;
#pragma unroll
                for (int ci = 0; ci < 2; ++ci)
#pragma unroll
                    for (int gq = 0; gq < 4; ++gq) { const size_t off = (size_t)(bn * 128 + t) * 2048 + g * 256 + 64 * wc + 32 * ci + 8 * gq + 4 * h;
                        const v2u uu = uv[ti][ci][gq]; v2u o;
                        o.x = pkbf(bflo(uu.x) * (acc[ti][ci][4 * gq] + bst[ti]), bfhi(uu.x) * (acc[ti][ci][4 * gq + 1] + bst[ti]));
                        o.y = pkbf(bflo(uu.y) * (acc[ti][ci][4 * gq + 2] + bst[ti]), bfhi(uu.y) * (acc[ti][ci][4 * gq + 3] + bst[ti]));
                        if (!variant) *(v2u*)(UG + off) = o; } }
        }
    }
    __syncthreads();
}

__device__ __forceinline__ int rel_bucket(int n) {
    if (n < 16) return n;
    const int large = 16 + (int)(logf((float)n / 16.0f) / 2.0794415416798357f * 16.0f);
    return large < 31 ? large : 31;
}
__device__ __forceinline__ s16x8 pack8(const f32x16& x, int s) {
    v4u p; p.x = pkbf(x[8 * s + 0], x[8 * s + 1]); p.y = pkbf(x[8 * s + 2], x[8 * s + 3]); p.z = pkbf(x[8 * s + 4], x[8 * s + 5]); p.w = pkbf(x[8 * s + 6], x[8 * s + 7]);
    return __builtin_bit_cast(s16x8, p);
}
constexpr int AT_KLD = 72, AT_CLD = 136;
constexpr int AT_BUF = 2 * 64 * AT_KLD * 2;
constexpr int AT_BLUT = 3 * AT_BUF, AT_IMP = AT_BLUT + 2048, AT_SELM = AT_IMP + 8192, AT_OT = AT_SELM + 256;

template <bool GEN>
__device__ __forceinline__ void attn_tile(const LAS bf16* Kt, const LAS bf16* Vt, const s16x8 (&qf)[4], f32x16 (&O)[2], float& m_run, float& l_run,
                                          int r, int h, int dl, unsigned wlim, bool ok, float cb, const LAS float* blut) {
    f32x16 S0, S1;
#pragma unroll
    for (int i = 0; i < 16; ++i) { S0[i] = 0.f; S1[i] = 0.f; }
    __builtin_amdgcn_s_setprio(1);
#pragma unroll
    for (int kk = 0; kk < 4; ++kk) {
        const s16x8 a0 = *(const LAS s16x8*)(Kt + r * AT_KLD + 16 * kk + 8 * h), a1 = *(const LAS s16x8*)(Kt + (32 + r) * AT_KLD + 16 * kk + 8 * h);
        S0 = MFMA32(a0, qf[kk], S0); S1 = MFMA32(a1, qf[kk], S1);
    }
    __builtin_amdgcn_s_setprio(0);
    float mx = NEGF;
    if (GEN) {
#pragma unroll
        for (int i = 0; i < 16; ++i) {
            const int off = (i & 3) + 8 * (i >> 2);
            const int d0 = dl - off, d1 = dl - off - 32;
            const bool v0 = ok && ((unsigned)d0 < wlim), v1 = ok && ((unsigned)d1 < wlim);
            const float b0 = blut[min((unsigned)d0, 127u)], b1 = blut[min((unsigned)d1, 127u)];
            S0[i] = v0 ? S0[i] + b0 : NEGF; S1[i] = v1 ? S1[i] + b1 : NEGF;
            mx = fmaxf(mx, fmaxf(S0[i], S1[i]));
        }
    } else {
#pragma unroll
        for (int i = 0; i < 16; ++i) mx = fmaxf(mx, fmaxf(S0[i], S1[i]));
        mx = ok ? mx + cb : NEGF;
    }
    mx = fmaxf(mx, __shfl_xor(mx, 32));
    const float m_new = fmaxf(m_run, mx), m_eff = fmaxf(m_new, -1e29f);
    const float corr = __builtin_amdgcn_exp2f(m_run - m_eff);
    const float sub = GEN ? m_eff : (ok ? m_eff - cb : 3e38f);
    float ps = 0.f;
#pragma unroll
    for (int i = 0; i < 16; ++i) { S0[i] = __builtin_amdgcn_exp2f(S0[i] - sub); S1[i] = __builtin_amdgcn_exp2f(S1[i] - sub); ps += S0[i] + S1[i]; }
    ps += __shfl_xor(ps, 32);
    l_run = l_run * corr + ps; m_run = m_new;
    if (__builtin_amdgcn_ballot_w64(corr != 1.0f) != 0ull) {
#pragma unroll
        for (int i = 0; i < 16; ++i) { O[0][i] *= corr; O[1][i] *= corr; }
    }
    __builtin_amdgcn_s_setprio(1);
#pragma unroll
    for (int blk = 0; blk < 2; ++blk)
#pragma unroll
        for (int st = 0; st < 2; ++st) {
            const s16x8 pb = pack8(blk ? S1 : S0, st);
#pragma unroll
            for (int dt = 0; dt < 2; ++dt) {
                const LAS bf16* vp = Vt + (32 * dt + r) * AT_KLD + 32 * blk + 16 * st + 4 * h;
                const s16x4 lo = *(const LAS s16x4*)vp, hi = *(const LAS s16x4*)(vp + 8);
                O[dt] = MFMA32(__builtin_shufflevector(lo, hi, 0, 1, 2, 3, 4, 5, 6, 7), pb, O[dt]);
            }
        }
    __builtin_amdgcn_s_setprio(0);
}

__device__ __forceinline__ void attn_mfma_phase(ArgP a, unsigned char* ws, LAS unsigned char* lds, int G, int bx, int wave_id) {
    const int tid = cur_tid(wave_id);
    const int lane = tid & 63, w = wave_id, r = lane & 31, h = lane >> 5, hd = r >> 3, ql = r & 7;
    LAS float* BLUT = (LAS float*)(lds + AT_BLUT); LAS float* IMP = (LAS float*)(lds + AT_IMP); LAS unsigned* SELM = (LAS unsigned*)(lds + AT_SELM);
    const bf16* Q = (const bf16*)(ws + WS_Q); bf16* Og = (bf16*)(ws + WS_O); const float* GATES = (const float*)(ws + WS_GATES);
    const bf16* KV = (const bf16*)(ws + WS_KV); const bf16* KC = (const bf16*)(ws + WS_KC); const bf16* VCT = (const bf16*)(ws + WS_VC); const bf16* VTS = (const bf16*)(ws + WS_VTS);
    const float* rel = AIN(a, 1);
    const LAS float* blut = BLUT + hd * 128;
    const int srow = tid >> 3, sch = tid & 7;
    for (int item = bx; item < BATCH * 4 * 32; item += G) {
        const int qb = ((item & 31) + 2 * (item >> 8)) & 31, g = (item >> 5) & 3, b = item >> 7;
        const int q0 = qb * 64, tq = q0 + 8 * w + ql, head = g * 4 + hd;
        const size_t row = (size_t)b * SEQ + tq;
        const int bg = b * 4 + g;
        __syncthreads();
#pragma unroll
        for (int j = 0; j < 2; ++j) { const int i = tid + 512 * j;
            { const int rr = i >> 3, ch = i & 7; *(LAS v4u*)((LAS bf16*)lds + rr * AT_KLD + ch * 8) = *(const v4u*)(KC + ((size_t)bg * 128 + rr) * 64 + ch * 8); }
            { const int rr = i >> 4, ch = i & 15; *(LAS v4u*)((LAS bf16*)(lds + AT_BUF) + rr * AT_CLD + ch * 8) = *(const v4u*)(VCT + ((size_t)bg * 64 + rr) * 128 + ch * 8); } }
        { const int hh = tid >> 7, dd = tid & 127; BLUT[hh * 128 + dd] = rel[rel_bucket(dd) * 16 + g * 4 + hh] * 1.4426950408889634f; }
        s16x8 qf[4];
#pragma unroll
        for (int kk = 0; kk < 4; ++kk) qf[kk] = *(const s16x8*)(Q + row * 1024 + head * 64 + 16 * kk + 8 * h);
        const float g0 = GATES[row * 48 + head * 3 + 0], g1 = GATES[row * 48 + head * 3 + 1], g2 = GATES[row * 48 + head * 3 + 2];
        f32x16 O[2];
        LAS float* otl = (LAS float*)(lds + AT_OT + w * 8192) + lane;
        __syncthreads();
        {
            const LAS bf16* Kc = (const LAS bf16*)lds; const LAS bf16* Vc = (const LAS bf16*)(lds + AT_BUF);
            float mx = NEGF, ps = 0.f;
            for (int kb = 0; kb < 4; ++kb) {
                f32x16 S;
#pragma unroll
                for (int i = 0; i < 16; ++i) S[i] = 0.f;
                __builtin_amdgcn_s_setprio(1);
#pragma unroll
                for (int kk = 0; kk < 4; ++kk) S = MFMA32(*(const LAS s16x8*)(Kc + (32 * kb + r) * AT_KLD + 16 * kk + 8 * h), qf[kk], S);
                __builtin_amdgcn_s_setprio(0);
                float bm = NEGF;
#pragma unroll
                for (int i = 0; i < 16; ++i) { const int ic = 32 * kb + (i & 3) + 8 * (i >> 2) + 4 * h; const int dist = tq - (16 * ic + 31);
                    const float bb = blut[min((unsigned)dist, 127u)]; S[i] = dist >= 0 ? S[i] + bb : NEGF; bm = fmaxf(bm, S[i]); }
                bm = fmaxf(bm, __shfl_xor(bm, 32));
                const float mn = fmaxf(mx, bm), me = fmaxf(mn, -1e29f); float bs = 0.f;
#pragma unroll
                for (int i = 0; i < 16; ++i) bs += __builtin_amdgcn_exp2f(S[i] - me);
                bs += __shfl_xor(bs, 32);
                ps = ps * __builtin_amdgcn_exp2f(mx - me) + bs; mx = mn;
            }
            const float m_eff = fmaxf(mx, -1e29f), linv = ps > 0.f ? 1.f / ps : 0.f;
#pragma unroll
            for (int i = 0; i < 16; ++i) { O[0][i] = 0.f; O[1][i] = 0.f; }
            float Lprev = 0.f;
            for (int kb = 0; kb < 4; ++kb) {
                f32x16 S;
#pragma unroll
                for (int i = 0; i < 16; ++i) S[i] = 0.f;
                __builtin_amdgcn_s_setprio(1);
#pragma unroll
                for (int kk = 0; kk < 4; ++kk) S = MFMA32(*(const LAS s16x8*)(Kc + (32 * kb + r) * AT_KLD + 16 * kk + 8 * h), qf[kk], S);
                __builtin_amdgcn_s_setprio(0);
#pragma unroll
                for (int i = 0; i < 16; ++i) { const int ic = 32 * kb + (i & 3) + 8 * (i >> 2) + 4 * h; const int dist = tq - (16 * ic + 31);
                    const float bb = blut[min((unsigned)dist, 127u)]; S[i] = dist >= 0 ? __builtin_amdgcn_exp2f(S[i] + bb - m_eff) * linv : 0.f; }
#pragma unroll
                for (int gq = 0; gq < 4; ++gq) {
                    const float Gs = (S[4 * gq] + S[4 * gq + 1]) + (S[4 * gq + 2] + S[4 * gq + 3]);
                    const float Lo = __shfl_xor(S[4 * gq + 3], 32);
                    float v = Gs + (h ? Lo : Lprev); Lprev = Lo;
                    v += __shfl_xor(v, 8); v += __shfl_xor(v, 16);
                    if (hd == 0) IMP[(8 * w + ql) * 32 + 2 * (4 * kb + gq) + h] = v; }
#pragma unroll
                for (int st = 0; st < 2; ++st) { const s16x8 pb = pack8(S, st);
#pragma unroll
                    for (int dt = 0; dt < 2; ++dt) { const LAS bf16* vp = Vc + (32 * dt + r) * AT_CLD + 32 * kb + 16 * st + 4 * h;
                        const s16x4 lo = *(const LAS s16x4*)vp, hi = *(const LAS s16x4*)(vp + 8);
                        O[dt] = MFMA32(__builtin_shufflevector(lo, hi, 0, 1, 2, 3, 4, 5, 6, 7), pb, O[dt]); } }
            }
#pragma unroll
            for (int i = 0; i < 16; ++i) { otl[i * 64] = g0 * O[0][i]; otl[(16 + i) * 64] = g0 * O[1][i]; }
        }
        __syncthreads();
        { const int q = tid >> 3, cur = (q0 + q) >> 6; unsigned mbits = 0u;
          for (int jj = 0; jj < 4; ++jj) { const int j = (tid & 7) * 4 + jj;
              const bool vj = j <= cur, fj = vj && (j == 0 || j > cur - 2); const float valj = fj ? 1e30f : (vj ? IMP[q * 32 + j] : -1e30f);
              int rank = 0;
              for (int k = 0; k < 32; ++k) { const bool vk = k <= cur, fk = vk && (k == 0 || k > cur - 2); const float valk = fk ? 1e30f : (vk ? IMP[q * 32 + k] : -1e30f);
                  rank += (valk > valj || (valk == valj && k < j)) ? 1 : 0; }
              if (rank < 8) mbits |= 1u << j; }
          mbits |= __shfl_xor(mbits, 1); mbits |= __shfl_xor(mbits, 2); mbits |= __shfl_xor(mbits, 4);
          if ((tid & 7) == 0) SELM[q] = mbits; }
        const int nsel = qb + 1, pw0 = q0 >= 512 ? q0 - 512 : 0, nwin = ((q0 - pw0) >> 6) + 1, ntile = nsel + nwin;
        const bf16* Ks = KV + (size_t)b * SEQ * NKV + 2 * 256 + g * 64; const bf16* Kw = KV + (size_t)b * SEQ * NKV + 4 * 256 + g * 64;
        const bf16* Vs = VTS + (size_t)bg * 64 * 2048; const bf16* Vw = VTS + (size_t)65536 * 256 + (size_t)bg * 64 * 2048;
        v4u kr0, vr0, kr1, vr1;
#define AT_LOAD(k, KR, VR) do { const bool sl_ = (k) < nsel; const int pb_ = sl_ ? 64 * (k) : pw0 + 64 * ((k) - nsel); \
            KR = *(const v4u*)((sl_ ? Ks : Kw) + (size_t)(pb_ + srow) * NKV + sch * 8); VR = *(const v4u*)((sl_ ? Vs : Vw) + (size_t)srow * 2048 + pb_ + sch * 8); } while (0)
#define AT_STORE(bufi, KR, VR) do { *(LAS v4u*)((LAS bf16*)(lds + (bufi) * AT_BUF) + srow * AT_KLD + sch * 8) = KR; *(LAS v4u*)((LAS bf16*)(lds + (bufi) * AT_BUF + 64 * AT_KLD * 2) + srow * AT_KLD + sch * 8) = VR; } while (0)
        AT_LOAD(0, kr0, vr0); if (ntile > 1) AT_LOAD(1, kr1, vr1);
        AT_STORE(0, kr0, vr0);
        __syncthreads();
        const unsigned selm = SELM[8 * w + ql];
        float m_run = NEGF, l_run = 0.f;
#pragma unroll
        for (int i = 0; i < 16; ++i) { O[0][i] = 0.f; O[1][i] = 0.f; }
        const int tmin = q0 + 8 * w, tmax = tmin + 7;
        const float cbfar = blut[127];
        int bufc = 0;
#define AT_STEP(k, KRN, VRN, KRS, VRS) do { \
            if ((k) + 2 < ntile) AT_LOAD((k) + 2, KRN, VRN); \
            const bool sl = (k) < nsel; const int pbase = sl ? 64 * (k) : pw0 + 64 * ((k) - nsel); \
            const LAS bf16* Kt = (const LAS bf16*)(lds + bufc * AT_BUF); const LAS bf16* Vt = (const LAS bf16*)(lds + bufc * AT_BUF + 64 * AT_KLD * 2); \
            const bool ok = sl ? ((selm >> (k)) & 1u) != 0u : true; \
            const bool fast = (tmin - (pbase + 63) >= 113) && (sl || (tmax - pbase < 512));     \
            if (__builtin_amdgcn_ballot_w64(ok) != 0ull) {                  \
            if (fast) attn_tile<false>(Kt, Vt, qf, O, m_run, l_run, r, h, 0, 0u, ok, cbfar, blut); \
            else attn_tile<true>(Kt, Vt, qf, O, m_run, l_run, r, h, tq - pbase - 4 * h, sl ? 0x7fffffffu : 512u, ok, 0.f, blut); } \
            bufc = bufc == 2 ? 0 : bufc + 1; \
            if ((k) + 1 < ntile) AT_STORE(bufc, KRS, VRS); \
            __syncthreads(); \
            if ((k) == nsel - 1) {                                        \
                const float sc = l_run > 0.f ? g1 / l_run : 0.f; \
                _Pragma("unroll") for (int i = 0; i < 16; ++i) { otl[i * 64] += sc * O[0][i]; otl[(16 + i) * 64] += sc * O[1][i]; O[0][i] = 0.f; O[1][i] = 0.f; } \
                m_run = NEGF; l_run = 0.f; } } while (0)
        for (int k = 0; k < ntile; k += 2) {
            AT_STEP(k, kr0, vr0, kr1, vr1);
            if (k + 1 >= ntile) break;
            AT_STEP(k + 1, kr1, vr1, kr0, vr0);
        }
#undef AT_STEP
        { const float sc = l_run > 0.f ? g2 / l_run : 0.f;
#pragma unroll
          for (int i = 0; i < 16; ++i) { O[0][i] = otl[i * 64] + sc * O[0][i]; O[1][i] = otl[(16 + i) * 64] + sc * O[1][i]; } }
#undef AT_LOAD
#undef AT_STORE
#pragma unroll
        for (int dt = 0; dt < 2; ++dt)
#pragma unroll
            for (int gq = 0; gq < 4; ++gq) { v2u wv; wv.x = pkbf(O[dt][4 * gq], O[dt][4 * gq + 1]); wv.y = pkbf(O[dt][4 * gq + 2], O[dt][4 * gq + 3]);
                *(v2u*)(Og + row * 1024 + head * 64 + 32 * dt + 8 * gq + 4 * h) = wv; }
    }
    __syncthreads();
}

#define XB_TMO      128
#define XB_XCNT(j)  (256  + 64 * (j))
#define XB_XSUB(j)  (1280 + 64 * (j))
#define XB_XGEN(j)  (2304 + 64 * (j))
#define XB_TOP      3328
#define XB_TOPGEN   3392
#define XCD_BAR_WORDS 3456
#define XB_SPIN_CAP (1u << 18)
__device__ __forceinline__ unsigned xb_ld(unsigned* p)              { return __hip_atomic_load(p, __ATOMIC_RELAXED, __HIP_MEMORY_SCOPE_AGENT); }
__device__ __forceinline__ unsigned xb_add(unsigned* p, unsigned v) { return __hip_atomic_fetch_add(p, v, __ATOMIC_RELAXED, __HIP_MEMORY_SCOPE_AGENT); }
__device__ __forceinline__ unsigned xb_xcc_id() { return (unsigned)__builtin_amdgcn_s_getreg((3 << 11) | 20) & 0xFu; }
#define XB_SPIN(cond, bar) do { unsigned _sp = 0; while (cond) { __builtin_amdgcn_s_sleep(1); \
    if ((++_sp & 255u) == 0u) { if (xb_ld(&(bar)[XB_TMO])) break; if (_sp > XB_SPIN_CAP) { atomicAdd(&(bar)[XB_TMO], 1u); break; } } } } while (0)
__device__ __forceinline__ void xcd_barrier_complete(unsigned* bar, unsigned x, unsigned& nloc, unsigned& nx) {
    const unsigned G = gridDim.x * gridDim.y * gridDim.z;
    unsigned sum, cnt, mine, sp = 0u;
    for (;;) {
        sum = 0u; cnt = 0u; mine = 0u;
#pragma unroll
        for (unsigned j = 0; j < 16; ++j) { const unsigned c = xb_ld(&bar[XB_XCNT(j)]); sum += c; cnt += (c > 0u) ? 1u : 0u; mine = (j == x) ? c : mine; }
        if (sum == G) break;
        __builtin_amdgcn_s_sleep(1);
        if ((++sp & 255u) == 0u) { if (xb_ld(&bar[XB_TMO])) break; if (sp > XB_SPIN_CAP) { atomicAdd(&bar[XB_TMO], 1u); break; } }
    }
    nloc = mine > 0u ? mine : 1u; nx = cnt > 0u ? cnt : 1u;
}
__device__ __forceinline__ void xcd_barrier(unsigned* bar, unsigned x, volatile LAS unsigned* st, bool leader) {
    asm volatile("s_waitcnt vmcnt(0)" ::: "memory");
    __syncthreads();
    if (leader) {
        __builtin_amdgcn_s_waitcnt(0);
        unsigned nloc = st[0], nx = st[1];
        if (nloc == 0u) { xcd_barrier_complete(bar, x, nloc, nx); st[0] = nloc; st[1] = nx; }
        const unsigned old = xb_add(&bar[XB_XSUB(x)], 1u);
        const unsigned gen = old / nloc;
        if (old + 1u == (gen + 1u) * nloc) {
            __builtin_amdgcn_fence(__ATOMIC_RELEASE, "agent");
            asm volatile("s_waitcnt vmcnt(0)" ::: "memory");
            const unsigned og = xb_add(&bar[XB_TOP], 1u);
            const unsigned tg = og / nx;
            if (og + 1u == (tg + 1u) * nx) xb_add(&bar[XB_TOPGEN], 1u);
            else XB_SPIN(xb_ld(&bar[XB_TOPGEN]) == tg, bar);
            __builtin_amdgcn_fence(__ATOMIC_ACQUIRE, "agent");
            xb_add(&bar[XB_XGEN(x)], 1u);
            asm volatile("s_waitcnt vmcnt(0)" ::: "memory");
        } else {
            XB_SPIN(xb_ld(&bar[XB_XGEN(x)]) == gen, bar);
            __builtin_amdgcn_fence(__ATOMIC_ACQUIRE, "agent");
            asm volatile("s_waitcnt vmcnt(0)" ::: "memory");
        }
    }
    __syncthreads();
}

enum { PT_PREP = 0, PT_UP, PT_DOWN, PT_LN, PT_SGUIN, PT_SPATIAL, PT_SGUOUT, PT_KV, PT_CMP1, PT_CMP2, PT_QG, PT_ATTN, PT_WO };
constexpr int N_PHASES = 33;
constexpr int N_RUN = N_PHASES + (DUP_A >= 0 ? 2 : 0);
__device__ __forceinline__ void decode_phase(int ph, int& type, int& layer, int& pos) {
    pos = 0;
    if (ph == 0) { type = PT_PREP; layer = 0; return; }
    if (ph == N_PHASES - 1) { type = PT_LN; layer = 3; return; }
    if (ph <= 7) { layer = 0; pos = ph - 1; }
    else if (ph <= 14) { layer = 1; pos = ph - 8; }
    else if (ph <= 24) { layer = 2; pos = ph - 15; if (pos < 3) { type = PT_KV + pos; pos = 0; return; } pos -= 3; }
    else { layer = 3; pos = ph - 25; }
    const bool A = layer < 2;
    switch (pos) {
        case 0: case 5: type = PT_UP; break;
        case 1: case 6: type = PT_DOWN; break;
        case 2: type = A ? PT_SGUIN : PT_QG; break;
        case 3: type = A ? PT_SPATIAL : PT_ATTN; break;
        default: type = A ? PT_SGUOUT : PT_WO; break;
    }
}

__global__ void __launch_bounds__(NTHR, 2) mega_fwd(Args kargs) {
    extern __shared__ __attribute__((aligned(16))) unsigned char lds_raw[];
    LAS unsigned char* lds = (LAS unsigned char*)lds_raw;
    const int wave = __builtin_amdgcn_readfirstlane((int)threadIdx.x >> 6);
    int G = gridDim.x, bx = blockIdx.x;
    unsigned long long wsi = (unsigned long long)kargs.ws, Yi = (unsigned long long)kargs.out; const int ph_lo = kargs.ph_lo, ph_hi = kargs.ph_hi;
    LAS float* scr = (LAS float*)(lds + wave * 16384);
    using namespace pg8;
    volatile LAS unsigned* xst = (volatile LAS unsigned*)(lds + 147456);
    const unsigned xcc = xb_xcc_id();
    { const int t0 = cur_tid(wave); if (t0 == 0) { xst[0] = 0u; xst[1] = 0u; (void)xb_add((unsigned*)(kargs.ws + WS_CTL) + XB_XCNT(xcc), 1u); } }
    __syncthreads();

    for (int ph = ph_lo; ph < ph_hi; ++ph) {
        int type, layer, pos; decode_phase(DUP_A < 0 ? ph : (ph <= DUP_A ? ph : (ph <= DUP_B + 1 ? ph - 1 : ph - 2)), type, layer, pos);
        type = __builtin_amdgcn_readfirstlane(type); layer = __builtin_amdgcn_readfirstlane(layer); pos = __builtin_amdgcn_readfirstlane(pos);
        const __attribute__((address_space(4))) Args* ap = (const __attribute__((address_space(4))) Args*)__builtin_amdgcn_kernarg_segment_ptr(); asm volatile("" : "+s"(ap));
        const ArgP args = (ArgP)ap;
        const int tid = cur_tid(wave);
        const int lane = tid & 63;
        asm volatile("" : "+s"(wsi), "+s"(G), "+s"(bx), "+s"(Yi));
        unsigned char* ws = (unsigned char*)(__attribute__((address_space(1))) unsigned char*)wsi; float* Y = (float*)(__attribute__((address_space(1))) float*)Yi;
#if PROBE_MASK
        if (bx == 0 && tid == 0) { unsigned long long* pp = (unsigned long long*)(ws + WS_BIAS2 + 65536); if (ph == 0) pp[1] = 0ull; pp[0] = __builtin_amdgcn_s_memrealtime(); }
#endif
        bf16* HB = (bf16*)(ws + WS_HB); float* VEC = (float*)(ws + WS_VEC);
        const int gw = bx * NWAVES + wave, NGW = G * NWAVES;
        const int sub = pos >= 5 ? 1 : 0;
        const int dc = 3 * layer + (pos > 1 ? 1 : 0) + (pos > 4 ? 1 : 0);
        const float* PSc = dc > 0 ? (const float*)(ws + WS_PS + (size_t)((dc - 1) & 1) * PS_BYTES) : nullptr;
        float* PSn = (float*)(ws + WS_PS + (size_t)(dc & 1) * PS_BYTES);
        const int lnc = dc - 1;
        const float* lng = dc > 0 ? AIN(args, 2) + (size_t)lnc * D : nullptr; const float* lnb = dc > 0 ? AIN(args, 3) + (size_t)lnc * D : nullptr;
        const size_t wi = (size_t)(layer * 2 + sub);
        switch (type) {
        case PT_PREP: {
            for (int k = 0; k < 5; ++k) convert_set(args, ws, k, scr, gw, NGW, lane);
            if (gw < 512) { const int s = gw >> 8, j = gw & 255; const float* pe = AIN(args, 14) + (size_t)s * 2048; const float* w1 = AIN(args, 15) + (size_t)s * 2048 * 256; float acc = 0.f;
                for (int k = lane; k < 2048; k += 64) acc += pe[k] * w1[(size_t)k * 256 + j];
                acc = wave_sum(acc); if (lane == 0) ((float*)(ws + WS_BIAS2))[gw] = acc + AIN(args, 16)[gw]; }
            const float* x = AIN(args, 0);
            for (size_t i = (size_t)bx * NTHR + tid; i < (size_t)T * D / 8; i += (size_t)G * NTHR) { const f32x4 a0 = *((const f32x4*)x + 2 * i), a1 = *((const f32x4*)x + 2 * i + 1);
                *((v4u*)HB + i) = (v4u){cvt_pk_bf16(a0.x, a0.y), cvt_pk_bf16(a0.z, a0.w), cvt_pk_bf16(a1.x, a1.y), cvt_pk_bf16(a1.z, a1.w)}; }
        } break;
        case PT_UP: {
            Gemm g = make_gemm(HB, (const bf16*)(ws + WS_WUP + wi * UPW_BYTES), T, NUP, D); StaticOrder S; S.init(T, NUP, G, bx);
            EpiSwiGLU E{(bf16*)(ws + WS_U), FFN, PSc, VEC + VEC_UP + wi * 11264, VEC + VEC_UP + wi * 11264 + 5632};
            gemm_phase<EpiSwiGLU, StaticOrder>(lds, g, S, E, wave);
        } break;
        case PT_DOWN: {
            Gemm g = make_gemm((const bf16*)(ws + WS_U), (const bf16*)(ws + WS_WDN + wi * DNW_BYTES), T, D, FFN); StaticOrder S; S.init(T, D, G, bx);
            EpiResid E{dc > 0 ? Y : AIN(args, 0), Y, HB, PSc, PSn, lng, lnb, ALPHA, 0.5f, (layer == 3 && pos == 6) ? 1 : 0};
            gemm_phase<EpiResid, StaticOrder>(lds, g, S, E, wave);
        } break;
        case PT_LN: {
            const float* gg = AIN(args, 2) + (size_t)11 * D; const float* bb = AIN(args, 3) + (size_t)11 * D;
            for (int r = gw; r < T; r += NGW) ln_row(Y + (size_t)r * D, gg, bb, nullptr, nullptr, Y + (size_t)r * D, lane);
        } break;
        case PT_SGUIN: {
            Gemm g = make_gemm(HB, (const bf16*)(ws + WS_WMIXL + (size_t)layer * 8 * MiB), T, SGUH, D); StaticOrder S; S.init(T, SGUH, G, bx);
            EpiSguIn E{(bf16*)(ws + WS_UG), (bf16*)(ws + WS_VT), (float*)(ws + WS_VSTAT), PSc, VEC + VEC_MIX + layer * 8192, VEC + VEC_MIX + layer * 8192 + 4096, lds + STAGE_BYTES};
            gemm_phase<EpiSguIn, StaticOrder>(lds, g, S, E, wave);
        } break;
        case PT_SPATIAL: spatial_phase(args, ws, layer, lds, G, bx, wave, (DUP_A >= 0 && SGUIN_VARIANT && ph <= DUP_B + 1) ? 1 : 0); break;
        case PT_SGUOUT: case PT_WO: {
            const bool sg = type == PT_SGUOUT;
            Gemm g = make_gemm((const bf16*)(ws + (sg ? WS_UG : WS_O)), (const bf16*)(ws + WS_WMIX2L + (size_t)layer * 4 * MiB), T, D, sg ? SGUHALF : D); StaticOrder S; S.init(T, D, G, bx);
            EpiResid E{Y, Y, HB, PSc, PSn, lng, lnb, ALPHA, 1.0f, 0};
            gemm_phase<EpiResid, StaticOrder>(lds, g, S, E, wave);
        } break;
        case PT_KV: {
            Gemm g = make_gemm(HB, (const bf16*)(ws + WS_WKV), T, NKV, D); StaticOrder S; S.init(T, NKV, G, bx);
            EpiKV E{(bf16*)(ws + WS_KV), (bf16*)(ws + WS_VTS), PSc, VEC + VEC_KV, VEC + VEC_KV + 1536};
            gemm_phase<EpiKV, StaticOrder>(lds, g, S, E, wave);
        } break;
        case PT_CMP1: {
            const int half = G / 2, s = bx >= half ? 1 : 0;
            if (bx < 2 * half) {
                Gemm g; g.A = (const bf16*)(ws + WS_KV) + s * 256; g.Bt = (const bf16*)(ws + WS_WC1) + (size_t)s * 256 * 2048; g.M = NCMPROWS; g.N = 256; g.K = 2048;
                g.lda = 16 * NKV; g.a_kstep = NKV * 2; g.a_hstep = 64 * 2; g.a_div = 2; g.a_thi = (long)SEQ * NKV * 2; g.a_tlo = 128 * 2;
                StaticOrder S; S.init(NCMPROWS, 256, half, bx - s * half);
                EpiBf16<1> E{(bf16*)(ws + WS_HID) + (size_t)s * NCMPROWS * 256, 256, (const float*)(ws + WS_BIAS2) + s * 256};
                gemm_phase<EpiBf16<1>, StaticOrder>(lds, g, S, E, wave);
            }
        } break;
        case PT_CMP2: {
            const int half = G / 2, s = bx >= half ? 1 : 0;
            if (bx < 2 * half) {
                Gemm g = make_gemm((const bf16*)(ws + WS_HID) + (size_t)s * NCMPROWS * 256, (const bf16*)(ws + WS_WC2) + (size_t)s * 256 * 256, NCMPROWS, 256, 256);
                StaticOrder S; S.init(NCMPROWS, 256, half, bx - s * half);
                EpiCmp2 E{(bf16*)(ws + (s ? WS_VC : WS_KC)), s};
                gemm_phase<EpiCmp2, StaticOrder>(lds, g, S, E, wave);
            }
        } break;
        case PT_QG: {
            Gemm g = make_gemm(HB, (const bf16*)(ws + WS_WMIXL + (size_t)layer * 8 * MiB), T, NQGP, D); StaticOrder S; S.init(T, NQGP, G, bx);
            EpiQG E{(bf16*)(ws + WS_Q), (float*)(ws + WS_GATES), PSc, VEC + VEC_MIX + layer * 8192, VEC + VEC_MIX + layer * 8192 + 4096};
            gemm_phase<EpiQG, StaticOrder>(lds, g, S, E, wave);
        } break;
        case PT_ATTN: attn_mfma_phase(args, ws, lds, G, bx, wave); break;
        default: break;
        }
        if (ph + 1 < ph_hi) { if (ph == ph_lo) cg::this_grid().sync(); else xcd_barrier((unsigned*)(ws + WS_CTL), xcc, xst, tid == 0); }
#if PROBE_MASK
        if (bx == 0 && tid == 0 && ((PROBE_MASK >> type) & 1)) { unsigned long long* pp = (unsigned long long*)(ws + WS_BIAS2 + 65536); pp[1] += __builtin_amdgcn_s_memrealtime() - pp[0]; }
#endif
    }
#if PROBE_MASK
    __syncthreads();
    if (blockIdx.x == 0 && cur_tid(wave) == 0) { asm volatile("s_waitcnt vmcnt(0)" ::: "memory"); kargs.out[0] += (float)((unsigned long long*)(kargs.ws + WS_BIAS2 + 65536))[1] * 1e-5f; }
#endif
}

extern "C" void kernel_launch(void* const* d_in, const int* in_sizes, int n_in, void* d_out, int out_size, void* d_ws, size_t ws_size, hipStream_t stream) {
    static int grid = 0;
    if (grid == 0) {
        if (n_in != 20 || in_sizes[0] != T * D || out_size != T * D || ws_size < WS_END) { fprintf(stderr, "kernel_launch: unexpected shapes: n_in %d in0 %d out %d ws %zu\n", n_in, n_in > 0 ? in_sizes[0] : -1, out_size, ws_size); grid = -1; return; }
        int dev = 0, cus = 0, per_cu = 0;
        if (hipGetDevice(&dev) != hipSuccess || hipDeviceGetAttribute(&cus, hipDeviceAttributeMultiprocessorCount, dev) != hipSuccess) { grid = -1; return; }
        if (hipFuncSetAttribute((const void*)mega_fwd, hipFuncAttributeMaxDynamicSharedMemorySize, LDS_BYTES) != hipSuccess) { fprintf(stderr, "kernel_launch: hipFuncSetAttribute failed\n"); grid = -1; return; }
        if (hipOccupancyMaxActiveBlocksPerMultiprocessor(&per_cu, (const void*)mega_fwd, NTHR, LDS_BYTES) != hipSuccess || per_cu < 1) { fprintf(stderr, "kernel_launch: occupancy query says %d\n", per_cu); per_cu = 1; }
        (void)hipGetLastError();
        grid = cus * 1;
        if (grid & 1) grid -= 1;
    }
    if (grid < 0) return;
    Args a{};
    for (int i = 0; i < 20; ++i) a.in[i] = (const float*)d_in[i];
    a.out = (float*)d_out; a.ws = (unsigned char*)d_ws;
    if (hipMemsetAsync((char*)d_ws + WS_CTL, 0, CTL_BYTES, stream) != hipSuccess) { fprintf(stderr, "kernel_launch: hipMemsetAsync failed\n"); return; }
#if MK_PER_PHASE
    for (int ph = 0; ph < N_PHASES; ++ph) { a.ph_lo = ph; a.ph_hi = ph + 1; hipLaunchKernelGGL(mega_fwd, dim3(grid), dim3(NTHR), LDS_BYTES, stream, a); }
#else
    a.ph_lo = 0; a.ph_hi = N_RUN;
    void* kargs[] = {&a};
    hipError_t e = hipLaunchCooperativeKernel((const void*)mega_fwd, dim3(grid), dim3(NTHR), kargs, LDS_BYTES, stream);
    if (e != hipSuccess) fprintf(stderr, "kernel_launch: cooperative launch failed: %s (grid %d)\n", hipGetErrorString(e), grid);
#endif
}
```

```cpp
#include <hip/hip_runtime.h>
#include <hip/hip_cooperative_groups.h>
#include <cstdio>
#include <cstdint>
namespace cg = cooperative_groups;

#ifndef MK_PER_PHASE
#define MK_PER_PHASE 0
#endif
#ifndef RESID_ROWS
#define RESID_ROWS 1
#endif
#ifndef SGUIN_VARIANT
#define SGUIN_VARIANT 0
#endif
#ifndef DUP_A
#define DUP_A -1
#define DUP_B -1
#endif
#ifndef PROBE_MASK
#define PROBE_MASK 0
#endif

__device__ __forceinline__ int cur_tid(int wave) { int l = (int)__builtin_amdgcn_mbcnt_hi(~0u, __builtin_amdgcn_mbcnt_lo(~0u, 0u)); asm volatile("" : "+v"(l)); return l + 64 * wave; }
namespace pg8 {
#define PG8_LAS __attribute__((address_space(3)))
typedef unsigned short bf16_t;
typedef short bf16x8 __attribute__((ext_vector_type(8)));
typedef float f32x4 __attribute__((ext_vector_type(4)));
typedef float f32x2 __attribute__((ext_vector_type(2)));
typedef unsigned u32x4 __attribute__((ext_vector_type(4)));
typedef unsigned u32x2 __attribute__((ext_vector_type(2)));
constexpr float QSCALE = 0.125f * 1.4426950408889634f;
constexpr int BM = 256, BK = 64, HALF = 128, HTB = HALF * BK * 2, STAGE_BYTES = 8 * HTB, NXCD = 8, WGM = 4;

__host__ __device__ __forceinline__ int lds_byte(int r, int c) { const int st = (r >> 4) * 2 + (c >> 5), rr = r & 15, cc = c & 31, ob = rr * 64 + cc * 2; return st * 1024 + (ob ^ (((ob >> 9) & 1) << 5)); }
__host__ __device__ __forceinline__ void stage_rc(int b, int& R, int& C) { const int st = b / 1024, sb = b % 1024, swz = sb ^ (((sb >> 9) & 1) << 5); R = (st >> 1) * 16 + swz / 64; C = (st & 1) * 32 + (swz % 64) / 2; }
__host__ __device__ __forceinline__ int perm32(int rho) { const int n = rho >> 4, i = rho & 15; return 8 * (i >> 2) + 4 * n + (i & 3); }

struct Unit { int pm, pn; };
struct Gemm { const bf16_t* A; const bf16_t* Bt; int M, N, K; int lda; long a_kstep, a_hstep; int a_div; long a_thi, a_tlo; };
__device__ __forceinline__ Gemm make_gemm(const bf16_t* A, const bf16_t* Bt, int M, int N, int K) {
    Gemm g; g.A = A; g.Bt = Bt; g.M = M; g.N = N; g.K = K; g.lda = K; g.a_kstep = BK * 2; g.a_hstep = (long)HALF * K * 2; g.a_div = 1; g.a_thi = (long)BM * K * 2; g.a_tlo = 0; return g;
}

struct StaticOrder {
    int nM, nN, nwg, G, c;
    __host__ __device__ void init(int M, int N, int G_, int c_) { nM = M / BM; nN = N / BM; nwg = nM * nN; G = G_; c = c_; }
    __host__ __device__ bool next(int i, Unit& u) const {
        const long L = (long)i * G + c; if (L >= nwg) return false;
        int wgid = (int)L; { const int q = nwg / NXCD, r = nwg % NXCD, xcd = wgid % NXCD, off = wgid / NXCD; wgid = (xcd < r ? xcd * (q + 1) : r * (q + 1) + (xcd - r) * q) + off; }
        const int nig = WGM * nN, gid = wgid / nig, fm = gid * WGM, gsz = (nM - fm) < WGM ? (nM - fm) : WGM;
        u.pm = fm + ((wgid % nig) % gsz); u.pn = (wgid % nig) / gsz; return true;
    }
};

__device__ __forceinline__ unsigned cvt_pk_bf16(float lo, float hi) { unsigned r; asm volatile("v_cvt_pk_bf16_f32 %0, %1, %2" : "=v"(r) : "v"(lo), "v"(hi)); return r; }
__device__ __forceinline__ f32x2 gelu_pk(f32x2 v) {
    const f32x2 av = __builtin_elementwise_abs(v), d = av * 0.2316418882f + 1.0f;
    f32x2 t; t.x = __builtin_amdgcn_rcpf(d.x); t.y = __builtin_amdgcn_rcpf(d.y);
    f32x2 q = t * 0.5307027145f + (-0.7265760135f); q = q * t + 0.7107068705f; q = q * t + (-0.142248368f); q = q * t + 0.127414796f; q = q * t;
    const f32x2 s = (v * v) * (-0.72134752044f);
    f32x2 e; e.x = __builtin_amdgcn_exp2f(s.x); e.y = __builtin_amdgcn_exp2f(s.y);
    const f32x2 m = v * (q * e), r = v - m;
    f32x2 o; o.x = v.x < 0.f ? m.x : r.x; o.y = v.y < 0.f ? m.y : r.y; return o;
}
__device__ __forceinline__ f32x4 gelu4(f32x4 v) { f32x2 a = gelu_pk((f32x2){v[0], v[1]}), b = gelu_pk((f32x2){v[2], v[3]}); return (f32x4){a.x, a.y, b.x, b.y}; }
__device__ __forceinline__ float bf2f(unsigned short b) { return __uint_as_float(((unsigned)b) << 16); }

#define EPI_ZERO_INIT __device__ __forceinline__ void init(f32x4 (&iv)[2][2], const Unit&, int, int, int, int) const { iv[0][0] = iv[0][1] = iv[1][0] = iv[1][1] = (f32x4){0.f, 0.f, 0.f, 0.f}; }
template <int ACT> struct EpiBf16 {
    static constexpr bool PERM = true;
    EPI_ZERO_INIT
    bf16_t* O; int ldc; const float* bias;
    __device__ __forceinline__ void operator()(const f32x4 (&acc)[2][2][4][2], const Unit& u, int wr, int wc, int fr, int fq) const {
        const int row0 = u.pm * BM + wr * 64 + fr; const int col0 = u.pn * BM + wc * 32 + 8 * fq;
        f32x4 bv[2][2];
#pragma unroll
        for (int bj = 0; bj < 2; ++bj)
#pragma unroll
            for (int n = 0; n < 2; ++n) bv[bj][n] = bias ? *(const f32x4*)(bias + col0 + bj * HALF + 4 * n) : (f32x4){0.f, 0.f, 0.f, 0.f};
#pragma unroll
        for (int ai = 0; ai < 2; ++ai)
#pragma unroll
            for (int m = 0; m < 4; ++m) { bf16_t* rowp = O + (size_t)(row0 + ai * HALF + m * 16) * ldc + col0;
#pragma unroll
                for (int bj = 0; bj < 2; ++bj) { f32x4 v0 = acc[ai][bj][m][0] + bv[bj][0], v1 = acc[ai][bj][m][1] + bv[bj][1];
                    if (ACT == 1) { v0 = gelu4(v0); v1 = gelu4(v1); }
                    u32x4 w; w.x = cvt_pk_bf16(v0[0], v0[1]); w.y = cvt_pk_bf16(v0[2], v0[3]); w.z = cvt_pk_bf16(v1[0], v1[1]); w.w = cvt_pk_bf16(v1[2], v1[3]);
                    *(u32x4*)(rowp + bj * HALF) = w; } }
    }
};
__device__ __forceinline__ void row_stats4(const float* PS, int rowa, int fq, float (&mu)[4], float (&rs)[4]) {
    f32x4 a[4], b[4];
#pragma unroll
    for (int r = 0; r < 4; ++r) { const f32x4* p = (const f32x4*)(PS + (size_t)(rowa + r * 16) * 32 + fq * 8); a[r] = p[0]; b[r] = p[1]; }
#pragma unroll
    for (int r = 0; r < 4; ++r) { float s = (a[r].x + a[r].z) + (b[r].x + b[r].z), q = (a[r].y + a[r].w) + (b[r].y + b[r].w);
        s += __shfl_xor(s, 16); s += __shfl_xor(s, 32); q += __shfl_xor(q, 16); q += __shfl_xor(q, 32);
        mu[r] = s * (1.f / 1024.f); rs[r] = __builtin_amdgcn_rsqf(fmaxf(q * (1.f / 1024.f) - mu[r] * mu[r], 0.f) + 1e-5f); }
}
__device__ __forceinline__ void row_stats8(const float* PS, int row0, int fq, float (&mu)[8], float (&rs)[8]) {
    float m0[4], r0[4], m1[4], r1[4]; row_stats4(PS, row0, fq, m0, r0); row_stats4(PS, row0 + HALF, fq, m1, r1);
#pragma unroll
    for (int r = 0; r < 4; ++r) { mu[r] = m0[r]; rs[r] = r0[r]; mu[4 + r] = m1[r]; rs[4 + r] = r1[r]; }
}
struct EpiSwiGLU {
    static constexpr bool PERM = false;
    EPI_ZERO_INIT
    bf16_t* U; int ldc; const float* PS; const float* GW; const float* BW;
    __device__ __forceinline__ void operator()(const f32x4 (&acc)[2][2][4][2], const Unit& u, int wr, int wc, int fr, int fq) const {
        const int row0 = u.pm * BM + wr * 64 + fr;
        float mu[8], rs[8]; f32x4 gwa[2], gwb[2], bwa[2], bwb[2];
        if (PS) { row_stats8(PS, row0, fq, mu, rs);
#pragma unroll
            for (int bj = 0; bj < 2; ++bj) { const int c = (u.pn * 8 + bj * 4 + wc) * 32 + 4 * fq; gwa[bj] = *(const f32x4*)(GW + c); gwb[bj] = *(const f32x4*)(GW + c + 16); bwa[bj] = *(const f32x4*)(BW + c); bwb[bj] = *(const f32x4*)(BW + c + 16); } }
#pragma unroll
        for (int ai = 0; ai < 2; ++ai)
#pragma unroll
            for (int m = 0; m < 4; ++m) { const int row = row0 + ai * HALF + m * 16; bf16_t* rowp = U + (size_t)row * ldc;
#pragma unroll
                for (int bj = 0; bj < 2; ++bj) { const int G32 = u.pn * 8 + bj * 4 + wc; f32x4 a = acc[ai][bj][m][0], b = acc[ai][bj][m][1]; f32x4 o;
                    if (PS) { a = (a - mu[ai * 4 + m] * gwa[bj]) * rs[ai * 4 + m] + bwa[bj]; b = (b - mu[ai * 4 + m] * gwb[bj]) * rs[ai * 4 + m] + bwb[bj]; }
#pragma unroll
                    for (int j = 0; j < 4; ++j) { const float e = __builtin_amdgcn_exp2f(a[j] * -1.44269504089f); o[j] = a[j] * __builtin_amdgcn_rcpf(1.0f + e) * b[j]; }
                    u32x2 w; w.x = cvt_pk_bf16(o[0], o[1]); w.y = cvt_pk_bf16(o[2], o[3]);
                    *(u32x2*)(rowp + G32 * 16 + fq * 4) = w; } }
    }
};
struct EpiResid {
    static constexpr bool PERM = false;
    const float* Yin; float* Yout; bf16_t* YB; const float* PSin; float* PSout; const float* g; const float* b; float alpha, scale; int last;
    __device__ __forceinline__ void init(f32x4 (&iv)[2][2], const Unit& u, int wr, int wc, int fr, int fq) const {
        const int col0 = u.pn * BM + wc * 32 + 4 * fq; const float k = alpha / scale;
#pragma unroll
        for (int bj = 0; bj < 2; ++bj)
#pragma unroll
            for (int n = 0; n < 2; ++n) iv[bj][n] = PSin ? *(const f32x4*)(b + col0 + bj * HALF + n * 16) * k : (f32x4){0.f, 0.f, 0.f, 0.f};
    }
    __device__ __forceinline__ void operator()(const f32x4 (&acc)[2][2][4][2], const Unit& u, int wr, int wc, int fr, int fq) const {
        const int row0 = u.pm * BM + wr * 64 + fr, col0 = u.pn * BM + wc * 32 + 4 * fq;
        f32x4 gv[2][2];
#pragma unroll
        for (int bj = 0; bj < 2; ++bj)
#pragma unroll
            for (int n = 0; n < 2; ++n) gv[bj][n] = PSin ? *(const f32x4*)(g + col0 + bj * HALF + n * 16) : (f32x4){1.f, 1.f, 1.f, 1.f};
        const unsigned e0 = (unsigned)row0 * 1024u + (unsigned)col0;
#pragma unroll
        for (int ai = 0; ai < 2; ++ai) {
#pragma unroll
            for (int mp = 0; mp < 2; ++mp) {
                f32x4 y[2][2][2]; f32x4 sa[2], sb[2];
                if (PSin) {
#pragma unroll
                    for (int mm = 0; mm < 2; ++mm) { const f32x4* p = (const f32x4*)(PSin + (size_t)(row0 + ai * HALF + (mp * 2 + mm) * 16) * 32 + fq * 8); sa[mm] = p[0]; sb[mm] = p[1]; } }
#pragma unroll
                for (int mm = 0; mm < 2; ++mm)
#pragma unroll
                    for (int bj = 0; bj < 2; ++bj)
#pragma unroll
                        for (int n = 0; n < 2; ++n) y[mm][bj][n] = *(const f32x4*)((const char*)Yin + (size_t)((e0 + (unsigned)(ai * HALF + (mp * 2 + mm) * 16) * 1024u + bj * HALF + n * 16) * 4u));
#pragma unroll
                for (int mm = 0; mm < 2; ++mm) { const int m = mp * 2 + mm; const unsigned er = e0 + (unsigned)(ai * HALF + m * 16) * 1024u;
                    float mu_ = 0.f, rs_ = 1.f;
                    if (PSin) { float s1 = (sa[mm].x + sa[mm].z) + (sb[mm].x + sb[mm].z), q1 = (sa[mm].y + sa[mm].w) + (sb[mm].y + sb[mm].w);
                        s1 += __shfl_xor(s1, 16); s1 += __shfl_xor(s1, 32); q1 += __shfl_xor(q1, 16); q1 += __shfl_xor(q1, 32);
                        mu_ = s1 * (1.f / 1024.f); rs_ = __builtin_amdgcn_rsqf(fmaxf(q1 * (1.f / 1024.f) - mu_ * mu_, 0.f) + 1e-5f); }
                    float s = 0.f, q = 0.f;
#pragma unroll
                    for (int bj = 0; bj < 2; ++bj)
#pragma unroll
                        for (int n = 0; n < 2; ++n) { const unsigned e = er + bj * HALF + n * 16; f32x4 v = y[mm][bj][n];
                            if (PSin) v = (v - mu_) * rs_ * gv[bj][n];
                            v = v * alpha + acc[ai][bj][m][n] * scale;
                            *(f32x4*)((char*)Yout + (size_t)(e * 4u)) = v;
                            if (!last) { u32x2 w; w.x = cvt_pk_bf16(v[0], v[1]); w.y = cvt_pk_bf16(v[2], v[3]); *(u32x2*)((char*)YB + (size_t)(e * 2u)) = w; }
                            s += (v[0] + v[1]) + (v[2] + v[3]); q += (v[0] * v[0] + v[1] * v[1]) + (v[2] * v[2] + v[3] * v[3]); }
                    s += __shfl_xor(s, 16); s += __shfl_xor(s, 32); q += __shfl_xor(q, 16); q += __shfl_xor(q, 32);
                    if (fq == 0 && !last) *(f32x2*)(PSout + (size_t)(row0 + ai * HALF + m * 16) * 32 + (u.pn * 4 + wc) * 2) = (f32x2){s, q}; }
                } }
    }
};
struct EpiSguIn {
    static constexpr bool PERM = false;
    EPI_ZERO_INIT
    bf16_t* UG; bf16_t* VT; float* VSTAT; const float* PS; const float* GW; const float* BW; PG8_LAS unsigned char* xscr;
    __device__ __forceinline__ void operator()(const f32x4 (&acc)[2][2][4][2], const Unit& u, int wr, int wc, int fr, int fq) const {
        const int row0 = u.pm * BM + wr * 64 + fr, col0 = u.pn * BM + wc * 32 + 4 * fq;
        PG8_LAS bf16_t* xs = (PG8_LAS bf16_t*)(xscr + (wr * 4 + wc) * 2048);
        const int lane = fq * 16 + fr;
#pragma unroll
        for (int ai = 0; ai < 2; ++ai) {
            float mu[4], rs[4], sa[4], qa[4];
#pragma unroll
            for (int r = 0; r < 4; ++r) { sa[r] = 0.f; qa[r] = 0.f; }
            row_stats4(PS, row0 + ai * HALF, fq, mu, rs);
            f32x4 gnx = *(const f32x4*)(GW + col0), bnx = *(const f32x4*)(BW + col0);
#pragma unroll
            for (int bj = 0; bj < 2; ++bj)
#pragma unroll
                for (int n = 0; n < 2; ++n) { const int col = col0 + bj * HALF + n * 16;
                    const f32x4 gv = gnx, bv = bnx;
                    if (bj * 2 + n < 3) { const int cn = col0 + ((bj * 2 + n + 1) >> 1) * HALF + ((bj * 2 + n + 1) & 1) * 16; gnx = *(const f32x4*)(GW + cn); bnx = *(const f32x4*)(BW + cn); }
#pragma unroll
                    for (int m = 0; m < 4; ++m) { const int row = row0 + ai * HALF + m * 16;
                        const f32x4 v = gelu4((acc[ai][bj][m][n] - mu[m] * gv) * rs[m] + bv);
                        const unsigned w0 = cvt_pk_bf16(v[0], v[1]), w1 = cvt_pk_bf16(v[2], v[3]);
                        if (u.pn < 8) { u32x2 w; w.x = w0; w.y = w1; *(u32x2*)(UG + (size_t)row * 2048 + col) = w; }
                        else { const unsigned short h0 = (unsigned short)(w0 & 0xffff), h1 = (unsigned short)(w0 >> 16), h2 = (unsigned short)(w1 & 0xffff), h3 = (unsigned short)(w1 >> 16);
                            PG8_LAS bf16_t* p = xs + (4 * fq) * 64 + m * 16 + fr; p[0] = h0; p[64] = h1; p[128] = h2; p[192] = h3;
                            const float f0 = bf2f(h0), f1 = bf2f(h1), f2 = bf2f(h2), f3 = bf2f(h3);
                            sa[m] += (f0 + f1) + (f2 + f3); qa[m] += (f0 * f0 + f1 * f1) + (f2 * f2 + f3 * f3); } }
                    if (u.pn >= 8) {
                        const int rowbase = u.pm * BM + ai * HALF + wr * 64, cvb = (u.pn - 8) * BM + bj * HALF + wc * 32 + n * 16;
#pragma unroll
                        for (int k = 0; k < 2; ++k) { const int ch = lane + 64 * k, cc = ch >> 3, part = ch & 7;
                            const u32x4 d = *(const PG8_LAS u32x4*)(xs + cc * 64 + part * 8);
                            *(u32x4*)(VT + (size_t)(rowbase >> 7) * (2048 * 128) + (size_t)(cvb + cc) * 128 + (rowbase & 127) + part * 8) = d; } }
                    }
            if (u.pn >= 8) {
#pragma unroll
                for (int r = 0; r < 4; ++r) { float s = sa[r], q = qa[r];
                    s += __shfl_xor(s, 16); s += __shfl_xor(s, 32); q += __shfl_xor(q, 16); q += __shfl_xor(q, 32);
                    if (fq == 0) *(f32x2*)(VSTAT + ((size_t)(row0 + ai * HALF + r * 16) * 32 + (u.pn - 8) * 4 + wc) * 2) = (f32x2){s, q}; } }
        }
    }
};
struct EpiCmp2 {
    static constexpr bool PERM = false;
    EPI_ZERO_INIT
    bf16_t* KC; int tr;
    __device__ __forceinline__ void operator()(const f32x4 (&acc)[2][2][4][2], const Unit& u, int wr, int wc, int fr, int fq) const {
        if (u.pn != 0 || wc >= 2) return;
        const int row0 = u.pm * BM + wr * 64 + fr, col0 = wc * 32 + 4 * fq;
#pragma unroll
        for (int ai = 0; ai < 2; ++ai)
#pragma unroll
            for (int m = 0; m < 4; ++m) { const int row = row0 + ai * HALF + m * 16; const bool z = (row & 127) == 127;
#pragma unroll
                for (int n = 0; n < 2; ++n) { const f32x4 v = acc[ai][0][m][n]; u32x2 w; w.x = cvt_pk_bf16(v[0], v[1]); w.y = cvt_pk_bf16(v[2], v[3]); if (z) { w.x = 0u; w.y = 0u; }
                    if (!tr) *(u32x2*)(KC + (size_t)row * 64 + col0 + n * 16) = w;
                    else { bf16_t* p = KC + ((size_t)(row >> 7) * 64 + col0 + n * 16) * 128 + (row & 127);
                        p[0] = (bf16_t)(w.x & 0xffff); p[128] = (bf16_t)(w.x >> 16); p[256] = (bf16_t)(w.y & 0xffff); p[384] = (bf16_t)(w.y >> 16); } } }
    }
};
struct EpiKV {
    static constexpr bool PERM = false;
    EPI_ZERO_INIT
    bf16_t* KV; bf16_t* VT; const float* PS; const float* GW; const float* BW;
    __device__ __forceinline__ void operator()(const f32x4 (&acc)[2][2][4][2], const Unit& u, int wr, int wc, int fr, int fq) const {
        const int row0 = u.pm * BM + wr * 64 + fr, c0 = wc * 32 + 4 * fq;
        const bool tr = (u.pn == 3 || u.pn == 5);
        float mu[8], rs[8]; f32x4 gv[2][2], bv[2][2];
        row_stats8(PS, row0, fq, mu, rs);
#pragma unroll
        for (int bj = 0; bj < 2; ++bj)
#pragma unroll
            for (int n = 0; n < 2; ++n) { gv[bj][n] = *(const f32x4*)(GW + u.pn * 256 + c0 + bj * HALF + n * 16); bv[bj][n] = *(const f32x4*)(BW + u.pn * 256 + c0 + bj * HALF + n * 16); }
#pragma unroll
        for (int ai = 0; ai < 2; ++ai)
#pragma unroll
            for (int m = 0; m < 4; ++m) { const int row = row0 + ai * HALF + m * 16;
#pragma unroll
                for (int bj = 0; bj < 2; ++bj)
#pragma unroll
                    for (int n = 0; n < 2; ++n) { const int c = c0 + bj * HALF + n * 16;
                        const f32x4 v = (acc[ai][bj][m][n] - mu[ai * 4 + m] * gv[bj][n]) * rs[ai * 4 + m] + bv[bj][n];
                        u32x2 w; w.x = cvt_pk_bf16(v[0], v[1]); w.y = cvt_pk_bf16(v[2], v[3]);
                        if (!tr) *(u32x2*)(KV + (size_t)row * 1536 + u.pn * 256 + c) = w;
                        else { bf16_t* p = VT + (size_t)((u.pn - 3) >> 1) * ((size_t)65536 * 256) + ((size_t)((row >> 11) * 4 + (c >> 6)) * 64 + (c & 63)) * 2048 + (row & 2047);
                            p[0] = (bf16_t)(w.x & 0xffff); p[2048] = (bf16_t)(w.x >> 16); p[4096] = (bf16_t)(w.y & 0xffff); p[6144] = (bf16_t)(w.y >> 16); } } }
    }
};
struct EpiQG {
    static constexpr bool PERM = false;
    EPI_ZERO_INIT
    bf16_t* Q; float* GATES; const float* PS; const float* GW; const float* BW;
    __device__ __forceinline__ void operator()(const f32x4 (&acc)[2][2][4][2], const Unit& u, int wr, int wc, int fr, int fq) const {
        const int row0 = u.pm * BM + wr * 64 + fr, col0 = u.pn * BM + wc * 32 + 4 * fq;
        float mu[8], rs[8]; f32x4 gv[2][2], bv[2][2];
        row_stats8(PS, row0, fq, mu, rs);
#pragma unroll
        for (int bj = 0; bj < 2; ++bj)
#pragma unroll
            for (int n = 0; n < 2; ++n) { gv[bj][n] = *(const f32x4*)(GW + col0 + bj * HALF + n * 16); bv[bj][n] = *(const f32x4*)(BW + col0 + bj * HALF + n * 16); }
#pragma unroll
        for (int ai = 0; ai < 2; ++ai)
#pragma unroll
            for (int m = 0; m < 4; ++m) { const int row = row0 + ai * HALF + m * 16;
#pragma unroll
                for (int bj = 0; bj < 2; ++bj)
#pragma unroll
                    for (int n = 0; n < 2; ++n) { const int col = col0 + bj * HALF + n * 16; const f32x4 v = (acc[ai][bj][m][n] - mu[ai * 4 + m] * gv[bj][n]) * rs[ai * 4 + m] + bv[bj][n];
                        if (u.pn < 4) { u32x2 w; w.x = cvt_pk_bf16(v[0] * QSCALE, v[1] * QSCALE); w.y = cvt_pk_bf16(v[2] * QSCALE, v[3] * QSCALE); *(u32x2*)(Q + (size_t)row * 1024 + col) = w; }
                        else if (col < 1072) { f32x4 o;
#pragma unroll
                            for (int j = 0; j < 4; ++j) o[j] = __builtin_amdgcn_rcpf(1.0f + __builtin_amdgcn_exp2f(v[j] * -1.44269504089f));
                            *(f32x4*)(GATES + (size_t)row * 48 + (col - 1024)) = o; } } }
    }
};

template <class Epi, class Sched, bool ALIGN_EPI = true>
__device__ __forceinline__ void gemm_phase(PG8_LAS unsigned char* lds, const Gemm g, const Sched& S, const Epi& E, int wave_id) {
    const int tid = cur_tid(wave_id);
    const int wid = wave_id, lane = tid & 63, wr = wid >> 2, wc = wid & 3, fr = lane & 15, fq = lane >> 4;
    const int K = g.K, nt = K / BK;
    unsigned voffA[2], voffB[2];
#pragma unroll
    for (int i = 0; i < 2; ++i) { int R, C; stage_rc(tid * 16 + i * 8192, R, C); const int Rb = Epi::PERM ? ((R & ~31) + perm32(R & 31)) : R;
        voffA[i] = (unsigned)(R * g.lda + C) * 2u; voffB[i] = (unsigned)(Rb * K + C) * 2u; }
    const size_t kstepB = (size_t)(BK * 2), hstepB = (size_t)HALF * K * 2, tstepB = 2 * hstepB;
    const size_t kstepA = (size_t)g.a_kstep, hstepA = (size_t)g.a_hstep;
    const unsigned ldsw = (unsigned)wid * 1024u;
    const int aoff = lds_byte(wr * 64 + fr, fq * 8), boff = lds_byte(wc * 32 + fr, fq * 8);
#define PG8_ABASE(pm) ((const char*)g.A + (size_t)((pm) / g.a_div) * (size_t)g.a_thi + (size_t)((pm) % g.a_div) * (size_t)g.a_tlo)
#define PG8_SA(b, h) (((b) * 2 + (h)) * HTB)
#define PG8_SB(b, h) ((4 + (b) * 2 + (h)) * HTB)
#define PG8_STAGE(bufoff, gbase, voff) do { _Pragma("unroll") for (int _i = 0; _i < 2; ++_i) \
        __builtin_amdgcn_global_load_lds((const unsigned*)((const char*)(gbase) + (voff)[_i]), (PG8_LAS unsigned*)(lds + (bufoff) + ldsw + _i * 8192), 16, 0, 0); } while (0)
#define PG8_LDA(dst, b, h) do { _Pragma("unroll") for (int m = 0; m < 4; ++m) _Pragma("unroll") for (int k = 0; k < 2; ++k) dst[m][k] = *(const PG8_LAS bf16x8*)(lds + PG8_SA(b, h) + aoff + m * 2048 + k * 1024); } while (0)
#define PG8_LDB(dst, b, h) do { _Pragma("unroll") for (int n = 0; n < 2; ++n) _Pragma("unroll") for (int k = 0; k < 2; ++k) dst[n][k] = *(const PG8_LAS bf16x8*)(lds + PG8_SB(b, h) + boff + n * 2048 + k * 1024); } while (0)
#define PG8_MMA(ai, bj, At, Bt) do { __builtin_amdgcn_s_setprio(1); _Pragma("unroll") for (int m = 0; m < 4; ++m) _Pragma("unroll") for (int n = 0; n < 2; ++n) _Pragma("unroll") for (int k = 0; k < 2; ++k) \
        acc[ai][bj][m][n] = __builtin_amdgcn_mfma_f32_16x16x32_bf16(Bt[n][k], At[m][k], acc[ai][bj][m][n], 0, 0, 0); __builtin_amdgcn_s_setprio(0); } while (0)
#define PG8_WAIT_V(n) asm volatile("s_waitcnt vmcnt(" #n ")" ::: "memory")
#define PG8_WAIT_L(n) asm volatile("s_waitcnt lgkmcnt(" #n ")" ::: "memory")
#define PG8_BAR __builtin_amdgcn_s_barrier()
#define PG8_SCHED __builtin_amdgcn_sched_barrier(0)
    Unit cur, nxt; int ui = 0;
    if (!S.next(0, cur)) return;
    f32x4 acc[2][2][4][2];
#define PG8_ACC_INIT(un) do { f32x4 iv_[2][2]; E.init(iv_, un, wr, wc, fr, fq); _Pragma("unroll") for (int a = 0; a < 2; ++a) _Pragma("unroll") for (int b = 0; b < 2; ++b) _Pragma("unroll") for (int m = 0; m < 4; ++m) _Pragma("unroll") for (int n = 0; n < 2; ++n) acc[a][b][m][n] = iv_[b][n]; } while (0)
    PG8_ACC_INIT(cur);
    bf16x8 At[4][2], B0[2][2], B1[2][2];
    const char* cA = PG8_ABASE(cur.pm); const char* cB = (const char*)g.Bt + (size_t)cur.pn * tstepB;
    PG8_STAGE(PG8_SB(0, 0), cB, voffB); PG8_STAGE(PG8_SB(0, 1), cB + hstepB, voffB); PG8_STAGE(PG8_SA(0, 0), cA, voffA); PG8_STAGE(PG8_SA(0, 1), cA + hstepA, voffA);
    if (wr == 1) PG8_BAR;
    PG8_WAIT_V(2); PG8_BAR;
    PG8_STAGE(PG8_SB(1, 0), cB + kstepB, voffB); PG8_STAGE(PG8_SA(1, 0), cA + kstepA, voffA); PG8_STAGE(PG8_SB(1, 1), cB + hstepB + kstepB, voffB);
    PG8_WAIT_V(6); PG8_BAR;
    for (;;) {
        const bool has_next = S.next(ui + 1, nxt);
        const char* nA = has_next ? PG8_ABASE(nxt.pm) : cA; const char* nB = has_next ? (const char*)g.Bt + (size_t)nxt.pn * tstepB : cB;
        for (int t = 0; t < nt; t += 2) {
            const bool last = (t == nt - 2);
            const char* a1 = cA + (size_t)(t + 1) * kstepA;
            const char* a2 = last ? nA : cA + (size_t)(t + 2) * kstepA; const char* b2 = last ? nB : cB + (size_t)(t + 2) * kstepB;
            const char* a3 = a2 + kstepA; const char* b3 = b2 + kstepB;
            PG8_LDB(B0, 0, 0); PG8_LDB(B1, 0, 1); PG8_SCHED; PG8_LDA(At, 0, 0); PG8_STAGE(PG8_SA(1, 1), a1 + hstepA, voffA);
            PG8_WAIT_V(8); PG8_WAIT_L(0); PG8_BAR; PG8_MMA(0, 0, At, B0); PG8_MMA(0, 1, At, B1); PG8_BAR; PG8_SCHED;
            PG8_LDA(At, 0, 1); PG8_STAGE(PG8_SB(0, 0), b2, voffB); PG8_STAGE(PG8_SB(0, 1), b2 + hstepB, voffB); PG8_STAGE(PG8_SA(0, 0), a2, voffA);
            PG8_WAIT_V(8); PG8_WAIT_L(0); PG8_BAR; PG8_MMA(1, 0, At, B0); PG8_MMA(1, 1, At, B1); PG8_BAR; PG8_SCHED;
            PG8_LDB(B0, 1, 0); PG8_LDB(B1, 1, 1); PG8_SCHED; PG8_LDA(At, 1, 0); PG8_STAGE(PG8_SA(0, 1), a2 + hstepA, voffA);
            PG8_WAIT_V(8); PG8_WAIT_L(0); PG8_BAR; PG8_MMA(0, 0, At, B0); PG8_MMA(0, 1, At, B1); PG8_BAR; PG8_SCHED;
            PG8_LDA(At, 1, 1); PG8_STAGE(PG8_SB(1, 0), b3, voffB); PG8_STAGE(PG8_SB(1, 1), b3 + hstepB, voffB); PG8_STAGE(PG8_SA(1, 0), a3, voffA);
            PG8_WAIT_V(8); PG8_WAIT_L(0); PG8_BAR; PG8_MMA(1, 0, At, B0); PG8_MMA(1, 1, At, B1); PG8_BAR; PG8_SCHED;
        }
        if constexpr (ALIGN_EPI) { if (wr == 0) PG8_BAR; }
        E(acc, cur, wr, wc, fr, fq);
        if (!has_next) break;
        cur = nxt; cA = nA; cB = nB; ++ui;
        PG8_ACC_INIT(cur);
        if constexpr (ALIGN_EPI) { if (wr == 1) PG8_BAR; }
    }
    PG8_WAIT_V(0);
    if constexpr (!ALIGN_EPI) { if (wr == 0) PG8_BAR; }
    PG8_BAR;
#undef PG8_ACC_INIT
#undef PG8_ABASE
#undef PG8_SA
#undef PG8_SB
#undef PG8_STAGE
#undef PG8_LDA
#undef PG8_LDB
#undef PG8_MMA
#undef PG8_WAIT_V
#undef PG8_WAIT_L
#undef PG8_BAR
#undef PG8_SCHED
}
}

#define LAS __attribute__((address_space(3)))
typedef unsigned short bf16;
typedef unsigned v4u __attribute__((ext_vector_type(4)));
typedef unsigned v2u __attribute__((ext_vector_type(2)));
typedef float f32x4 __attribute__((ext_vector_type(4)));
typedef float f32x2 __attribute__((ext_vector_type(2)));
constexpr int NWAVES = 8, NTHR = 512;
constexpr int BATCH = 32, SEQ = 2048, D = 1024, T = BATCH * SEQ, FFN = 2816, NUP = 2 * FFN, SGUH = 4096, SGUHALF = 2048;
constexpr int NKV = 1536, NQG = 1072, NQGP = 1280, NCMPROWS = 16384;
constexpr float ALPHA = 1.681792830507429f, LN_EPS = 1e-5f, NEGF = -1e30f;
constexpr size_t MiB = 1u << 20;
constexpr size_t WS_VEC = 0, WS_WUP = 1 * MiB  , WS_WDN = 89 * MiB  , WS_WMIXL = 133 * MiB  , WS_WMIX2L = 165 * MiB  ;
constexpr size_t WS_WKV = 181 * MiB, WS_WC1 = 184 * MiB, WS_WC2 = 186 * MiB, WS_BIAS2 = 187 * MiB, WS_PS = 188 * MiB  , WS_VSTAT = 204 * MiB;
constexpr size_t WS_HB = 220 * MiB  , WS_SCR = 348 * MiB;
constexpr size_t WS_U = WS_SCR, WS_UG = WS_SCR, WS_VT = WS_SCR + 256 * MiB, WS_Q = WS_SCR, WS_O = WS_SCR + 128 * MiB, WS_GATES = WS_SCR + 256 * MiB;
constexpr size_t WS_KV = 700 * MiB, WS_KC = 892 * MiB, WS_VC = 894 * MiB, WS_HID = 896 * MiB, WS_VTS = 912 * MiB  , WS_END = 976 * MiB;
constexpr size_t UPW_BYTES = 11 * MiB, DNW_BYTES = (size_t)D * FFN * 2, PS_BYTES = 8 * MiB;
constexpr int VEC_UP = 0  , VEC_MIX = 8 * 11264  , VEC_KV = VEC_MIX + 4 * 8192  ;
constexpr int LDS_BYTES = 147456 + 64;
constexpr size_t WS_CTL = 187 * MiB + 512 * 1024, CTL_BYTES = 16384;

__device__ __forceinline__ unsigned f2bf(float f) { unsigned u = __builtin_bit_cast(unsigned, f); return (u + 0x7fffu + ((u >> 16) & 1u)) >> 16; }
__device__ __forceinline__ unsigned pk2(float lo, float hi) { return f2bf(lo) | (f2bf(hi) << 16); }
__device__ __forceinline__ float bflo(unsigned w) { return __uint_as_float(w << 16); }
__device__ __forceinline__ float bfhi(unsigned w) { return __uint_as_float(w & 0xffff0000u); }
__device__ __forceinline__ float wave_sum(float v) {
#pragma unroll
    for (int o = 1; o < 64; o <<= 1) v += __shfl_xor(v, o);
    return v;
}
#define LDS_WAIT() asm volatile("s_waitcnt lgkmcnt(0)" ::: "memory")

__device__ __forceinline__ int rowmap(int n, int mode) { return mode == 0 ? n : (32 * (n >> 4) + (n & 15) + (mode == 2 ? 16 : 0)); }
__device__ __forceinline__ void transpose_item(const float* W, int K, int N, bf16* WT, int mode, LAS float* scr, int item, int lane) {
    const int nblk = (N + 31) / 32, kb = item / nblk, nb = item % nblk, k0 = 64 * kb, n0 = 32 * nb;
    const bool nok = (n0 + (lane & 31)) < N;
    { const int nn = (lane & 7) * 4; const bool ok4 = (n0 + nn) < N;
#pragma unroll
      for (int i = 0; i < 8; ++i) { const int kk = 8 * i + (lane >> 3); f32x4 v = (f32x4){0.f, 0.f, 0.f, 0.f}; if (ok4) v = *(const f32x4*)(W + (size_t)(k0 + kk) * N + n0 + nn);
          LAS float* d = scr + kk * 33 + nn; d[0] = v.x; d[1] = v.y; d[2] = v.z; d[3] = v.w; } }
    LDS_WAIT(); asm volatile("" ::: "memory");
    const int c = lane & 7;
#pragma unroll
    for (int j = 0; j < 4; ++j) { const int n = (lane >> 3) + 8 * j; const LAS float* s = scr + (8 * c) * 33 + n;
        v4u o; o.x = pk2(s[0 * 33], s[1 * 33]); o.y = pk2(s[2 * 33], s[3 * 33]); o.z = pk2(s[4 * 33], s[5 * 33]); o.w = pk2(s[6 * 33], s[7 * 33]);
        if (n0 + n < N) *(v4u*)(WT + (size_t)rowmap(n0 + n, mode) * K + k0 + 8 * c) = o; }
    LDS_WAIT(); asm volatile("" ::: "memory");
}
struct Args { const float* in[20]; float* out; unsigned char* ws; int ph_lo, ph_hi; };
typedef const __attribute__((address_space(4))) unsigned long long* ArgP;
#define AIN(a, i) ((const float*)(const __attribute__((address_space(1))) float*)(a)[(i)])

__device__ __forceinline__ void fold_item(const float* W, int K, int N, bf16* WT, int mode, const float* g, const float* b, float* GW, float* BW, LAS float* scr, int nb, int lane) {
    const int n0 = 32 * nb; const bool nok = (n0 + (lane & 31)) < N; const int c = lane & 7;
    float gs[4] = {0.f, 0.f, 0.f, 0.f}, bs[4] = {0.f, 0.f, 0.f, 0.f};
    for (int k0 = 0; k0 < K; k0 += 64) {
        { const int nn = (lane & 7) * 4; const bool ok4 = (n0 + nn) < N;
#pragma unroll
          for (int i = 0; i < 8; ++i) { const int kk = 8 * i + (lane >> 3); f32x4 v = (f32x4){0.f, 0.f, 0.f, 0.f}; if (ok4) v = *(const f32x4*)(W + (size_t)(k0 + kk) * N + n0 + nn);
              LAS float* d = scr + kk * 33 + nn; d[0] = v.x; d[1] = v.y; d[2] = v.z; d[3] = v.w; } }
        LDS_WAIT(); asm volatile("" ::: "memory");
        f32x4 g0 = (f32x4){1.f, 1.f, 1.f, 1.f}, g1 = g0, b0 = (f32x4){0.f, 0.f, 0.f, 0.f}, b1 = b0;
        if (g) { g0 = *(const f32x4*)(g + k0 + 8 * c); g1 = *(const f32x4*)(g + k0 + 8 * c + 4); b0 = *(const f32x4*)(b + k0 + 8 * c); b1 = *(const f32x4*)(b + k0 + 8 * c + 4); }
#pragma unroll
        for (int j = 0; j < 4; ++j) { const int n = (lane >> 3) + 8 * j; const LAS float* sp = scr + (8 * c) * 33 + n;
            const float w0 = sp[0 * 33], w1 = sp[1 * 33], w2 = sp[2 * 33], w3 = sp[3 * 33], w4 = sp[4 * 33], w5 = sp[5 * 33], w6 = sp[6 * 33], w7 = sp[7 * 33];
            v4u o; o.x = pk2(w0 * g0.x, w1 * g0.y); o.y = pk2(w2 * g0.z, w3 * g0.w); o.z = pk2(w4 * g1.x, w5 * g1.y); o.w = pk2(w6 * g1.z, w7 * g1.w);
            gs[j] += ((bflo(o.x) + bfhi(o.x)) + (bflo(o.y) + bfhi(o.y))) + ((bflo(o.z) + bfhi(o.z)) + (bflo(o.w) + bfhi(o.w)));
            bs[j] += ((w0 * b0.x + w1 * b0.y) + (w2 * b0.z + w3 * b0.w)) + ((w4 * b1.x + w5 * b1.y) + (w6 * b1.z + w7 * b1.w));
            if (n0 + n < N) *(v4u*)(WT + (size_t)rowmap(n0 + n, mode) * K + k0 + 8 * c) = o; }
        LDS_WAIT(); asm volatile("" ::: "memory");
    }
#pragma unroll
    for (int j = 0; j < 4; ++j) { float x = gs[j], y = bs[j];
        x += __shfl_xor(x, 1); x += __shfl_xor(x, 2); x += __shfl_xor(x, 4); y += __shfl_xor(y, 1); y += __shfl_xor(y, 2); y += __shfl_xor(y, 4);
        const int n = (lane >> 3) + 8 * j; if (c == 0 && n0 + n < N) { GW[rowmap(n0 + n, mode)] = x; BW[rowmap(n0 + n, mode)] = y; } }
}
__device__ __forceinline__ void get_mat(ArgP a, unsigned char* ws, int cs, int mi, const float*& W, int& K, int& N, bf16*& WT, int& mode, int& fold, const float*& gam, const float*& bet, float*& GW, float*& BW) {
    mode = 0; fold = 0; gam = nullptr; bet = nullptr; GW = nullptr; BW = nullptr; float* vec = (float*)(ws + WS_VEC);
    if (cs < 4) {
        if (mi < 6) { const int sb = mi / 3, k = mi % 3; const size_t wi = (size_t)(cs * 2 + sb);
            if (k < 2) { W = AIN(a, 4 + k) + wi * D * FFN; K = D; N = FFN; WT = (bf16*)(ws + WS_WUP + wi * UPW_BYTES); mode = 1 + k; fold = 1;
                const int li = sb ? cs * 3 + 1 : cs * 3 - 1;
                if (li >= 0) { gam = AIN(a, 2) + (size_t)li * D; bet = AIN(a, 3) + (size_t)li * D; }
                GW = vec + VEC_UP + wi * 11264; BW = GW + 5632; }
            else { W = AIN(a, 6) + wi * FFN * D; K = FFN; N = D; WT = (bf16*)(ws + WS_WDN + wi * DNW_BYTES); } }
        else if (mi == 6) { fold = 1; gam = AIN(a, 2) + (size_t)(cs * 3) * D; bet = AIN(a, 3) + (size_t)(cs * 3) * D; GW = vec + VEC_MIX + cs * 8192; BW = GW + 4096; K = D; WT = (bf16*)(ws + WS_WMIXL + (size_t)cs * 8 * MiB);
            if (cs < 2) { W = AIN(a, 7) + (size_t)cs * D * SGUH; N = SGUH; } else { W = AIN(a, 18) + (size_t)(cs - 2) * D * NQG; N = NQG; } }
        else { N = D; WT = (bf16*)(ws + WS_WMIX2L + (size_t)cs * 4 * MiB);
            if (cs < 2) { W = AIN(a, 12) + (size_t)cs * SGUHALF * D; K = SGUHALF; } else { W = AIN(a, 19) + (size_t)(cs - 2) * D * D; K = D; } }
    } else {
        if (mi == 0) { W = AIN(a, 13); K = D; N = NKV; WT = (bf16*)(ws + WS_WKV); fold = 1; gam = AIN(a, 2) + (size_t)5 * D; bet = AIN(a, 3) + (size_t)5 * D; GW = vec + VEC_KV; BW = GW + 1536; }
        else if (mi < 3) { const int sl = mi - 1; W = AIN(a, 15) + (size_t)sl * 2048 * 256; K = 2048; N = 256; WT = (bf16*)(ws + WS_WC1) + (size_t)sl * 256 * 2048; }
        else { const int sl = mi - 3; W = AIN(a, 17) + (size_t)sl * 256 * 64; K = 256; N = 64; WT = (bf16*)(ws + WS_WC2) + (size_t)sl * 256 * 256; }
    }
}
__device__ __forceinline__ void convert_set(ArgP a, unsigned char* ws, int cs, LAS float* scr, int gw, int NGW, int lane) {
    const int nmat = cs < 4 ? 8 : 5;
    for (int mi = 0; mi < nmat; ++mi) { const float* W; int K, N, mode, fold; bf16* WT; const float* gam; const float* bet; float* GW; float* BW;
        get_mat(a, ws, cs, mi, W, K, N, WT, mode, fold, gam, bet, GW, BW);
        if (fold) { const int nitems = (N + 31) / 32; const int rot = (gw + 97 * (cs * 8 + mi)) % NGW;
            for (int it = rot; it < nitems; it += NGW) fold_item(W, K, N, WT, mode, gam, bet, GW, BW, scr, it, lane); }
        else { const int nitems = (K / 64) * ((N + 31) / 32);
            for (int it = gw; it < nitems; it += NGW) transpose_item(W, K, N, WT, mode, scr, it, lane); } }
}

__device__ __forceinline__ void ln_row(const float* yrow, const float* g, const float* b, bf16* hb, float* stats, float* fout, int lane) {
    const f32x4* xr = (const f32x4*)yrow + lane;
    f32x4 v[4]; float s = 0.f;
#pragma unroll
    for (int j = 0; j < 4; ++j) { v[j] = xr[64 * j]; s += (v[j].x + v[j].y) + (v[j].z + v[j].w); }
    const float mean = wave_sum(s) * (1.f / D); float s2 = 0.f;
#pragma unroll
    for (int j = 0; j < 4; ++j) { const f32x4 d = v[j] - mean; s2 += (d.x * d.x + d.y * d.y) + (d.z * d.z + d.w * d.w); }
    const float rstd = 1.f / sqrtf(wave_sum(s2) * (1.f / D) + LN_EPS);
#pragma unroll
    for (int j = 0; j < 4; ++j) { const f32x4 gv = *((const f32x4*)g + lane + 64 * j), bv = *((const f32x4*)b + lane + 64 * j);
        const f32x4 o = (v[j] - mean) * rstd * gv + bv;
        if (fout) *((f32x4*)fout + lane + 64 * j) = o;
        else { v2u w; w.x = pg8::cvt_pk_bf16(o.x, o.y); w.y = pg8::cvt_pk_bf16(o.z, o.w); *((v2u*)hb + lane + 64 * j) = w; } }
    if (stats && lane == 0) { stats[0] = mean; stats[1] = rstd; }
}

typedef float f32x16 __attribute__((ext_vector_type(16)));
typedef short s16x8 __attribute__((ext_vector_type(8)));
typedef short s16x4 __attribute__((ext_vector_type(4)));
typedef __bf16 bf16x2_t __attribute__((ext_vector_type(2)));
#define MFMA32(a, b, c) __builtin_amdgcn_mfma_f32_32x32x16_bf16((a), (b), (c), 0, 0, 0)
__device__ __forceinline__ unsigned pkbf(float lo, float hi) { return __builtin_bit_cast(unsigned, __builtin_convertvector((f32x2){lo, hi}, bf16x2_t)); }
constexpr int SP_LD = 136;
__device__ __forceinline__ void spatial_phase(ArgP a, unsigned char* ws, int layer, LAS unsigned char* lds, int G, int bx, int wave_id, int variant) {
    const int tid = cur_tid(wave_id);
    LAS bf16* Ws = (LAS bf16*)lds;
    LAS bf16* Vs = (LAS bf16*)(lds + 128 * SP_LD * 2);
    LAS float* MU = (LAS float*)(lds + (128 + 256) * SP_LD * 2);
    const float* w_s = AIN(a, 10) + (size_t)layer * 8 * 128 * 128; const float* b_s = AIN(a, 11) + (size_t)layer * 8 * 128;
    const float* lng = AIN(a, 8) + (size_t)layer * SGUHALF; const float* lnb = AIN(a, 9) + (size_t)layer * SGUHALF;
    bf16* UG = (bf16*)(ws + WS_UG); const bf16* VT = (const bf16*)(ws + WS_VT); const float* VSTAT = (const float*)(ws + WS_VSTAT);
    int gl = -1;
    for (int u = bx; u < 512 * 8; u += G) {
        const int g = u & 7, bn = u >> 3;
        __syncthreads();
        const int lane = tid & 63, w = wave_id, r = lane & 31, h = lane >> 5, wr = w >> 2, wc = w & 3;
        v2u uv[2][2][4]; float bst[2];
#pragma unroll
        for (int ti = 0; ti < 2; ++ti) { const int t = 64 * wr + 32 * ti + r; bst[ti] = b_s[g * 128 + t];
#pragma unroll
                for (int ci = 0; ci < 2; ++ci)
#pragma unroll
                    for (int gq = 0; gq < 4; ++gq) uv[ti][ci][gq] = *(const v2u*)(UG + (size_t)(bn * 128 + t) * 2048 + g * 256 + 64 * wc + 32 * ci + 8 * gq + 4 * h); }
        if (g != gl) { gl = g;
            for (int i = tid; i < 128 * 32; i += NTHR) { const int t = i >> 5, s4 = (i & 31) * 4; f32x4 w = *(const f32x4*)(w_s + ((size_t)g * 128 + t) * 128 + s4);
                if (s4 + 0 > t) w.x = 0.f; if (s4 + 1 > t) w.y = 0.f; if (s4 + 2 > t) w.z = 0.f; if (s4 + 3 > t) w.w = 0.f;
                v2u o; o.x = pk2(w.x, w.y); o.y = pk2(w.z, w.w); *(LAS v2u*)(Ws + t * SP_LD + s4) = o; } }
        if (tid < 128) { const float* p = VSTAT + ((size_t)(bn * 128 + tid) * 32) * 2; float s = 0.f, q = 0.f;
#pragma unroll
            for (int j = 0; j < 16; ++j) { const f32x4 v = *(const f32x4*)(p + 4 * j); s += v.x + v.z; q += v.y + v.w; }
            const float mean = s * (1.f / 2048.f); const float var = q * (1.f / 2048.f) - mean * mean;
            MU[tid] = mean; MU[128 + tid] = 1.f / sqrtf(fmaxf(var, 0.f) + LN_EPS); }
        __syncthreads();
        for (int i = tid; i < 256 * 16; i += NTHR) { const int c = i >> 4, s8 = (i & 15) * 8; const int cg = g * 256 + c;
            const v4u raw = *(const v4u*)(VT + ((size_t)bn * 2048 + cg) * 128 + s8); const float gg = lng[cg], bb = lnb[cg];
            const unsigned rw[4] = {raw.x, raw.y, raw.z, raw.w}; unsigned ow[4];
#pragma unroll
            for (int j = 0; j < 4; ++j) { const int s = s8 + 2 * j; const float x0 = (bflo(rw[j]) - MU[s]) * MU[128 + s] * gg + bb, x1 = (bfhi(rw[j]) - MU[s + 1]) * MU[128 + s + 1] * gg + bb; ow[j] = pk2(x0, x1); }
            *(LAS v4u*)(Vs + c * SP_LD + s8) = (v4u){ow[0], ow[1], ow[2], ow[3]}; }
        __syncthreads();
        {
            f32x16 acc[2][2];
#pragma unroll
            for (int ti = 0; ti < 2; ++ti)
#pragma unroll
                for (int ci = 0; ci < 2; ++ci)
#pragma unroll
                    for (int i = 0; i < 16; ++i) acc[ti][ci][i] = 0.f;
#pragma unroll
            for (int ks = 0; ks < 8; ++ks) {
                if (16 * ks <= 64 * wr + 63) {
                    const s16x8 a0 = *(const LAS s16x8*)(Vs + (64 * wc + r) * SP_LD + 16 * ks + 8 * h), a1 = *(const LAS s16x8*)(Vs + (64 * wc + 32 + r) * SP_LD + 16 * ks + 8 * h);
                    const s16x8 b0 = *(const LAS s16x8*)(Ws + (64 * wr + r) * SP_LD + 16 * ks + 8 * h), b1 = *(const LAS s16x8*)(Ws + (64 * wr + 32 + r) * SP_LD + 16 * ks + 8 * h);
                    if (16 * ks <= 64 * wr + 31) { acc[0][0] = MFMA32(a0, b0, acc[0][0]); acc[0][1] = MFMA32(a1, b0, acc[0][1]); }
                    acc[1][0] = MFMA32(a0, b1, acc[1][0]); acc[1][1] = MFMA32(a1, b1, acc[1][1]);
                }
            }
#pragma unroll
            for (int ti = 0; ti < 2; ++ti) { const int t = 64 * wr + 32 * ti + r;
#pragma unroll
                for (int ci = 0; ci < 2; ++ci)
#pragma unroll
                    for (int gq = 0; gq < 4; ++gq) { const size_t off = (size_t)(bn * 128 + t) * 2048 + g * 256 + 64 * wc + 32 * ci + 8 * gq + 4 * h;
                        const v2u uu = uv[ti][ci][gq]; v2u o;
                        o.x = pkbf(bflo(uu.x) * (acc[ti][ci][4 * gq] + bst[ti]), bfhi(uu.x) * (acc[ti][ci][4 * gq + 1] + bst[ti]));
                        o.y = pkbf(bflo(uu.y) * (acc[ti][ci][4 * gq + 2] + bst[ti]), bfhi(uu.y) * (acc[ti][ci][4 * gq + 3] + bst[ti]));
                        if (!variant) *(v2u*)(UG + off) = o; } }
        }
    }
    __syncthreads();
}

__device__ __forceinline__ int rel_bucket(int n) {
    if (n < 16) return n;
    const int large = 16 + (int)(logf((float)n / 16.0f) / 2.0794415416798357f * 16.0f);
    return large < 31 ? large : 31;
}
__device__ __forceinline__ s16x8 pack8(const f32x16& x, int s) {
    v4u p; p.x = pkbf(x[8 * s + 0], x[8 * s + 1]); p.y = pkbf(x[8 * s + 2], x[8 * s + 3]); p.z = pkbf(x[8 * s + 4], x[8 * s + 5]); p.w = pkbf(x[8 * s + 6], x[8 * s + 7]);
    return __builtin_bit_cast(s16x8, p);
}
constexpr int AT_KLD = 72, AT_CLD = 136;
constexpr int AT_BUF = 2 * 64 * AT_KLD * 2;
constexpr int AT_BLUT = 3 * AT_BUF, AT_IMP = AT_BLUT + 2048, AT_SELM = AT_IMP + 8192, AT_OT = AT_SELM + 256;

template <bool GEN>
__device__ __forceinline__ void attn_tile(const LAS bf16* Kt, const LAS bf16* Vt, const s16x8 (&qf)[4], f32x16 (&O)[2], float& m_run, float& l_run,
                                          int r, int h, int dl, unsigned wlim, bool ok, float cb, const LAS float* blut) {
    f32x16 S0, S1;
#pragma unroll
    for (int i = 0; i < 16; ++i) { S0[i] = 0.f; S1[i] = 0.f; }
    __builtin_amdgcn_s_setprio(3);
#pragma unroll
    for (int kk = 0; kk < 4; ++kk) {
        const s16x8 a0 = *(const LAS s16x8*)(Kt + r * AT_KLD + 16 * kk + 8 * h), a1 = *(const LAS s16x8*)(Kt + (32 + r) * AT_KLD + 16 * kk + 8 * h);
        S0 = MFMA32(a0, qf[kk], S0); S1 = MFMA32(a1, qf[kk], S1);
    }
    __builtin_amdgcn_s_setprio(0);
    float mx = NEGF;
    if (GEN) {
#pragma unroll
        for (int i = 0; i < 16; ++i) {
            const int off = (i & 3) + 8 * (i >> 2);
            const int d0 = dl - off, d1 = dl - off - 32;
            const bool v0 = ok && ((unsigned)d0 < wlim), v1 = ok && ((unsigned)d1 < wlim);
            const float b0 = blut[min((unsigned)d0, 127u)], b1 = blut[min((unsigned)d1, 127u)];
            S0[i] = v0 ? S0[i] + b0 : NEGF; S1[i] = v1 ? S1[i] + b1 : NEGF;
            mx = fmaxf(mx, fmaxf(S0[i], S1[i]));
        }
    } else {
#pragma unroll
        for (int i = 0; i < 16; ++i) mx = fmaxf(mx, fmaxf(S0[i], S1[i]));
        mx = ok ? mx + cb : NEGF;
    }
    mx = fmaxf(mx, __shfl_xor(mx, 32));
    const float m_new = fmaxf(m_run, mx), m_eff = fmaxf(m_new, -1e29f);
    const float corr = __builtin_amdgcn_exp2f(m_run - m_eff);
    const float sub = GEN ? m_eff : (ok ? m_eff - cb : 3e38f);
    float ps = 0.f;
#pragma unroll
    for (int i = 0; i < 16; ++i) { S0[i] = __builtin_amdgcn_exp2f(S0[i] - sub); S1[i] = __builtin_amdgcn_exp2f(S1[i] - sub); ps += S0[i] + S1[i]; }
    ps += __shfl_xor(ps, 32);
    l_run = l_run * corr + ps; m_run = m_new;
    if (__builtin_amdgcn_ballot_w64(corr != 1.0f) != 0ull) {
#pragma unroll
        for (int i = 0; i < 16; ++i) { O[0][i] *= corr; O[1][i] *= corr; }
    }
    __builtin_amdgcn_s_setprio(3);
#pragma unroll
    for (int blk = 0; blk < 2; ++blk)
#pragma unroll
        for (int st = 0; st < 2; ++st) {
            const s16x8 pb = pack8(blk ? S1 : S0, st);
#pragma unroll
            for (int dt = 0; dt < 2; ++dt) {
                const LAS bf16* vp = Vt + (32 * dt + r) * AT_KLD + 32 * blk + 16 * st + 4 * h;
                const s16x4 lo = *(const LAS s16x4*)vp, hi = *(const LAS s16x4*)(vp + 8);
                O[dt] = MFMA32(__builtin_shufflevector(lo, hi, 0, 1, 2, 3, 4, 5, 6, 7), pb, O[dt]);
            }
        }
    __builtin_amdgcn_s_setprio(0);
}

__device__ __forceinline__ void attn_mfma_phase(ArgP a, unsigned char* ws, LAS unsigned char* lds, int G, int bx, int wave_id) {
    const int tid = cur_tid(wave_id);
    const int lane = tid & 63, w = wave_id, r = lane & 31, h = lane >> 5, hd = r >> 3, ql = r & 7;
    LAS float* BLUT = (LAS float*)(lds + AT_BLUT); LAS float* IMP = (LAS float*)(lds + AT_IMP); LAS unsigned* SELM = (LAS unsigned*)(lds + AT_SELM);
    const bf16* Q = (const bf16*)(ws + WS_Q); bf16* Og = (bf16*)(ws + WS_O); const float* GATES = (const float*)(ws + WS_GATES);
    const bf16* KV = (const bf16*)(ws + WS_KV); const bf16* KC = (const bf16*)(ws + WS_KC); const bf16* VCT = (const bf16*)(ws + WS_VC); const bf16* VTS = (const bf16*)(ws + WS_VTS);
    const float* rel = AIN(a, 1);
    const LAS float* blut = BLUT + hd * 128;
    const int srow = tid >> 3, sch = tid & 7;
    for (int item = bx; item < BATCH * 4 * 32; item += G) {
        const int qb = ((item & 31) + 2 * (item >> 8)) & 31, g = (item >> 5) & 3, b = item >> 7;
        const int q0 = qb * 64, tq = q0 + 8 * w + ql, head = g * 4 + hd;
        const size_t row = (size_t)b * SEQ + tq;
        const int bg = b * 4 + g;
        __syncthreads();
#pragma unroll
        for (int j = 0; j < 2; ++j) { const int i = tid + 512 * j;
            { const int rr = i >> 3, ch = i & 7; *(LAS v4u*)((LAS bf16*)lds + rr * AT_KLD + ch * 8) = *(const v4u*)(KC + ((size_t)bg * 128 + rr) * 64 + ch * 8); }
            { const int rr = i >> 4, ch = i & 15; *(LAS v4u*)((LAS bf16*)(lds + AT_BUF) + rr * AT_CLD + ch * 8) = *(const v4u*)(VCT + ((size_t)bg * 64 + rr) * 128 + ch * 8); } }
        { const int hh = tid >> 7, dd = tid & 127; BLUT[hh * 128 + dd] = rel[rel_bucket(dd) * 16 + g * 4 + hh] * 1.4426950408889634f; }
        s16x8 qf[4];
#pragma unroll
        for (int kk = 0; kk < 4; ++kk) qf[kk] = *(const s16x8*)(Q + row * 1024 + head * 64 + 16 * kk + 8 * h);
        const float g0 = GATES[row * 48 + head * 3 + 0], g1 = GATES[row * 48 + head * 3 + 1], g2 = GATES[row * 48 + head * 3 + 2];
        f32x16 O[2];
        LAS float* otl = (LAS float*)(lds + AT_OT + w * 8192) + lane;
        __syncthreads();
        {
            const LAS bf16* Kc = (const LAS bf16*)lds; const LAS bf16* Vc = (const LAS bf16*)(lds + AT_BUF);
            float mx = NEGF, ps = 0.f;
            for (int kb = 0; kb < 4; ++kb) {
                f32x16 S;
#pragma unroll
                for (int i = 0; i < 16; ++i) S[i] = 0.f;
#pragma unroll
                for (int kk = 0; kk < 4; ++kk) S = MFMA32(*(const LAS s16x8*)(Kc + (32 * kb + r) * AT_KLD + 16 * kk + 8 * h), qf[kk], S);
                float bm = NEGF;
#pragma unroll
                for (int i = 0; i < 16; ++i) { const int ic = 32 * kb + (i & 3) + 8 * (i >> 2) + 4 * h; const int dist = tq - (16 * ic + 31);
                    const float bb = blut[min((unsigned)dist, 127u)]; S[i] = dist >= 0 ? S[i] + bb : NEGF; bm = fmaxf(bm, S[i]); }
                bm = fmaxf(bm, __shfl_xor(bm, 32));
                const float mn = fmaxf(mx, bm), me = fmaxf(mn, -1e29f); float bs = 0.f;
#pragma unroll
                for (int i = 0; i < 16; ++i) bs += __builtin_amdgcn_exp2f(S[i] - me);
                bs += __shfl_xor(bs, 32);
                ps = ps * __builtin_amdgcn_exp2f(mx - me) + bs; mx = mn;
            }
            const float m_eff = fmaxf(mx, -1e29f), linv = ps > 0.f ? 1.f / ps : 0.f;
#pragma unroll
            for (int i = 0; i < 16; ++i) { O[0][i] = 0.f; O[1][i] = 0.f; }
            float Lprev = 0.f;
            for (int kb = 0; kb < 4; ++kb) {
                f32x16 S;
#pragma unroll
                for (int i = 0; i < 16; ++i) S[i] = 0.f;
#pragma unroll
                for (int kk = 0; kk < 4; ++kk) S = MFMA32(*(const LAS s16x8*)(Kc + (32 * kb + r) * AT_KLD + 16 * kk + 8 * h), qf[kk], S);
#pragma unroll
                for (int i = 0; i < 16; ++i) { const int ic = 32 * kb + (i & 3) + 8 * (i >> 2) + 4 * h; const int dist = tq - (16 * ic + 31);
                    const float bb = blut[min((unsigned)dist, 127u)]; S[i] = dist >= 0 ? __builtin_amdgcn_exp2f(S[i] + bb - m_eff) * linv : 0.f; }
#pragma unroll
                for (int gq = 0; gq < 4; ++gq) {
                    const float Gs = (S[4 * gq] + S[4 * gq + 1]) + (S[4 * gq + 2] + S[4 * gq + 3]);
                    const float Lo = __shfl_xor(S[4 * gq + 3], 32);
                    float v = Gs + (h ? Lo : Lprev); Lprev = Lo;
                    v += __shfl_xor(v, 8); v += __shfl_xor(v, 16);
                    if (hd == 0) IMP[(8 * w + ql) * 32 + 2 * (4 * kb + gq) + h] = v; }
#pragma unroll
                for (int st = 0; st < 2; ++st) { const s16x8 pb = pack8(S, st);
#pragma unroll
                    for (int dt = 0; dt < 2; ++dt) { const LAS bf16* vp = Vc + (32 * dt + r) * AT_CLD + 32 * kb + 16 * st + 4 * h;
                        const s16x4 lo = *(const LAS s16x4*)vp, hi = *(const LAS s16x4*)(vp + 8);
                        O[dt] = MFMA32(__builtin_shufflevector(lo, hi, 0, 1, 2, 3, 4, 5, 6, 7), pb, O[dt]); } }
            }
#pragma unroll
            for (int i = 0; i < 16; ++i) { otl[i * 64] = g0 * O[0][i]; otl[(16 + i) * 64] = g0 * O[1][i]; }
        }
        __syncthreads();
        { const int q = tid >> 3, cur = (q0 + q) >> 6; unsigned mbits = 0u;
          for (int jj = 0; jj < 4; ++jj) { const int j = (tid & 7) * 4 + jj;
              const bool vj = j <= cur, fj = vj && (j == 0 || j > cur - 2); const float valj = fj ? 1e30f : (vj ? IMP[q * 32 + j] : -1e30f);
              int rank = 0;
              for (int k = 0; k < 32; ++k) { const bool vk = k <= cur, fk = vk && (k == 0 || k > cur - 2); const float valk = fk ? 1e30f : (vk ? IMP[q * 32 + k] : -1e30f);
                  rank += (valk > valj || (valk == valj && k < j)) ? 1 : 0; }
              if (rank < 8) mbits |= 1u << j; }
          mbits |= __shfl_xor(mbits, 1); mbits |= __shfl_xor(mbits, 2); mbits |= __shfl_xor(mbits, 4);
          if ((tid & 7) == 0) SELM[q] = mbits; }
        const int nsel = qb + 1, pw0 = q0 >= 512 ? q0 - 512 : 0, nwin = ((q0 - pw0) >> 6) + 1, ntile = nsel + nwin;
        const bf16* Ks = KV + (size_t)b * SEQ * NKV + 2 * 256 + g * 64; const bf16* Kw = KV + (size_t)b * SEQ * NKV + 4 * 256 + g * 64;
        const bf16* Vs = VTS + (size_t)bg * 64 * 2048; const bf16* Vw = VTS + (size_t)65536 * 256 + (size_t)bg * 64 * 2048;
        v4u kr0, vr0, kr1, vr1;
#define AT_LOAD(k, KR, VR) do { const bool sl_ = (k) < nsel; const int pb_ = sl_ ? 64 * (k) : pw0 + 64 * ((k) - nsel); \
            KR = *(const v4u*)((sl_ ? Ks : Kw) + (size_t)(pb_ + srow) * NKV + sch * 8); VR = *(const v4u*)((sl_ ? Vs : Vw) + (size_t)srow * 2048 + pb_ + sch * 8); } while (0)
#define AT_STORE(bufi, KR, VR) do { *(LAS v4u*)((LAS bf16*)(lds + (bufi) * AT_BUF) + srow * AT_KLD + sch * 8) = KR; *(LAS v4u*)((LAS bf16*)(lds + (bufi) * AT_BUF + 64 * AT_KLD * 2) + srow * AT_KLD + sch * 8) = VR; } while (0)
        AT_LOAD(0, kr0, vr0); if (ntile > 1) AT_LOAD(1, kr1, vr1);
        AT_STORE(0, kr0, vr0);
        __syncthreads();
        const unsigned selm = SELM[8 * w + ql];
        float m_run = NEGF, l_run = 0.f;
#pragma unroll
        for (int i = 0; i < 16; ++i) { O[0][i] = 0.f; O[1][i] = 0.f; }
        const int tmin = q0 + 8 * w, tmax = tmin + 7;
        const float cbfar = blut[127];
        int bufc = 0;
#define AT_STEP(k, KRN, VRN, KRS, VRS) do { \
            if ((k) + 2 < ntile) AT_LOAD((k) + 2, KRN, VRN); \
            const bool sl = (k) < nsel; const int pbase = sl ? 64 * (k) : pw0 + 64 * ((k) - nsel); \
            const LAS bf16* Kt = (const LAS bf16*)(lds + bufc * AT_BUF); const LAS bf16* Vt = (const LAS bf16*)(lds + bufc * AT_BUF + 64 * AT_KLD * 2); \
            const bool ok = sl ? ((selm >> (k)) & 1u) != 0u : true; \
            const bool fast = (tmin - (pbase + 63) >= 113) && (sl || (tmax - pbase < 512));     \
            if (__builtin_amdgcn_ballot_w64(ok) != 0ull) {                  \
            if (fast) attn_tile<false>(Kt, Vt, qf, O, m_run, l_run, r, h, 0, 0u, ok, cbfar, blut); \
            else attn_tile<true>(Kt, Vt, qf, O, m_run, l_run, r, h, tq - pbase - 4 * h, sl ? 0x7fffffffu : 512u, ok, 0.f, blut); } \
            bufc = bufc == 2 ? 0 : bufc + 1; \
            if ((k) + 1 < ntile) AT_STORE(bufc, KRS, VRS); \
            __syncthreads(); \
            if ((k) == nsel - 1) {                                        \
                const float sc = l_run > 0.f ? g1 / l_run : 0.f; \
                _Pragma("unroll") for (int i = 0; i < 16; ++i) { otl[i * 64] += sc * O[0][i]; otl[(16 + i) * 64] += sc * O[1][i]; O[0][i] = 0.f; O[1][i] = 0.f; } \
                m_run = NEGF; l_run = 0.f; } } while (0)
        for (int k = 0; k < ntile; k += 2) {
            AT_STEP(k, kr0, vr0, kr1, vr1);
            if (k + 1 >= ntile) break;
            AT_STEP(k + 1, kr1, vr1, kr0, vr0);
        }
#undef AT_STEP
        { const float sc = l_run > 0.f ? g2 / l_run : 0.f;
#pragma unroll
          for (int i = 0; i < 16; ++i) { O[0][i] = otl[i * 64] + sc * O[0][i]; O[1][i] = otl[(16 + i) * 64] + sc * O[1][i]; } }
#undef AT_LOAD
#undef AT_STORE
#pragma unroll
        for (int dt = 0; dt < 2; ++dt)
#pragma unroll
            for (int gq = 0; gq < 4; ++gq) { v2u wv; wv.x = pkbf(O[dt][4 * gq], O[dt][4 * gq + 1]); wv.y = pkbf(O[dt][4 * gq + 2], O[dt][4 * gq + 3]);
                *(v2u*)(Og + row * 1024 + head * 64 + 32 * dt + 8 * gq + 4 * h) = wv; }
    }
    __syncthreads();
}

#define XB_TMO      128
#define XB_XCNT(j)  (256  + 64 * (j))
#define XB_XSUB(j)  (1280 + 64 * (j))
#define XB_XGEN(j)  (2304 + 64 * (j))
#define XB_TOP      3328
#define XB_TOPGEN   3392
#define XCD_BAR_WORDS 3456
#define XB_SPIN_CAP (1u << 18)
__device__ __forceinline__ unsigned xb_ld(unsigned* p)              { return __hip_atomic_load(p, __ATOMIC_RELAXED, __HIP_MEMORY_SCOPE_AGENT); }
__device__ __forceinline__ unsigned xb_add(unsigned* p, unsigned v) { return __hip_atomic_fetch_add(p, v, __ATOMIC_RELAXED, __HIP_MEMORY_SCOPE_AGENT); }
__device__ __forceinline__ unsigned xb_xcc_id() { return (unsigned)__builtin_amdgcn_s_getreg((3 << 11) | 20) & 0xFu; }
#define XB_SPIN(cond, bar) do { unsigned _sp = 0; while (cond) { __builtin_amdgcn_s_sleep(1); \
    if ((++_sp & 255u) == 0u) { if (xb_ld(&(bar)[XB_TMO])) break; if (_sp > XB_SPIN_CAP) { atomicAdd(&(bar)[XB_TMO], 1u); break; } } } } while (0)
__device__ __forceinline__ void xcd_barrier_complete(unsigned* bar, unsigned x, unsigned& nloc, unsigned& nx) {
    const unsigned G = gridDim.x * gridDim.y * gridDim.z;
    unsigned sum, cnt, mine, sp = 0u;
    for (;;) {
        sum = 0u; cnt = 0u; mine = 0u;
#pragma unroll
        for (unsigned j = 0; j < 16; ++j) { const unsigned c = xb_ld(&bar[XB_XCNT(j)]); sum += c; cnt += (c > 0u) ? 1u : 0u; mine = (j == x) ? c : mine; }
        if (sum == G) break;
        __builtin_amdgcn_s_sleep(1);
        if ((++sp & 255u) == 0u) { if (xb_ld(&bar[XB_TMO])) break; if (sp > XB_SPIN_CAP) { atomicAdd(&bar[XB_TMO], 1u); break; } }
    }
    nloc = mine > 0u ? mine : 1u; nx = cnt > 0u ? cnt : 1u;
}
__device__ __forceinline__ void xcd_barrier(unsigned* bar, unsigned x, volatile LAS unsigned* st, bool leader) {
    asm volatile("s_waitcnt vmcnt(0)" ::: "memory");
    __syncthreads();
    if (leader) {
        __builtin_amdgcn_s_waitcnt(0);
        unsigned nloc = st[0], nx = st[1];
        if (nloc == 0u) { xcd_barrier_complete(bar, x, nloc, nx); st[0] = nloc; st[1] = nx; }
        const unsigned old = xb_add(&bar[XB_XSUB(x)], 1u);
        const unsigned gen = old / nloc;
        if (old + 1u == (gen + 1u) * nloc) {
            __builtin_amdgcn_fence(__ATOMIC_RELEASE, "agent");
            asm volatile("s_waitcnt vmcnt(0)" ::: "memory");
            const unsigned og = xb_add(&bar[XB_TOP], 1u);
            const unsigned tg = og / nx;
            if (og + 1u == (tg + 1u) * nx) xb_add(&bar[XB_TOPGEN], 1u);
            else XB_SPIN(xb_ld(&bar[XB_TOPGEN]) == tg, bar);
            __builtin_amdgcn_fence(__ATOMIC_ACQUIRE, "agent");
            xb_add(&bar[XB_XGEN(x)], 1u);
            asm volatile("s_waitcnt vmcnt(0)" ::: "memory");
        } else {
            XB_SPIN(xb_ld(&bar[XB_XGEN(x)]) == gen, bar);
            __builtin_amdgcn_fence(__ATOMIC_ACQUIRE, "agent");
            asm volatile("s_waitcnt vmcnt(0)" ::: "memory");
        }
    }
    __syncthreads();
}

enum { PT_PREP = 0, PT_UP, PT_DOWN, PT_LN, PT_SGUIN, PT_SPATIAL, PT_SGUOUT, PT_KV, PT_CMP1, PT_CMP2, PT_QG, PT_ATTN, PT_WO };
constexpr int N_PHASES = 33;
constexpr int N_RUN = N_PHASES + (DUP_A >= 0 ? 2 : 0);
__device__ __forceinline__ void decode_phase(int ph, int& type, int& layer, int& pos) {
    pos = 0;
    if (ph == 0) { type = PT_PREP; layer = 0; return; }
    if (ph == N_PHASES - 1) { type = PT_LN; layer = 3; return; }
    if (ph <= 7) { layer = 0; pos = ph - 1; }
    else if (ph <= 14) { layer = 1; pos = ph - 8; }
    else if (ph <= 24) { layer = 2; pos = ph - 15; if (pos < 3) { type = PT_KV + pos; pos = 0; return; } pos -= 3; }
    else { layer = 3; pos = ph - 25; }
    const bool A = layer < 2;
    switch (pos) {
        case 0: case 5: type = PT_UP; break;
        case 1: case 6: type = PT_DOWN; break;
        case 2: type = A ? PT_SGUIN : PT_QG; break;
        case 3: type = A ? PT_SPATIAL : PT_ATTN; break;
        default: type = A ? PT_SGUOUT : PT_WO; break;
    }
}

__global__ void __launch_bounds__(NTHR, 2) mega_fwd(Args kargs) {
    extern __shared__ __attribute__((aligned(16))) unsigned char lds_raw[];
    LAS unsigned char* lds = (LAS unsigned char*)lds_raw;
    const int wave = __builtin_amdgcn_readfirstlane((int)threadIdx.x >> 6);
    int G = gridDim.x, bx = blockIdx.x;
    unsigned long long wsi = (unsigned long long)kargs.ws, Yi = (unsigned long long)kargs.out; const int ph_lo = kargs.ph_lo, ph_hi = kargs.ph_hi;
    LAS float* scr = (LAS float*)(lds + wave * 16384);
    using namespace pg8;
    volatile LAS unsigned* xst = (volatile LAS unsigned*)(lds + 147456);
    const unsigned xcc = xb_xcc_id();
    { const int t0 = cur_tid(wave); if (t0 == 0) { xst[0] = 0u; xst[1] = 0u; (void)xb_add((unsigned*)(kargs.ws + WS_CTL) + XB_XCNT(xcc), 1u); } }
    __syncthreads();

    for (int ph = ph_lo; ph < ph_hi; ++ph) {
        int type, layer, pos; decode_phase(DUP_A < 0 ? ph : (ph <= DUP_A ? ph : (ph <= DUP_B + 1 ? ph - 1 : ph - 2)), type, layer, pos);
        type = __builtin_amdgcn_readfirstlane(type); layer = __builtin_amdgcn_readfirstlane(layer); pos = __builtin_amdgcn_readfirstlane(pos);
        const __attribute__((address_space(4))) Args* ap = (const __attribute__((address_space(4))) Args*)__builtin_amdgcn_kernarg_segment_ptr(); asm volatile("" : "+s"(ap));
        const ArgP args = (ArgP)ap;
        const int tid = cur_tid(wave);
        const int lane = tid & 63;
        asm volatile("" : "+s"(wsi), "+s"(G), "+s"(bx), "+s"(Yi));
        unsigned char* ws = (unsigned char*)(__attribute__((address_space(1))) unsigned char*)wsi; float* Y = (float*)(__attribute__((address_space(1))) float*)Yi;
#if PROBE_MASK
        if (bx == 0 && tid == 0) { unsigned long long* pp = (unsigned long long*)(ws + WS_BIAS2 + 65536); if (ph == 0) pp[1] = 0ull; pp[0] = __builtin_amdgcn_s_memrealtime(); }
#endif
        bf16* HB = (bf16*)(ws + WS_HB); float* VEC = (float*)(ws + WS_VEC);
        const int gw = bx * NWAVES + wave, NGW = G * NWAVES;
        const int sub = pos >= 5 ? 1 : 0;
        const int dc = 3 * layer + (pos > 1 ? 1 : 0) + (pos > 4 ? 1 : 0);
        const float* PSc = dc > 0 ? (const float*)(ws + WS_PS + (size_t)((dc - 1) & 1) * PS_BYTES) : nullptr;
        float* PSn = (float*)(ws + WS_PS + (size_t)(dc & 1) * PS_BYTES);
        const int lnc = dc - 1;
        const float* lng = dc > 0 ? AIN(args, 2) + (size_t)lnc * D : nullptr; const float* lnb = dc > 0 ? AIN(args, 3) + (size_t)lnc * D : nullptr;
        const size_t wi = (size_t)(layer * 2 + sub);
        switch (type) {
        case PT_PREP: {
            for (int k = 0; k < 5; ++k) convert_set(args, ws, k, scr, gw, NGW, lane);
            if (gw < 512) { const int s = gw >> 8, j = gw & 255; const float* pe = AIN(args, 14) + (size_t)s * 2048; const float* w1 = AIN(args, 15) + (size_t)s * 2048 * 256; float acc = 0.f;
                for (int k = lane; k < 2048; k += 64) acc += pe[k] * w1[(size_t)k * 256 + j];
                acc = wave_sum(acc); if (lane == 0) ((float*)(ws + WS_BIAS2))[gw] = acc + AIN(args, 16)[gw]; }
            const float* x = AIN(args, 0);
            for (size_t i = (size_t)bx * NTHR + tid; i < (size_t)T * D / 8; i += (size_t)G * NTHR) { const f32x4 a0 = *((const f32x4*)x + 2 * i), a1 = *((const f32x4*)x + 2 * i + 1);
                *((v4u*)HB + i) = (v4u){cvt_pk_bf16(a0.x, a0.y), cvt_pk_bf16(a0.z, a0.w), cvt_pk_bf16(a1.x, a1.y), cvt_pk_bf16(a1.z, a1.w)}; }
        } break;
        case PT_UP: {
            Gemm g = make_gemm(HB, (const bf16*)(ws + WS_WUP + wi * UPW_BYTES), T, NUP, D); StaticOrder S; S.init(T, NUP, G, bx);
            EpiSwiGLU E{(bf16*)(ws + WS_U), FFN, PSc, VEC + VEC_UP + wi * 11264, VEC + VEC_UP + wi * 11264 + 5632};
            gemm_phase<EpiSwiGLU, StaticOrder>(lds, g, S, E, wave);
        } break;
        case PT_DOWN: {
            Gemm g = make_gemm((const bf16*)(ws + WS_U), (const bf16*)(ws + WS_WDN + wi * DNW_BYTES), T, D, FFN); StaticOrder S; S.init(T, D, G, bx);
            EpiResid E{dc > 0 ? Y : AIN(args, 0), Y, HB, PSc, PSn, lng, lnb, ALPHA, 0.5f, (layer == 3 && pos == 6) ? 1 : 0};
            gemm_phase<EpiResid, StaticOrder>(lds, g, S, E, wave);
        } break;
        case PT_LN: {
            const float* gg = AIN(args, 2) + (size_t)11 * D; const float* bb = AIN(args, 3) + (size_t)11 * D;
            for (int r = gw; r < T; r += NGW) ln_row(Y + (size_t)r * D, gg, bb, nullptr, nullptr, Y + (size_t)r * D, lane);
        } break;
        case PT_SGUIN: {
            Gemm g = make_gemm(HB, (const bf16*)(ws + WS_WMIXL + (size_t)layer * 8 * MiB), T, SGUH, D); StaticOrder S; S.init(T, SGUH, G, bx);
            EpiSguIn E{(bf16*)(ws + WS_UG), (bf16*)(ws + WS_VT), (float*)(ws + WS_VSTAT), PSc, VEC + VEC_MIX + layer * 8192, VEC + VEC_MIX + layer * 8192 + 4096, lds + STAGE_BYTES};
            gemm_phase<EpiSguIn, StaticOrder>(lds, g, S, E, wave);
        } break;
        case PT_SPATIAL: spatial_phase(args, ws, layer, lds, G, bx, wave, (DUP_A >= 0 && SGUIN_VARIANT && ph <= DUP_B + 1) ? 1 : 0); break;
        case PT_SGUOUT: case PT_WO: {
            const bool sg = type == PT_SGUOUT;
            Gemm g = make_gemm((const bf16*)(ws + (sg ? WS_UG : WS_O)), (const bf16*)(ws + WS_WMIX2L + (size_t)layer * 4 * MiB), T, D, sg ? SGUHALF : D); StaticOrder S; S.init(T, D, G, bx);
            EpiResid E{Y, Y, HB, PSc, PSn, lng, lnb, ALPHA, 1.0f, 0};
            gemm_phase<EpiResid, StaticOrder>(lds, g, S, E, wave);
        } break;
        case PT_KV: {
            Gemm g = make_gemm(HB, (const bf16*)(ws + WS_WKV), T, NKV, D); StaticOrder S; S.init(T, NKV, G, bx);
            EpiKV E{(bf16*)(ws + WS_KV), (bf16*)(ws + WS_VTS), PSc, VEC + VEC_KV, VEC + VEC_KV + 1536};
            gemm_phase<EpiKV, StaticOrder>(lds, g, S, E, wave);
        } break;
        case PT_CMP1: {
            const int half = G / 2, s = bx >= half ? 1 : 0;
            if (bx < 2 * half) {
                Gemm g; g.A = (const bf16*)(ws + WS_KV) + s * 256; g.Bt = (const bf16*)(ws + WS_WC1) + (size_t)s * 256 * 2048; g.M = NCMPROWS; g.N = 256; g.K = 2048;
                g.lda = 16 * NKV; g.a_kstep = NKV * 2; g.a_hstep = 64 * 2; g.a_div = 2; g.a_thi = (long)SEQ * NKV * 2; g.a_tlo = 128 * 2;
                StaticOrder S; S.init(NCMPROWS, 256, half, bx - s * half);
                EpiBf16<1> E{(bf16*)(ws + WS_HID) + (size_t)s * NCMPROWS * 256, 256, (const float*)(ws + WS_BIAS2) + s * 256};
                gemm_phase<EpiBf16<1>, StaticOrder>(lds, g, S, E, wave);
            }
        } break;
        case PT_CMP2: {
            const int half = G / 2, s = bx >= half ? 1 : 0;
            if (bx < 2 * half) {
                Gemm g = make_gemm((const bf16*)(ws + WS_HID) + (size_t)s * NCMPROWS * 256, (const bf16*)(ws + WS_WC2) + (size_t)s * 256 * 256, NCMPROWS, 256, 256);
                StaticOrder S; S.init(NCMPROWS, 256, half, bx - s * half);
                EpiCmp2 E{(bf16*)(ws + (s ? WS_VC : WS_KC)), s};
                gemm_phase<EpiCmp2, StaticOrder>(lds, g, S, E, wave);
            }
        } break;
        case PT_QG: {
            Gemm g = make_gemm(HB, (const bf16*)(ws + WS_WMIXL + (size_t)layer * 8 * MiB), T, NQGP, D); StaticOrder S; S.init(T, NQGP, G, bx);
            EpiQG E{(bf16*)(ws + WS_Q), (float*)(ws + WS_GATES), PSc, VEC + VEC_MIX + layer * 8192, VEC + VEC_MIX + layer * 8192 + 4096};
            gemm_phase<EpiQG, StaticOrder>(lds, g, S, E, wave);
        } break;
        case PT_ATTN: attn_mfma_phase(args, ws, lds, G, bx, wave); break;
        default: break;
        }
        if (ph + 1 < ph_hi) { if (ph == ph_lo) cg::this_grid().sync(); else xcd_barrier((unsigned*)(ws + WS_CTL), xcc, xst, tid == 0); }
#if PROBE_MASK
        if (bx == 0 && tid == 0 && ((PROBE_MASK >> type) & 1)) { unsigned long long* pp = (unsigned long long*)(ws + WS_BIAS2 + 65536); pp[1] += __builtin_amdgcn_s_memrealtime() - pp[0]; }
#endif
    }
#if PROBE_MASK
    __syncthreads();
    if (blockIdx.x == 0 && cur_tid(wave) == 0) { asm volatile("s_waitcnt vmcnt(0)" ::: "memory"); kargs.out[0] += (float)((unsigned long long*)(kargs.ws + WS_BIAS2 + 65536))[1] * 1e-5f; }
#endif
}

extern "C" void kernel_launch(void* const* d_in, const int* in_sizes, int n_in, void* d_out, int out_size, void* d_ws, size_t ws_size, hipStream_t stream) {
    static int grid = 0;
    if (grid == 0) {
        if (n_in != 20 || in_sizes[0] != T * D || out_size != T * D || ws_size < WS_END) { fprintf(stderr, "kernel_launch: unexpected shapes: n_in %d in0 %d out %d ws %zu\n", n_in, n_in > 0 ? in_sizes[0] : -1, out_size, ws_size); grid = -1; return; }
        int dev = 0, cus = 0, per_cu = 0;
        if (hipGetDevice(&dev) != hipSuccess || hipDeviceGetAttribute(&cus, hipDeviceAttributeMultiprocessorCount, dev) != hipSuccess) { grid = -1; return; }
        if (hipFuncSetAttribute((const void*)mega_fwd, hipFuncAttributeMaxDynamicSharedMemorySize, LDS_BYTES) != hipSuccess) { fprintf(stderr, "kernel_launch: hipFuncSetAttribute failed\n"); grid = -1; return; }
        if (hipOccupancyMaxActiveBlocksPerMultiprocessor(&per_cu, (const void*)mega_fwd, NTHR, LDS_BYTES) != hipSuccess || per_cu < 1) { fprintf(stderr, "kernel_launch: occupancy query says %d\n", per_cu); per_cu = 1; }
        (void)hipGetLastError();
        grid = cus * 1;
        if (grid & 1) grid -= 1;
    }
    if (grid < 0) return;
    Args a{};
    for (int i = 0; i < 20; ++i) a.in[i] = (const float*)d_in[i];
    a.out = (float*)d_out; a.ws = (unsigned char*)d_ws;
    if (hipMemsetAsync((char*)d_ws + WS_CTL, 0, CTL_BYTES, stream) != hipSuccess) { fprintf(stderr, "kernel_launch: hipMemsetAsync failed\n"); return; }
#if MK_PER_PHASE
    for (int ph = 0; ph < N_PHASES; ++ph) { a.ph_lo = ph; a.ph_hi = ph + 1; hipLaunchKernelGGL(mega_fwd, dim3(grid), dim3(NTHR), LDS_BYTES, stream, a); }
#else
    a.ph_lo = 0; a.ph_hi = N_RUN;
    void* kargs[] = {&a};
    hipError_t e = hipLaunchCooperativeKernel((const void*)mega_fwd, dim3(grid), dim3(NTHR), kargs, LDS_BYTES, stream);
    if (e != hipSuccess) fprintf(stderr, "kernel_launch: cooperative launch failed: %s (grid %d)\n", hipGetErrorString(e), grid);
#endif
}
```

```cpp
#include <hip/hip_runtime.h>
#include <hip/hip_cooperative_groups.h>
#include <cstdio>
#include <cstdint>
namespace cg = cooperative_groups;

#ifndef MK_PER_PHASE
#define MK_PER_PHASE 0
#endif
#ifndef RESID_ROWS
#define RESID_ROWS 1
#endif
#ifndef SGUIN_VARIANT
#define SGUIN_VARIANT 0
#endif
#ifndef DUP_A
#define DUP_A -1
#define DUP_B -1
#endif
#ifndef PROBE_MASK
#define PROBE_MASK 0
#endif

__device__ __forceinline__ int cur_tid(int wave) { int l = (int)__builtin_amdgcn_mbcnt_hi(~0u, __builtin_amdgcn_mbcnt_lo(~0u, 0u)); asm volatile("" : "+v"(l)); return l + 64 * wave; }
namespace pg8 {
#define PG8_LAS __attribute__((address_space(3)))
typedef unsigned short bf16_t;
typedef short bf16x8 __attribute__((ext_vector_type(8)));
typedef float f32x4 __attribute__((ext_vector_type(4)));
typedef float f32x2 __attribute__((ext_vector_type(2)));
typedef unsigned u32x4 __attribute__((ext_vector_type(4)));
typedef unsigned u32x2 __attribute__((ext_vector_type(2)));
constexpr float QSCALE = 0.125f * 1.4426950408889634f;
constexpr int BM = 256, BK = 64, HALF = 128, HTB = HALF * BK * 2, STAGE_BYTES = 8 * HTB, NXCD = 8, WGM = 4;

__host__ __device__ __forceinline__ int lds_byte(int r, int c) { const int st = (r >> 4) * 2 + (c >> 5), rr = r & 15, cc = c & 31, ob = rr * 64 + cc * 2; return st * 1024 + (ob ^ (((ob >> 9) & 1) << 5)); }
__host__ __device__ __forceinline__ void stage_rc(int b, int& R, int& C) { const int st = b / 1024, sb = b % 1024, swz = sb ^ (((sb >> 9) & 1) << 5); R = (st >> 1) * 16 + swz / 64; C = (st & 1) * 32 + (swz % 64) / 2; }
__host__ __device__ __forceinline__ int perm32(int rho) { const int n = rho >> 4, i = rho & 15; return 8 * (i >> 2) + 4 * n + (i & 3); }

struct Unit { int pm, pn; };
struct Gemm { const bf16_t* A; const bf16_t* Bt; int M, N, K; int lda; long a_kstep, a_hstep; int a_div; long a_thi, a_tlo; };
__device__ __forceinline__ Gemm make_gemm(const bf16_t* A, const bf16_t* Bt, int M, int N, int K) {
    Gemm g; g.A = A; g.Bt = Bt; g.M = M; g.N = N; g.K = K; g.lda = K; g.a_kstep = BK * 2; g.a_hstep = (long)HALF * K * 2; g.a_div = 1; g.a_thi = (long)BM * K * 2; g.a_tlo = 0; return g;
}

struct StaticOrder {
    int nM, nN, nwg, G, c;
    __host__ __device__ void init(int M, int N, int G_, int c_) { nM = M / BM; nN = N / BM; nwg = nM * nN; G = G_; c = c_; }
    __host__ __device__ bool next(int i, Unit& u) const {
        const long L = (long)i * G + c; if (L >= nwg) return false;
        int wgid = (int)L; { const int q = nwg / NXCD, r = nwg % NXCD, xcd = wgid % NXCD, off = wgid / NXCD; wgid = (xcd < r ? xcd * (q + 1) : r * (q + 1) + (xcd - r) * q) + off; }
        const int nig = WGM * nN, gid = wgid / nig, fm = gid * WGM, gsz = (nM - fm) < WGM ? (nM - fm) : WGM;
        u.pm = fm + ((wgid % nig) % gsz); u.pn = (wgid % nig) / gsz; return true;
    }
};

__device__ __forceinline__ unsigned cvt_pk_bf16(float lo, float hi) { unsigned r; asm volatile("v_cvt_pk_bf16_f32 %0, %1, %2" : "=v"(r) : "v"(lo), "v"(hi)); return r; }
__device__ __forceinline__ f32x2 gelu_pk(f32x2 v) {
    const f32x2 av = __builtin_elementwise_abs(v), d = av * 0.2316418882f + 1.0f;
    f32x2 t; t.x = __builtin_amdgcn_rcpf(d.x); t.y = __builtin_amdgcn_rcpf(d.y);
    f32x2 q = t * 0.5307027145f + (-0.7265760135f); q = q * t + 0.7107068705f; q = q * t + (-0.142248368f); q = q * t + 0.127414796f; q = q * t;
    const f32x2 s = (v * v) * (-0.72134752044f);
    f32x2 e; e.x = __builtin_amdgcn_exp2f(s.x); e.y = __builtin_amdgcn_exp2f(s.y);
    const f32x2 m = v * (q * e), r = v - m;
    f32x2 o; o.x = v.x < 0.f ? m.x : r.x; o.y = v.y < 0.f ? m.y : r.y; return o;
}
__device__ __forceinline__ f32x4 gelu4(f32x4 v) { f32x2 a = gelu_pk((f32x2){v[0], v[1]}), b = gelu_pk((f32x2){v[2], v[3]}); return (f32x4){a.x, a.y, b.x, b.y}; }
__device__ __forceinline__ float bf2f(unsigned short b) { return __uint_as_float(((unsigned)b) << 16); }

#define EPI_ZERO_INIT __device__ __forceinline__ void init(f32x4 (&iv)[2][2], const Unit&, int, int, int, int) const { iv[0][0] = iv[0][1] = iv[1][0] = iv[1][1] = (f32x4){0.f, 0.f, 0.f, 0.f}; }
template <int ACT> struct EpiBf16 {
    static constexpr bool PERM = true;
    EPI_ZERO_INIT
    bf16_t* O; int ldc; const float* bias;
    __device__ __forceinline__ void operator()(const f32x4 (&acc)[2][2][4][2], const Unit& u, int wr, int wc, int fr, int fq) const {
        const int row0 = u.pm * BM + wr * 64 + fr; const int col0 = u.pn * BM + wc * 32 + 8 * fq;
        f32x4 bv[2][2];
#pragma unroll
        for (int bj = 0; bj < 2; ++bj)
#pragma unroll
            for (int n = 0; n < 2; ++n) bv[bj][n] = bias ? *(const f32x4*)(bias + col0 + bj * HALF + 4 * n) : (f32x4){0.f, 0.f, 0.f, 0.f};
#pragma unroll
        for (int ai = 0; ai < 2; ++ai)
#pragma unroll
            for (int m = 0; m < 4; ++m) { bf16_t* rowp = O + (size_t)(row0 + ai * HALF + m * 16) * ldc + col0;
#pragma unroll
                for (int bj = 0; bj < 2; ++bj) { f32x4 v0 = acc[ai][bj][m][0] + bv[bj][0], v1 = acc[ai][bj][m][1] + bv[bj][1];
                    if (ACT == 1) { v0 = gelu4(v0); v1 = gelu4(v1); }
                    u32x4 w; w.x = cvt_pk_bf16(v0[0], v0[1]); w.y = cvt_pk_bf16(v0[2], v0[3]); w.z = cvt_pk_bf16(v1[0], v1[1]); w.w = cvt_pk_bf16(v1[2], v1[3]);
                    *(u32x4*)(rowp + bj * HALF) = w; } }
    }
};
__device__ __forceinline__ void row_stats4(const float* PS, int rowa, int fq, float (&mu)[4], float (&rs)[4]) {
    f32x4 a[4], b[4];
#pragma unroll
    for (int r = 0; r < 4; ++r) { const f32x4* p = (const f32x4*)(PS + (size_t)(rowa + r * 16) * 32 + fq * 8); a[r] = p[0]; b[r] = p[1]; }
#pragma unroll
    for (int r = 0; r < 4; ++r) { float s = (a[r].x + a[r].z) + (b[r].x + b[r].z), q = (a[r].y + a[r].w) + (b[r].y + b[r].w);
        s += __shfl_xor(s, 16); s += __shfl_xor(s, 32); q += __shfl_xor(q, 16); q += __shfl_xor(q, 32);
        mu[r] = s * (1.f / 1024.f); rs[r] = __builtin_amdgcn_rsqf(fmaxf(q * (1.f / 1024.f) - mu[r] * mu[r], 0.f) + 1e-5f); }
}
__device__ __forceinline__ void row_stats8(const float* PS, int row0, int fq, float (&mu)[8], float (&rs)[8]) {
    float m0[4], r0[4], m1[4], r1[4]; row_stats4(PS, row0, fq, m0, r0); row_stats4(PS, row0 + HALF, fq, m1, r1);
#pragma unroll
    for (int r = 0; r < 4; ++r) { mu[r] = m0[r]; rs[r] = r0[r]; mu[4 + r] = m1[r]; rs[4 + r] = r1[r]; }
}
struct EpiSwiGLU {
    static constexpr bool PERM = false;
    EPI_ZERO_INIT
    bf16_t* U; int ldc; const float* PS; const float* GW; const float* BW;
    __device__ __forceinline__ void operator()(const f32x4 (&acc)[2][2][4][2], const Unit& u, int wr, int wc, int fr, int fq) const {
        const int row0 = u.pm * BM + wr * 64 + fr;
        float mu[8], rs[8]; f32x4 gwa[2], gwb[2], bwa[2], bwb[2];
        if (PS) { row_stats8(PS, row0, fq, mu, rs);
#pragma unroll
            for (int bj = 0; bj < 2; ++bj) { const int c = (u.pn * 8 + bj * 4 + wc) * 32 + 4 * fq; gwa[bj] = *(const f32x4*)(GW + c); gwb[bj] = *(const f32x4*)(GW + c + 16); bwa[bj] = *(const f32x4*)(BW + c); bwb[bj] = *(const f32x4*)(BW + c + 16); } }
#pragma unroll
        for (int ai = 0; ai < 2; ++ai)
#pragma unroll
            for (int m = 0; m < 4; ++m) { const int row = row0 + ai * HALF + m * 16; bf16_t* rowp = U + (size_t)row * ldc;
#pragma unroll
                for (int bj = 0; bj < 2; ++bj) { const int G32 = u.pn * 8 + bj * 4 + wc; f32x4 a = acc[ai][bj][m][0], b = acc[ai][bj][m][1]; f32x4 o;
                    if (PS) { a = (a - mu[ai * 4 + m] * gwa[bj]) * rs[ai * 4 + m] + bwa[bj]; b = (b - mu[ai * 4 + m] * gwb[bj]) * rs[ai * 4 + m] + bwb[bj]; }
#pragma unroll
                    for (int j = 0; j < 4; ++j) { const float e = __builtin_amdgcn_exp2f(a[j] * -1.44269504089f); o[j] = a[j] * __builtin_amdgcn_rcpf(1.0f + e) * b[j]; }
                    u32x2 w; w.x = cvt_pk_bf16(o[0], o[1]); w.y = cvt_pk_bf16(o[2], o[3]);
                    *(u32x2*)(rowp + G32 * 16 + fq * 4) = w; } }
    }
};
struct EpiResid {
    static constexpr bool PERM = false;
    const float* Yin; float* Yout; bf16_t* YB; const float* PSin; float* PSout; const float* g; const float* b; float alpha, scale; int last;
    __device__ __forceinline__ void init(f32x4 (&iv)[2][2], const Unit& u, int wr, int wc, int fr, int fq) const {
        const int col0 = u.pn * BM + wc * 32 + 4 * fq; const float k = alpha / scale;
#pragma unroll
        for (int bj = 0; bj < 2; ++bj)
#pragma unroll
            for (int n = 0; n < 2; ++n) iv[bj][n] = PSin ? *(const f32x4*)(b + col0 + bj * HALF + n * 16) * k : (f32x4){0.f, 0.f, 0.f, 0.f};
    }
    __device__ __forceinline__ void operator()(const f32x4 (&acc)[2][2][4][2], const Unit& u, int wr, int wc, int fr, int fq) const {
        const int row0 = u.pm * BM + wr * 64 + fr, col0 = u.pn * BM + wc * 32 + 4 * fq;
        f32x4 gv[2][2];
#pragma unroll
        for (int bj = 0; bj < 2; ++bj)
#pragma unroll
            for (int n = 0; n < 2; ++n) gv[bj][n] = PSin ? *(const f32x4*)(g + col0 + bj * HALF + n * 16) : (f32x4){1.f, 1.f, 1.f, 1.f};
        const unsigned e0 = (unsigned)row0 * 1024u + (unsigned)col0;
#pragma unroll
        for (int ai = 0; ai < 2; ++ai) {
#pragma unroll
            for (int mp = 0; mp < 2; ++mp) {
                f32x4 y[2][2][2]; f32x4 sa[2], sb[2];
                if (PSin) {
#pragma unroll
                    for (int mm = 0; mm < 2; ++mm) { const f32x4* p = (const f32x4*)(PSin + (size_t)(row0 + ai * HALF + (mp * 2 + mm) * 16) * 32 + fq * 8); sa[mm] = p[0]; sb[mm] = p[1]; } }
#pragma unroll
                for (int mm = 0; mm < 2; ++mm)
#pragma unroll
                    for (int bj = 0; bj < 2; ++bj)
#pragma unroll
                        for (int n = 0; n < 2; ++n) y[mm][bj][n] = *(const f32x4*)((const char*)Yin + (size_t)((e0 + (unsigned)(ai * HALF + (mp * 2 + mm) * 16) * 1024u + bj * HALF + n * 16) * 4u));
#pragma unroll
                for (int mm = 0; mm < 2; ++mm) { const int m = mp * 2 + mm; const unsigned er = e0 + (unsigned)(ai * HALF + m * 16) * 1024u;
                    float mu_ = 0.f, rs_ = 1.f;
                    if (PSin) { float s1 = (sa[mm].x + sa[mm].z) + (sb[mm].x + sb[mm].z), q1 = (sa[mm].y + sa[mm].w) + (sb[mm].y + sb[mm].w);
                        s1 += __shfl_xor(s1, 16); s1 += __shfl_xor(s1, 32); q1 += __shfl_xor(q1, 16); q1 += __shfl_xor(q1, 32);
                        mu_ = s1 * (1.f / 1024.f); rs_ = __builtin_amdgcn_rsqf(fmaxf(q1 * (1.f / 1024.f) - mu_ * mu_, 0.f) + 1e-5f); }
                    float s = 0.f, q = 0.f;
#pragma unroll
                    for (int bj = 0; bj < 2; ++bj)
#pragma unroll
                        for (int n = 0; n < 2; ++n) { const unsigned e = er + bj * HALF + n * 16; f32x4 v = y[mm][bj][n];
                            if (PSin) v = (v - mu_) * rs_ * gv[bj][n];
                            v = v * alpha + acc[ai][bj][m][n] * scale;
                            *(f32x4*)((char*)Yout + (size_t)(e * 4u)) = v;
                            if (!last) { u32x2 w; w.x = cvt_pk_bf16(v[0], v[1]); w.y = cvt_pk_bf16(v[2], v[3]); *(u32x2*)((char*)YB + (size_t)(e * 2u)) = w; }
                            s += (v[0] + v[1]) + (v[2] + v[3]); q += (v[0] * v[0] + v[1] * v[1]) + (v[2] * v[2] + v[3] * v[3]); }
                    s += __shfl_xor(s, 16); s += __shfl_xor(s, 32); q += __shfl_xor(q, 16); q += __shfl_xor(q, 32);
                    if (fq == 0 && !last) *(f32x2*)(PSout + (size_t)(row0 + ai * HALF + m * 16) * 32 + (u.pn * 4 + wc) * 2) = (f32x2){s, q}; }
                } }
    }
};
struct EpiSguIn {
    static constexpr bool PERM = false;
    EPI_ZERO_INIT
    bf16_t* UG; bf16_t* VT; float* VSTAT; const float* PS; const float* GW; const float* BW; PG8_LAS unsigned char* xscr;
    __device__ __forceinline__ void operator()(const f32x4 (&acc)[2][2][4][2], const Unit& u, int wr, int wc, int fr, int fq) const {
        const int row0 = u.pm * BM + wr * 64 + fr, col0 = u.pn * BM + wc * 32 + 4 * fq;
        PG8_LAS bf16_t* xs = (PG8_LAS bf16_t*)(xscr + (wr * 4 + wc) * 2048);
        const int lane = fq * 16 + fr;
#pragma unroll
        for (int ai = 0; ai < 2; ++ai) {
            float mu[4], rs[4], sa[4], qa[4];
#pragma unroll
            for (int r = 0; r < 4; ++r) { sa[r] = 0.f; qa[r] = 0.f; }
            row_stats4(PS, row0 + ai * HALF, fq, mu, rs);
            f32x4 gnx = *(const f32x4*)(GW + col0), bnx = *(const f32x4*)(BW + col0);
#pragma unroll
            for (int bj = 0; bj < 2; ++bj)
#pragma unroll
                for (int n = 0; n < 2; ++n) { const int col = col0 + bj * HALF + n * 16;
                    const f32x4 gv = gnx, bv = bnx;
                    if (bj * 2 + n < 3) { const int cn = col0 + ((bj * 2 + n + 1) >> 1) * HALF + ((bj * 2 + n + 1) & 1) * 16; gnx = *(const f32x4*)(GW + cn); bnx = *(const f32x4*)(BW + cn); }
#pragma unroll
                    for (int m = 0; m < 4; ++m) { const int row = row0 + ai * HALF + m * 16;
                        const f32x4 v = gelu4((acc[ai][bj][m][n] - mu[m] * gv) * rs[m] + bv);
                        const unsigned w0 = cvt_pk_bf16(v[0], v[1]), w1 = cvt_pk_bf16(v[2], v[3]);
                        if (u.pn < 8) { u32x2 w; w.x = w0; w.y = w1; *(u32x2*)(UG + (size_t)row * 2048 + col) = w; }
                        else { const unsigned short h0 = (unsigned short)(w0 & 0xffff), h1 = (unsigned short)(w0 >> 16), h2 = (unsigned short)(w1 & 0xffff), h3 = (unsigned short)(w1 >> 16);
                            PG8_LAS bf16_t* p = xs + (4 * fq) * 64 + m * 16 + fr; p[0] = h0; p[64] = h1; p[128] = h2; p[192] = h3;
                            const float f0 = bf2f(h0), f1 = bf2f(h1), f2 = bf2f(h2), f3 = bf2f(h3);
                            sa[m] += (f0 + f1) + (f2 + f3); qa[m] += (f0 * f0 + f1 * f1) + (f2 * f2 + f3 * f3); } }
                    if (u.pn >= 8) {
                        const int rowbase = u.pm * BM + ai * HALF + wr * 64, cvb = (u.pn - 8) * BM + bj * HALF + wc * 32 + n * 16;
#pragma unroll
                        for (int k = 0; k < 2; ++k) { const int ch = lane + 64 * k, cc = ch >> 3, part = ch & 7;
                            const u32x4 d = *(const PG8_LAS u32x4*)(xs + cc * 64 + part * 8);
                            *(u32x4*)(VT + (size_t)(rowbase >> 7) * (2048 * 128) + (size_t)(cvb + cc) * 128 + (rowbase & 127) + part * 8) = d; } }
                    }
            if (u.pn >= 8) {
#pragma unroll
                for (int r = 0; r < 4; ++r) { float s = sa[r], q = qa[r];
                    s += __shfl_xor(s, 16); s += __shfl_xor(s, 32); q += __shfl_xor(q, 16); q += __shfl_xor(q, 32);
                    if (fq == 0) *(f32x2*)(VSTAT + ((size_t)(row0 + ai * HALF + r * 16) * 32 + (u.pn - 8) * 4 + wc) * 2) = (f32x2){s, q}; } }
        }
    }
};
struct EpiCmp2 {
    static constexpr bool PERM = false;
    EPI_ZERO_INIT
    bf16_t* KC; int tr;
    __device__ __forceinline__ void operator()(const f32x4 (&acc)[2][2][4][2], const Unit& u, int wr, int wc, int fr, int fq) const {
        if (u.pn != 0 || wc >= 2) return;
        const int row0 = u.pm * BM + wr * 64 + fr, col0 = wc * 32 + 4 * fq;
#pragma unroll
        for (int ai = 0; ai < 2; ++ai)
#pragma unroll
            for (int m = 0; m < 4; ++m) { const int row = row0 + ai * HALF + m * 16; const bool z = (row & 127) == 127;
#pragma unroll
                for (int n = 0; n < 2; ++n) { const f32x4 v = acc[ai][0][m][n]; u32x2 w; w.x = cvt_pk_bf16(v[0], v[1]); w.y = cvt_pk_bf16(v[2], v[3]); if (z) { w.x = 0u; w.y = 0u; }
                    if (!tr) *(u32x2*)(KC + (size_t)row * 64 + col0 + n * 16) = w;
                    else { bf16_t* p = KC + ((size_t)(row >> 7) * 64 + col0 + n * 16) * 128 + (row & 127);
                        p[0] = (bf16_t)(w.x & 0xffff); p[128] = (bf16_t)(w.x >> 16); p[256] = (bf16_t)(w.y & 0xffff); p[384] = (bf16_t)(w.y >> 16); } } }
    }
};
struct EpiKV {
    static constexpr bool PERM = false;
    EPI_ZERO_INIT
    bf16_t* KV; bf16_t* VT; const float* PS; const float* GW; const float* BW;
    __device__ __forceinline__ void operator()(const f32x4 (&acc)[2][2][4][2], const Unit& u, int wr, int wc, int fr, int fq) const {
        const int row0 = u.pm * BM + wr * 64 + fr, c0 = wc * 32 + 4 * fq;
        const bool tr = (u.pn == 3 || u.pn == 5);
        float mu[8], rs[8]; f32x4 gv[2][2], bv[2][2];
        row_stats8(PS, row0, fq, mu, rs);
#pragma unroll
        for (int bj = 0; bj < 2; ++bj)
#pragma unroll
            for (int n = 0; n < 2; ++n) { gv[bj][n] = *(const f32x4*)(GW + u.pn * 256 + c0 + bj * HALF + n * 16); bv[bj][n] = *(const f32x4*)(BW + u.pn * 256 + c0 + bj * HALF + n * 16); }
#pragma unroll
        for (int ai = 0; ai < 2; ++ai)
#pragma unroll
            for (int m = 0; m < 4; ++m) { const int row = row0 + ai * HALF + m * 16;
#pragma unroll
                for (int bj = 0; bj < 2; ++bj)
#pragma unroll
                    for (int n = 0; n < 2; ++n) { const int c = c0 + bj * HALF + n * 16;
                        const f32x4 v = (acc[ai][bj][m][n] - mu[ai * 4 + m] * gv[bj][n]) * rs[ai * 4 + m] + bv[bj][n];
                        u32x2 w; w.x = cvt_pk_bf16(v[0], v[1]); w.y = cvt_pk_bf16(v[2], v[3]);
                        if (!tr) *(u32x2*)(KV + (size_t)row * 1536 + u.pn * 256 + c) = w;
                        else { bf16_t* p = VT + (size_t)((u.pn - 3) >> 1) * ((size_t)65536 * 256) + ((size_t)((row >> 11) * 4 + (c >> 6)) * 64 + (c & 63)) * 2048 + (row & 2047);
                            p[0] = (bf16_t)(w.x & 0xffff); p[2048] = (bf16_t)(w.x >> 16); p[4096] = (bf16_t)(w.y & 0xffff); p[6144] = (bf16_t)(w.y >> 16); } } }
    }
};
struct EpiQG {
    static constexpr bool PERM = false;
    EPI_ZERO_INIT
    bf16_t* Q; float* GATES; const float* PS; const float* GW; const float* BW;
    __device__ __forceinline__ void operator()(const f32x4 (&acc)[2][2][4][2], const Unit& u, int wr, int wc, int fr, int fq) const {
        const int row0 = u.pm * BM + wr * 64 + fr, col0 = u.pn * BM + wc * 32 + 4 * fq;
        float mu[8], rs[8]; f32x4 gv[2][2], bv[2][2];
        row_stats8(PS, row0, fq, mu, rs);
#pragma unroll
        for (int bj = 0; bj < 2; ++bj)
#pragma unroll
            for (int n = 0; n < 2; ++n) { gv[bj][n] = *(const f32x4*)(GW + col0 + bj * HALF + n * 16); bv[bj][n] = *(const f32x4*)(BW + col0 + bj * HALF + n * 16); }
#pragma unroll
        for (int ai = 0; ai < 2; ++ai)
#pragma unroll
            for (int m = 0; m < 4; ++m) { const int row = row0 + ai * HALF + m * 16;
#pragma unroll
                for (int bj = 0; bj < 2; ++bj)
#pragma unroll
                    for (int n = 0; n < 2; ++n) { const int col = col0 + bj * HALF + n * 16; const f32x4 v = (acc[ai][bj][m][n] - mu[ai * 4 + m] * gv[bj][n]) * rs[ai * 4 + m] + bv[bj][n];
                        if (u.pn < 4) { u32x2 w; w.x = cvt_pk_bf16(v[0] * QSCALE, v[1] * QSCALE); w.y = cvt_pk_bf16(v[2] * QSCALE, v[3] * QSCALE); *(u32x2*)(Q + (size_t)row * 1024 + col) = w; }
                        else if (col < 1072) { f32x4 o;
#pragma unroll
                            for (int j = 0; j < 4; ++j) o[j] = __builtin_amdgcn_rcpf(1.0f + __builtin_amdgcn_exp2f(v[j] * -1.44269504089f));
                            *(f32x4*)(GATES + (size_t)row * 48 + (col - 1024)) = o; } } }
    }
};

template <class Epi, class Sched, bool ALIGN_EPI = true>
__device__ __forceinline__ void gemm_phase(PG8_LAS unsigned char* lds, const Gemm g, const Sched& S, const Epi& E, int wave_id) {
    const int tid = cur_tid(wave_id);
    const int wid = wave_id, lane = tid & 63, wr = wid >> 2, wc = wid & 3, fr = lane & 15, fq = lane >> 4;
    const int K = g.K, nt = K / BK;
    unsigned voffA[2], voffB[2];
#pragma unroll
    for (int i = 0; i < 2; ++i) { int R, C; stage_rc(tid * 16 + i * 8192, R, C); const int Rb = Epi::PERM ? ((R & ~31) + perm32(R & 31)) : R;
        voffA[i] = (unsigned)(R * g.lda + C) * 2u; voffB[i] = (unsigned)(Rb * K + C) * 2u; }
    const size_t kstepB = (size_t)(BK * 2), hstepB = (size_t)HALF * K * 2, tstepB = 2 * hstepB;
    const size_t kstepA = (size_t)g.a_kstep, hstepA = (size_t)g.a_hstep;
    const unsigned ldsw = (unsigned)wid * 1024u;
    const int aoff = lds_byte(wr * 64 + fr, fq * 8), boff = lds_byte(wc * 32 + fr, fq * 8);
#define PG8_ABASE(pm) ((const char*)g.A + (size_t)((pm) / g.a_div) * (size_t)g.a_thi + (size_t)((pm) % g.a_div) * (size_t)g.a_tlo)
#define PG8_SA(b, h) (((b) * 2 + (h)) * HTB)
#define PG8_SB(b, h) ((4 + (b) * 2 + (h)) * HTB)
#define PG8_STAGE(bufoff, gbase, voff) do { _Pragma("unroll") for (int _i = 0; _i < 2; ++_i) \
        __builtin_amdgcn_global_load_lds((const unsigned*)((const char*)(gbase) + (voff)[_i]), (PG8_LAS unsigned*)(lds + (bufoff) + ldsw + _i * 8192), 16, 0, 0); } while (0)
#define PG8_LDA(dst, b, h) do { _Pragma("unroll") for (int m = 0; m < 4; ++m) _Pragma("unroll") for (int k = 0; k < 2; ++k) dst[m][k] = *(const PG8_LAS bf16x8*)(lds + PG8_SA(b, h) + aoff + m * 2048 + k * 1024); } while (0)
#define PG8_LDB(dst, b, h) do { _Pragma("unroll") for (int n = 0; n < 2; ++n) _Pragma("unroll") for (int k = 0; k < 2; ++k) dst[n][k] = *(const PG8_LAS bf16x8*)(lds + PG8_SB(b, h) + boff + n * 2048 + k * 1024); } while (0)
#define PG8_MMA(ai, bj, At, Bt) do { __builtin_amdgcn_s_setprio(1); _Pragma("unroll") for (int m = 0; m < 4; ++m) _Pragma("unroll") for (int n = 0; n < 2; ++n) _Pragma("unroll") for (int k = 0; k < 2; ++k) \
        acc[ai][bj][m][n] = __builtin_amdgcn_mfma_f32_16x16x32_bf16(Bt[n][k], At[m][k], acc[ai][bj][m][n], 0, 0, 0); __builtin_amdgcn_s_setprio(0); } while (0)
#define PG8_WAIT_V(n) asm volatile("s_waitcnt vmcnt(" #n ")" ::: "memory")
#define PG8_WAIT_L(n) asm volatile("s_waitcnt lgkmcnt(" #n ")" ::: "memory")
#define PG8_BAR __builtin_amdgcn_s_barrier()
#define PG8_SCHED __builtin_amdgcn_sched_barrier(0)
    Unit cur, nxt; int ui = 0;
    if (!S.next(0, cur)) return;
    f32x4 acc[2][2][4][2];
#define PG8_ACC_INIT(un) do { f32x4 iv_[2][2]; E.init(iv_, un, wr, wc, fr, fq); _Pragma("unroll") for (int a = 0; a < 2; ++a) _Pragma("unroll") for (int b = 0; b < 2; ++b) _Pragma("unroll") for (int m = 0; m < 4; ++m) _Pragma("unroll") for (int n = 0; n < 2; ++n) acc[a][b][m][n] = iv_[b][n]; } while (0)
    PG8_ACC_INIT(cur);
    bf16x8 At[4][2], B0[2][2], B1[2][2];
    const char* cA = PG8_ABASE(cur.pm); const char* cB = (const char*)g.Bt + (size_t)cur.pn * tstepB;
    PG8_STAGE(PG8_SB(0, 0), cB, voffB); PG8_STAGE(PG8_SB(0, 1), cB + hstepB, voffB); PG8_STAGE(PG8_SA(0, 0), cA, voffA); PG8_STAGE(PG8_SA(0, 1), cA + hstepA, voffA);
    if (wr == 1) PG8_BAR;
    PG8_WAIT_V(2); PG8_BAR;
    PG8_STAGE(PG8_SB(1, 0), cB + kstepB, voffB); PG8_STAGE(PG8_SA(1, 0), cA + kstepA, voffA); PG8_STAGE(PG8_SB(1, 1), cB + hstepB + kstepB, voffB);
    PG8_WAIT_V(6); PG8_BAR;
    for (;;) {
        const bool has_next = S.next(ui + 1, nxt);
        const char* nA = has_next ? PG8_ABASE(nxt.pm) : cA; const char* nB = has_next ? (const char*)g.Bt + (size_t)nxt.pn * tstepB : cB;
        for (int t = 0; t < nt; t += 2) {
            const bool last = (t == nt - 2);
            const char* a1 = cA + (size_t)(t + 1) * kstepA;
            const char* a2 = last ? nA : cA + (size_t)(t + 2) * kstepA; const char* b2 = last ? nB : cB + (size_t)(t + 2) * kstepB;
            const char* a3 = a2 + kstepA; const char* b3 = b2 + kstepB;
            PG8_LDB(B0, 0, 0); PG8_LDB(B1, 0, 1); PG8_SCHED; PG8_LDA(At, 0, 0); PG8_STAGE(PG8_SA(1, 1), a1 + hstepA, voffA);
            PG8_WAIT_V(8); PG8_WAIT_L(0); PG8_BAR; PG8_MMA(0, 0, At, B0); PG8_MMA(0, 1, At, B1); PG8_BAR; PG8_SCHED;
            PG8_LDA(At, 0, 1); PG8_STAGE(PG8_SB(0, 0), b2, voffB); PG8_STAGE(PG8_SB(0, 1), b2 + hstepB, voffB); PG8_STAGE(PG8_SA(0, 0), a2, voffA);
            PG8_WAIT_V(8); PG8_WAIT_L(0); PG8_BAR; PG8_MMA(1, 0, At, B0); PG8_MMA(1, 1, At, B1); PG8_BAR; PG8_SCHED;
            PG8_LDB(B0, 1, 0); PG8_LDB(B1, 1, 1); PG8_SCHED; PG8_LDA(At, 1, 0); PG8_STAGE(PG8_SA(0, 1), a2 + hstepA, voffA);
            PG8_WAIT_V(8); PG8_WAIT_L(0); PG8_BAR; PG8_MMA(0, 0, At, B0); PG8_MMA(0, 1, At, B1); PG8_BAR; PG8_SCHED;
            PG8_LDA(At, 1, 1); PG8_STAGE(PG8_SB(1, 0), b3, voffB); PG8_STAGE(PG8_SB(1, 1), b3 + hstepB, voffB); PG8_STAGE(PG8_SA(1, 0), a3, voffA);
            PG8_WAIT_V(8); PG8_WAIT_L(0); PG8_BAR; PG8_MMA(1, 0, At, B0); PG8_MMA(1, 1, At, B1); PG8_BAR; PG8_SCHED;
        }
        if constexpr (ALIGN_EPI) { if (wr == 0) PG8_BAR; }
        E(acc, cur, wr, wc, fr, fq);
        if (!has_next) break;
        cur = nxt; cA = nA; cB = nB; ++ui;
        PG8_ACC_INIT(cur);
        if constexpr (ALIGN_EPI) { if (wr == 1) PG8_BAR; }
    }
    PG8_WAIT_V(0);
    if constexpr (!ALIGN_EPI) { if (wr == 0) PG8_BAR; }
    PG8_BAR;
#undef PG8_ACC_INIT
#undef PG8_ABASE
#undef PG8_SA
#undef PG8_SB
#undef PG8_STAGE
#undef PG8_LDA
#undef PG8_LDB
#undef PG8_MMA
#undef PG8_WAIT_V
#undef PG8_WAIT_L
#undef PG8_BAR
#undef PG8_SCHED
}
}

#define LAS __attribute__((address_space(3)))
typedef unsigned short bf16;
typedef unsigned v4u __attribute__((ext_vector_type(4)));
typedef unsigned v2u __attribute__((ext_vector_type(2)));
typedef float f32x4 __attribute__((ext_vector_type(4)));
typedef float f32x2 __attribute__((ext_vector_type(2)));
constexpr int NWAVES = 8, NTHR = 512;
constexpr int BATCH = 32, SEQ = 2048, D = 1024, T = BATCH * SEQ, FFN = 2816, NUP = 2 * FFN, SGUH = 4096, SGUHALF = 2048;
constexpr int NKV = 1536, NQG = 1072, NQGP = 1280, NCMPROWS = 16384;
constexpr float ALPHA = 1.681792830507429f, LN_EPS = 1e-5f, NEGF = -1e30f;
constexpr size_t MiB = 1u << 20;
constexpr size_t WS_VEC = 0, WS_WUP = 1 * MiB  , WS_WDN = 89 * MiB  , WS_WMIXL = 133 * MiB  , WS_WMIX2L = 165 * MiB  ;
constexpr size_t WS_WKV = 181 * MiB, WS_WC1 = 184 * MiB, WS_WC2 = 186 * MiB, WS_BIAS2 = 187 * MiB, WS_PS = 188 * MiB  , WS_VSTAT = 204 * MiB;
constexpr size_t WS_HB = 220 * MiB  , WS_SCR = 348 * MiB;
constexpr size_t WS_U = WS_SCR, WS_UG = WS_SCR, WS_VT = WS_SCR + 256 * MiB, WS_Q = WS_SCR, WS_O = WS_SCR + 128 * MiB, WS_GATES = WS_SCR + 256 * MiB;
constexpr size_t WS_KV = 700 * MiB, WS_KC = 892 * MiB, WS_VC = 894 * MiB, WS_HID = 896 * MiB, WS_VTS = 912 * MiB  , WS_END = 976 * MiB;
constexpr size_t UPW_BYTES = 11 * MiB, DNW_BYTES = (size_t)D * FFN * 2, PS_BYTES = 8 * MiB;
constexpr int VEC_UP = 0  , VEC_MIX = 8 * 11264  , VEC_KV = VEC_MIX + 4 * 8192  ;
constexpr int LDS_BYTES = 147456 + 64;
constexpr size_t WS_CTL = 187 * MiB + 512 * 1024, CTL_BYTES = 16384;

__device__ __forceinline__ unsigned f2bf(float f) { unsigned u = __builtin_bit_cast(unsigned, f); return (u + 0x7fffu + ((u >> 16) & 1u)) >> 16; }
__device__ __forceinline__ unsigned pk2(float lo, float hi) { return f2bf(lo) | (f2bf(hi) << 16); }
__device__ __forceinline__ float bflo(unsigned w) { return __uint_as_float(w << 16); }
__device__ __forceinline__ float bfhi(unsigned w) { return __uint_as_float(w & 0xffff0000u); }
__device__ __forceinline__ float wave_sum(float v) {
#pragma unroll
    for (int o = 1; o < 64; o <<= 1) v += __shfl_xor(v, o);
    return v;
}
#define LDS_WAIT() asm volatile("s_waitcnt lgkmcnt(0)" ::: "memory")

__device__ __forceinline__ int rowmap(int n, int mode) { return mode == 0 ? n : (32 * (n >> 4) + (n & 15) + (mode == 2 ? 16 : 0)); }
__device__ __forceinline__ void transpose_item(const float* W, int K, int N, bf16* WT, int mode, LAS float* scr, int item, int lane) {
    const int nblk = (N + 31) / 32, kb = item / nblk, nb = item % nblk, k0 = 64 * kb, n0 = 32 * nb;
    const bool nok = (n0 + (lane & 31)) < N;
    { const int nn = (lane & 7) * 4; const bool ok4 = (n0 + nn) < N;
#pragma unroll
      for (int i = 0; i < 8; ++i) { const int kk = 8 * i + (lane >> 3); f32x4 v = (f32x4){0.f, 0.f, 0.f, 0.f}; if (ok4) v = *(const f32x4*)(W + (size_t)(k0 + kk) * N + n0 + nn);
          LAS float* d = scr + kk * 33 + nn; d[0] = v.x; d[1] = v.y; d[2] = v.z; d[3] = v.w; } }
    LDS_WAIT(); asm volatile("" ::: "memory");
    const int c = lane & 7;
#pragma unroll
    for (int j = 0; j < 4; ++j) { const int n = (lane >> 3) + 8 * j; const LAS float* s = scr + (8 * c) * 33 + n;
        v4u o; o.x = pk2(s[0 * 33], s[1 * 33]); o.y = pk2(s[2 * 33], s[3 * 33]); o.z = pk2(s[4 * 33], s[5 * 33]); o.w = pk2(s[6 * 33], s[7 * 33]);
        if (n0 + n < N) *(v4u*)(WT + (size_t)rowmap(n0 + n, mode) * K + k0 + 8 * c) = o; }
    LDS_WAIT(); asm volatile("" ::: "memory");
}
struct Args { const float* in[20]; float* out; unsigned char* ws; int ph_lo, ph_hi; };
typedef const __attribute__((address_space(4))) unsigned long long* ArgP;
#define AIN(a, i) ((const float*)(const __attribute__((address_space(1))) float*)(a)[(i)])

__device__ __forceinline__ void fold_item(const float* W, int K, int N, bf16* WT, int mode, const float* g, const float* b, float* GW, float* BW, LAS float* scr, int nb, int lane) {
    const int n0 = 32 * nb; const bool nok = (n0 + (lane & 31)) < N; const int c = lane & 7;
    float gs[4] = {0.f, 0.f, 0.f, 0.f}, bs[4] = {0.f, 0.f, 0.f, 0.f};
    for (int k0 = 0; k0 < K; k0 += 64) {
        { const int nn = (lane & 7) * 4; const bool ok4 = (n0 + nn) < N;
#pragma unroll
          for (int i = 0; i < 8; ++i) { const int kk = 8 * i + (lane >> 3); f32x4 v = (f32x4){0.f, 0.f, 0.f, 0.f}; if (ok4) v = *(const f32x4*)(W + (size_t)(k0 + kk) * N + n0 + nn);
              LAS float* d = scr + kk * 33 + nn; d[0] = v.x; d[1] = v.y; d[2] = v.z; d[3] = v.w; } }
        LDS_WAIT(); asm volatile("" ::: "memory");
        f32x4 g0 = (f32x4){1.f, 1.f, 1.f, 1.f}, g1 = g0, b0 = (f32x4){0.f, 0.f, 0.f, 0.f}, b1 = b0;
        if (g) { g0 = *(const f32x4*)(g + k0 + 8 * c); g1 = *(const f32x4*)(g + k0 + 8 * c + 4); b0 = *(const f32x4*)(b + k0 + 8 * c); b1 = *(const f32x4*)(b + k0 + 8 * c + 4); }
#pragma unroll
        for (int j = 0; j < 4; ++j) { const int n = (lane >> 3) + 8 * j; const LAS float* sp = scr + (8 * c) * 33 + n;
            const float w0 = sp[0 * 33], w1 = sp[1 * 33], w2 = sp[2 * 33], w3 = sp[3 * 33], w4 = sp[4 * 33], w5 = sp[5 * 33], w6 = sp[6 * 33], w7 = sp[7 * 33];
            v4u o; o.x = pk2(w0 * g0.x, w1 * g0.y); o.y = pk2(w2 * g0.z, w3 * g0.w); o.z = pk2(w4 * g1.x, w5 * g1.y); o.w = pk2(w6 * g1.z, w7 * g1.w);
            gs[j] += ((bflo(o.x) + bfhi(o.x)) + (bflo(o.y) + bfhi(o.y))) + ((bflo(o.z) + bfhi(o.z)) + (bflo(o.w) + bfhi(o.w)));
            bs[j] += ((w0 * b0.x + w1 * b0.y) + (w2 * b0.z + w3 * b0.w)) + ((w4 * b1.x + w5 * b1.y) + (w6 * b1.z + w7 * b1.w));
            if (n0 + n < N) *(v4u*)(WT + (size_t)rowmap(n0 + n, mode) * K + k0 + 8 * c) = o; }
        LDS_WAIT(); asm volatile("" ::: "memory");
    }
#pragma unroll
    for (int j = 0; j < 4; ++j) { float x = gs[j], y = bs[j];
        x += __shfl_xor(x, 1); x += __shfl_xor(x, 2); x += __shfl_xor(x, 4); y += __shfl_xor(y, 1); y += __shfl_xor(y, 2); y += __shfl_xor(y, 4);
        const int n = (lane >> 3) + 8 * j; if (c == 0 && n0 + n < N) { GW[rowmap(n0 + n, mode)] = x; BW[rowmap(n0 + n, mode)] = y; } }
}
__device__ __forceinline__ void get_mat(ArgP a, unsigned char* ws, int cs, int mi, const float*& W, int& K, int& N, bf16*& WT, int& mode, int& fold, const float*& gam, const float*& bet, float*& GW, float*& BW) {
    mode = 0; fold = 0; gam = nullptr; bet = nullptr; GW = nullptr; BW = nullptr; float* vec = (float*)(ws + WS_VEC);
    if (cs < 4) {
        if (mi < 6) { const int sb = mi / 3, k = mi % 3; const size_t wi = (size_t)(cs * 2 + sb);
            if (k < 2) { W = AIN(a, 4 + k) + wi * D * FFN; K = D; N = FFN; WT = (bf16*)(ws + WS_WUP + wi * UPW_BYTES); mode = 1 + k; fold = 1;
                const int li = sb ? cs * 3 + 1 : cs * 3 - 1;
                if (li >= 0) { gam = AIN(a, 2) + (size_t)li * D; bet = AIN(a, 3) + (size_t)li * D; }
                GW = vec + VEC_UP + wi * 11264; BW = GW + 5632; }
            else { W = AIN(a, 6) + wi * FFN * D; K = FFN; N = D; WT = (bf16*)(ws + WS_WDN + wi * DNW_BYTES); } }
        else if (mi == 6) { fold = 1; gam = AIN(a, 2) + (size_t)(cs * 3) * D; bet = AIN(a, 3) + (size_t)(cs * 3) * D; GW = vec + VEC_MIX + cs * 8192; BW = GW + 4096; K = D; WT = (bf16*)(ws + WS_WMIXL + (size_t)cs * 8 * MiB);
            if (cs < 2) { W = AIN(a, 7) + (size_t)cs * D * SGUH; N = SGUH; } else { W = AIN(a, 18) + (size_t)(cs - 2) * D * NQG; N = NQG; } }
        else { N = D; WT = (bf16*)(ws + WS_WMIX2L + (size_t)cs * 4 * MiB);
            if (cs < 2) { W = AIN(a, 12) + (size_t)cs * SGUHALF * D; K = SGUHALF; } else { W = AIN(a, 19) + (size_t)(cs - 2) * D * D; K = D; } }
    } else {
        if (mi == 0) { W = AIN(a, 13); K = D; N = NKV; WT = (bf16*)(ws + WS_WKV); fold = 1; gam = AIN(a, 2) + (size_t)5 * D; bet = AIN(a, 3) + (size_t)5 * D; GW = vec + VEC_KV; BW = GW + 1536; }
        else if (mi < 3) { const int sl = mi - 1; W = AIN(a, 15) + (size_t)sl * 2048 * 256; K = 2048; N = 256; WT = (bf16*)(ws + WS_WC1) + (size_t)sl * 256 * 2048; }
        else { const int sl = mi - 3; W = AIN(a, 17) + (size_t)sl * 256 * 64; K = 256; N = 64; WT = (bf16*)(ws + WS_WC2) + (size_t)sl * 256 * 256; }
    }
}
__device__ __forceinline__ void convert_set(ArgP a, unsigned char* ws, int cs, LAS float* scr, int gw, int NGW, int lane) {
    const int nmat = cs < 4 ? 8 : 5;
    for (int mi = 0; mi < nmat; ++mi) { const float* W; int K, N, mode, fold; bf16* WT; const float* gam; const float* bet; float* GW; float* BW;
        get_mat(a, ws, cs, mi, W, K, N, WT, mode, fold, gam, bet, GW, BW);
        if (fold) { const int nitems = (N + 31) / 32; const int rot = (gw + 97 * (cs * 8 + mi)) % NGW;
            for (int it = rot; it < nitems; it += NGW) fold_item(W, K, N, WT, mode, gam, bet, GW, BW, scr, it, lane); }
        else { const int nitems = (K / 64) * ((N + 31) / 32);
            for (int it = gw; it < nitems; it += NGW) transpose_item(W, K, N, WT, mode, scr, it, lane); } }
}

__device__ __forceinline__ void ln_row(const float* yrow, const float* g, const float* b, bf16* hb, float* stats, float* fout, int lane) {
    const f32x4* xr = (const f32x4*)yrow + lane;
    f32x4 v[4]; float s = 0.f;
#pragma unroll
    for (int j = 0; j < 4; ++j) { v[j] = xr[64 * j]; s += (v[j].x + v[j].y) + (v[j].z + v[j].w); }
    const float mean = wave_sum(s) * (1.f / D); float s2 = 0.f;
#pragma unroll
    for (int j = 0; j < 4; ++j) { const f32x4 d = v[j] - mean; s2 += (d.x * d.x + d.y * d.y) + (d.z * d.z + d.w * d.w); }
    const float rstd = 1.f / sqrtf(wave_sum(s2) * (1.f / D) + LN_EPS);
#pragma unroll
    for (int j = 0; j < 4; ++j) { const f32x4 gv = *((const f32x4*)g + lane + 64 * j), bv = *((const f32x4*)b + lane + 64 * j);
        const f32x4 o = (v[j] - mean) * rstd * gv + bv;
        if (fout) *((f32x4*)fout + lane + 64 * j) = o;
        else { v2u w; w.x = pg8::cvt_pk_bf16(o.x, o.y); w.y = pg8::cvt_pk_bf16(o.z, o.w); *((v2u*)hb + lane + 64 * j) = w; } }
    if (stats && lane == 0) { stats[0] = mean; stats[1] = rstd; }
}

typedef float f32x16 __attribute__((ext_vector_type(16)));
typedef short s16x8 __attribute__((ext_vector_type(8)));
typedef short s16x4 __attribute__((ext_vector_type(4)));
typedef __bf16 bf16x2_t __attribute__((ext_vector_type(2)));
#define MFMA32(a, b, c) __builtin_amdgcn_mfma_f32_32x32x16_bf16((a), (b), (c), 0, 0, 0)
__device__ __forceinline__ unsigned pkbf(float lo, float hi) { return __builtin_bit_cast(unsigned, __builtin_convertvector((f32x2){lo, hi}, bf16x2_t)); }
constexpr int SP_LD = 136;
__device__ __forceinline__ void spatial_phase(ArgP a, unsigned char* ws, int layer, LAS unsigned char* lds, int G, int bx, int wave_id, int variant) {
    const int tid = cur_tid(wave_id);
    LAS bf16* Ws = (LAS bf16*)lds;
    LAS bf16* Vs = (LAS bf16*)(lds + 128 * SP_LD * 2);
    LAS float* MU = (LAS float*)(lds + (128 + 256) * SP_LD * 2);
    const float* w_s = AIN(a, 10) + (size_t)layer * 8 * 128 * 128; const float* b_s = AIN(a, 11) + (size_t)layer * 8 * 128;
    const float* lng = AIN(a, 8) + (size_t)layer * SGUHALF; const float* lnb = AIN(a, 9) + (size_t)layer * SGUHALF;
    bf16* UG = (bf16*)(ws + WS_UG); const bf16* VT = (const bf16*)(ws + WS_VT); const float* VSTAT = (const float*)(ws + WS_VSTAT);
    int gl = -1;
    for (int u = bx; u < 512 * 8; u += G) {
        const int g = u & 7, bn = u >> 3;
        __syncthreads();
        const int lane = tid & 63, w = wave_id, r = lane & 31, h = lane >> 5, wr = w >> 2, wc = w & 3;
        v2u uv[2][2][4]; float bst[2];
#pragma unroll
        for (int ti = 0; ti < 2; ++ti) { const int t = 64 * wr + 32 * ti + r; bst[ti] = b_s[g * 128 + t];
#pragma unroll
                for (int ci = 0; ci < 2; ++ci)
#pragma unroll
                    for (int gq = 0; gq < 4; ++gq) uv[ti][ci][gq] = *(const v2u*)(UG + (size_t)(bn * 128 + t) * 2048 + g * 256 + 64 * wc + 32 * ci + 8 * gq + 4 * h); }
        if (g != gl) { gl = g;
            for (int i = tid; i < 128 * 32; i += NTHR) { const int t = i >> 5, s4 = (i & 31) * 4; f32x4 w = *(const f32x4*)(w_s + ((size_t)g * 128 + t) * 128 + s4);
                if (s4 + 0 > t) w.x = 0.f; if (s4 + 1 > t) w.y = 0.f; if (s4 + 2 > t) w.z = 0.f; if (s4 + 3 > t) w.w = 0.f;
                v2u o; o.x = pk2(w.x, w.y); o.y = pk2(w.z, w.w); *(LAS v2u*)(Ws + t * SP_LD + s4) = o; } }
        if (tid < 128) { const float* p = VSTAT + ((size_t)(bn * 128 + tid) * 32) * 2; float s = 0.f, q = 0.f;
#pragma unroll
            for (int j = 0; j < 16; ++j) { const f32x4 v = *(const f32x4*)(p + 4 * j); s += v.x + v.z; q += v.y + v.w; }
            const float mean = s * (1.f / 2048.f); const float var = q * (1.f / 2048.f) - mean * mean;
            MU[tid] = mean; MU[128 + tid] = 1.f / sqrtf(fmaxf(var, 0.f) + LN_EPS); }
        __syncthreads();
        for (int i = tid; i < 256 * 16; i += NTHR) { const int c = i >> 4, s8 = (i & 15) * 8; const int cg = g * 256 + c;
            const v4u raw = *(const v4u*)(VT + ((size_t)bn * 2048 + cg) * 128 + s8); const float gg = lng[cg], bb = lnb[cg];
            const unsigned rw[4] = {raw.x, raw.y, raw.z, raw.w}; unsigned ow[4];
#pragma unroll
            for (int j = 0; j < 4; ++j) { const int s = s8 + 2 * j; const float x0 = (bflo(rw[j]) - MU[s]) * MU[128 + s] * gg + bb, x1 = (bfhi(rw[j]) - MU[s + 1]) * MU[128 + s + 1] * gg + bb; ow[j] = pk2(x0, x1); }
            *(LAS v4u*)(Vs + c * SP_LD + s8) = (v4u){ow[0], ow[1], ow[2], ow[3]}; }
        __syncthreads();
        {
            f32x16 acc[2][2];
#pragma unroll
            for (int ti = 0; ti < 2; ++ti)
#pragma unroll
                for (int ci = 0; ci < 2; ++ci)
#pragma unroll
                    for (int i = 0; i < 16; ++i) acc[ti][ci][i] = 0.f;
#pragma unroll
            for (int ks = 0; ks < 8; ++ks) {
                if (16 * ks <= 64 * wr + 63) {
                    const s16x8 a0 = *(const LAS s16x8*)(Vs + (64 * wc + r) * SP_LD + 16 * ks + 8 * h), a1 = *(const LAS s16x8*)(Vs + (64 * wc + 32 + r) * SP_LD + 16 * ks + 8 * h);
                    const s16x8 b0 = *(const LAS s16x8*)(Ws + (64 * wr + r) * SP_LD + 16 * ks + 8 * h), b1 = *(const LAS s16x8*)(Ws + (64 * wr + 32 + r) * SP_LD + 16 * ks + 8 * h);
                    if (16 * ks <= 64 * wr + 31) { acc[0][0] = MFMA32(a0, b0, acc[0][0]); acc[0][1] = MFMA32(a1, b0, acc[0][1]); }
                    acc[1][0] = MFMA32(a0, b1, acc[1][0]); acc[1][1] = MFMA32(a1, b1, acc[1][1]);
                }
            }
#pragma unroll
            for (int ti = 0; ti < 2; ++ti) { const int t = 64 * wr + 32 * ti + r;
#pragma unroll
                for (int ci = 0; ci < 2; ++ci)
#pragma unroll
                    for (int gq = 0; gq < 4; ++gq) { const size_t off = (size_t)(bn * 128 + t) * 2048 + g * 256 + 64 * wc + 32 * ci + 8 * gq + 4 * h;
                        const v2u uu = uv[ti][ci][gq]; v2u o;
                        o.x = pkbf(bflo(uu.x) * (acc[ti][ci][4 * gq] + bst[ti]), bfhi(uu.x) * (acc[ti][ci][4 * gq + 1] + bst[ti]));
                        o.y = pkbf(bflo(uu.y) * (acc[ti][ci][4 * gq + 2] + bst[ti]), bfhi(uu.y) * (acc[ti][ci][4 * gq + 3] + bst[ti]));
                        if (!variant) *(v2u*)(UG + off) = o; } }
        }
    }
    __syncthreads();
}

__device__ __forceinline__ int rel_bucket(int n) {
    if (n < 16) return n;
    const int large = 16 + (int)(logf((float)n / 16.0f) / 2.0794415416798357f * 16.0f);
    return large < 31 ? large : 31;
}
__device__ __forceinline__ s16x8 pack8(const f32x16& x, int s) {
    v4u p; p.x = pkbf(x[8 * s + 0], x[8 * s + 1]); p.y = pkbf(x[8 * s + 2], x[8 * s + 3]); p.z = pkbf(x[8 * s + 4], x[8 * s + 5]); p.w = pkbf(x[8 * s + 6], x[8 * s + 7]);
    return __builtin_bit_cast(s16x8, p);
}
constexpr int AT_KLD = 72, AT_CLD = 136, AT_VLD = 68;
constexpr int AT_BUF = 2 * 64 * AT_KLD * 2;
constexpr int AT_BLUT = 3 * AT_BUF, AT_IMP = AT_BLUT + 2048, AT_SELM = AT_IMP + 8192, AT_OT = AT_SELM + 256;

template <bool GEN>
__device__ __forceinline__ void attn_tile(const LAS bf16* Kt, const LAS bf16* Vt, const s16x8 (&qf)[4], f32x16 (&O)[2], float& m_run, float& l_run,
                                          int r, int h, int dl, unsigned wlim, bool ok, float cb, const LAS float* blut) {
    f32x16 S0, S1;
#pragma unroll
    for (int i = 0; i < 16; ++i) { S0[i] = 0.f; S1[i] = 0.f; }
    __builtin_amdgcn_s_setprio(1);
#pragma unroll
    for (int kk = 0; kk < 4; ++kk) {
        const s16x8 a0 = *(const LAS s16x8*)(Kt + r * AT_KLD + 16 * kk + 8 * h), a1 = *(const LAS s16x8*)(Kt + (32 + r) * AT_KLD + 16 * kk + 8 * h);
        S0 = MFMA32(a0, qf[kk], S0); S1 = MFMA32(a1, qf[kk], S1);
    }
    __builtin_amdgcn_s_setprio(0);
    float mx = NEGF;
    if (GEN) {
#pragma unroll
        for (int i = 0; i < 16; ++i) {
            const int off = (i & 3) + 8 * (i >> 2);
            const int d0 = dl - off, d1 = dl - off - 32;
            const bool v0 = ok && ((unsigned)d0 < wlim), v1 = ok && ((unsigned)d1 < wlim);
            const float b0 = blut[min((unsigned)d0, 127u)], b1 = blut[min((unsigned)d1, 127u)];
            S0[i] = v0 ? S0[i] + b0 : NEGF; S1[i] = v1 ? S1[i] + b1 : NEGF;
            mx = fmaxf(mx, fmaxf(S0[i], S1[i]));
        }
    } else {
#pragma unroll
        for (int i = 0; i < 16; ++i) mx = fmaxf(mx, fmaxf(S0[i], S1[i]));
        mx = ok ? mx + cb : NEGF;
    }
    mx = fmaxf(mx, __shfl_xor(mx, 32));
    const float m_new = fmaxf(m_run, mx), m_eff = fmaxf(m_new, -1e29f);
    const float corr = __builtin_amdgcn_exp2f(m_run - m_eff);
    const float sub = GEN ? m_eff : (ok ? m_eff - cb : 3e38f);
    float ps = 0.f;
#pragma unroll
    for (int i = 0; i < 16; ++i) { S0[i] = __builtin_amdgcn_exp2f(S0[i] - sub); S1[i] = __builtin_amdgcn_exp2f(S1[i] - sub); ps += S0[i] + S1[i]; }
    ps += __shfl_xor(ps, 32);
    l_run = l_run * corr + ps; m_run = m_new;
    if (__builtin_amdgcn_ballot_w64(corr != 1.0f) != 0ull) {
#pragma unroll
        for (int i = 0; i < 16; ++i) { O[0][i] *= corr; O[1][i] *= corr; }
    }
    __builtin_amdgcn_s_setprio(1);
#pragma unroll
    for (int blk = 0; blk < 2; ++blk)
#pragma unroll
        for (int st = 0; st < 2; ++st) {
            const s16x8 pb = pack8(blk ? S1 : S0, st);
#pragma unroll
            for (int dt = 0; dt < 2; ++dt) {
                const LAS bf16* vp = Vt + (32 * dt + r) * AT_VLD + 32 * blk + 16 * st + 4 * h;
                const s16x4 lo = *(const LAS s16x4*)vp, hi = *(const LAS s16x4*)(vp + 8);
                O[dt] = MFMA32(__builtin_shufflevector(lo, hi, 0, 1, 2, 3, 4, 5, 6, 7), pb, O[dt]);
            }
        }
    __builtin_amdgcn_s_setprio(0);
}

__device__ __forceinline__ void attn_mfma_phase(ArgP a, unsigned char* ws, LAS unsigned char* lds, int G, int bx, int wave_id) {
    const int tid = cur_tid(wave_id);
    const int lane = tid & 63, w = wave_id, r = lane & 31, h = lane >> 5, hd = r >> 3, ql = r & 7;
    LAS float* BLUT = (LAS float*)(lds + AT_BLUT); LAS float* IMP = (LAS float*)(lds + AT_IMP); LAS unsigned* SELM = (LAS unsigned*)(lds + AT_SELM);
    const bf16* Q = (const bf16*)(ws + WS_Q); bf16* Og = (bf16*)(ws + WS_O); const float* GATES = (const float*)(ws + WS_GATES);
    const bf16* KV = (const bf16*)(ws + WS_KV); const bf16* KC = (const bf16*)(ws + WS_KC); const bf16* VCT = (const bf16*)(ws + WS_VC); const bf16* VTS = (const bf16*)(ws + WS_VTS);
    const float* rel = AIN(a, 1);
    const LAS float* blut = BLUT + hd * 128;
    const int srow = tid >> 3, sch = tid & 7;
    for (int item = bx; item < BATCH * 4 * 32; item += G) {
        const int qb = ((item & 31) + 2 * (item >> 8)) & 31, g = (item >> 5) & 3, b = item >> 7;
        const int q0 = qb * 64, tq = q0 + 8 * w + ql, head = g * 4 + hd;
        const size_t row = (size_t)b * SEQ + tq;
        const int bg = b * 4 + g;
        __syncthreads();
#pragma unroll
        for (int j = 0; j < 2; ++j) { const int i = tid + 512 * j;
            { const int rr = i >> 3, ch = i & 7; *(LAS v4u*)((LAS bf16*)lds + rr * AT_KLD + ch * 8) = *(const v4u*)(KC + ((size_t)bg * 128 + rr) * 64 + ch * 8); }
            { const int rr = i >> 4, ch = i & 15; *(LAS v4u*)((LAS bf16*)(lds + AT_BUF) + rr * AT_CLD + ch * 8) = *(const v4u*)(VCT + ((size_t)bg * 64 + rr) * 128 + ch * 8); } }
        { const int hh = tid >> 7, dd = tid & 127; BLUT[hh * 128 + dd] = rel[rel_bucket(dd) * 16 + g * 4 + hh] * 1.4426950408889634f; }
        s16x8 qf[4];
#pragma unroll
        for (int kk = 0; kk < 4; ++kk) qf[kk] = *(const s16x8*)(Q + row * 1024 + head * 64 + 16 * kk + 8 * h);
        const float g0 = GATES[row * 48 + head * 3 + 0], g1 = GATES[row * 48 + head * 3 + 1], g2 = GATES[row * 48 + head * 3 + 2];
        f32x16 O[2];
        LAS float* otl = (LAS float*)(lds + AT_OT + w * 8192) + lane;
        __syncthreads();
        {
            const LAS bf16* Kc = (const LAS bf16*)lds; const LAS bf16* Vc = (const LAS bf16*)(lds + AT_BUF);
            float mx = NEGF, ps = 0.f;
            for (int kb = 0; kb < 4; ++kb) {
                f32x16 S;
#pragma unroll
                for (int i = 0; i < 16; ++i) S[i] = 0.f;
#pragma unroll
                for (int kk = 0; kk < 4; ++kk) S = MFMA32(*(const LAS s16x8*)(Kc + (32 * kb + r) * AT_KLD + 16 * kk + 8 * h), qf[kk], S);
                float bm = NEGF;
#pragma unroll
                for (int i = 0; i < 16; ++i) { const int ic = 32 * kb + (i & 3) + 8 * (i >> 2) + 4 * h; const int dist = tq - (16 * ic + 31);
                    const float bb = blut[min((unsigned)dist, 127u)]; S[i] = dist >= 0 ? S[i] + bb : NEGF; bm = fmaxf(bm, S[i]); }
                bm = fmaxf(bm, __shfl_xor(bm, 32));
                const float mn = fmaxf(mx, bm), me = fmaxf(mn, -1e29f); float bs = 0.f;
#pragma unroll
                for (int i = 0; i < 16; ++i) bs += __builtin_amdgcn_exp2f(S[i] - me);
                bs += __shfl_xor(bs, 32);
                ps = ps * __builtin_amdgcn_exp2f(mx - me) + bs; mx = mn;
            }
            const float m_eff = fmaxf(mx, -1e29f), linv = ps > 0.f ? 1.f / ps : 0.f;
#pragma unroll
            for (int i = 0; i < 16; ++i) { O[0][i] = 0.f; O[1][i] = 0.f; }
            float Lprev = 0.f;
            for (int kb = 0; kb < 4; ++kb) {
                f32x16 S;
#pragma unroll
                for (int i = 0; i < 16; ++i) S[i] = 0.f;
#pragma unroll
                for (int kk = 0; kk < 4; ++kk) S = MFMA32(*(const LAS s16x8*)(Kc + (32 * kb + r) * AT_KLD + 16 * kk + 8 * h), qf[kk], S);
#pragma unroll
                for (int i = 0; i < 16; ++i) { const int ic = 32 * kb + (i & 3) + 8 * (i >> 2) + 4 * h; const int dist = tq - (16 * ic + 31);
                    const float bb = blut[min((unsigned)dist, 127u)]; S[i] = dist >= 0 ? __builtin_amdgcn_exp2f(S[i] + bb - m_eff) * linv : 0.f; }
#pragma unroll
                for (int gq = 0; gq < 4; ++gq) {
                    const float Gs = (S[4 * gq] + S[4 * gq + 1]) + (S[4 * gq + 2] + S[4 * gq + 3]);
                    const float Lo = __shfl_xor(S[4 * gq + 3], 32);
                    float v = Gs + (h ? Lo : Lprev); Lprev = Lo;
                    v += __shfl_xor(v, 8); v += __shfl_xor(v, 16);
                    if (hd == 0) IMP[(8 * w + ql) * 32 + 2 * (4 * kb + gq) + h] = v; }
#pragma unroll
                for (int st = 0; st < 2; ++st) { const s16x8 pb = pack8(S, st);
#pragma unroll
                    for (int dt = 0; dt < 2; ++dt) { const LAS bf16* vp = Vc + (32 * dt + r) * AT_CLD + 32 * kb + 16 * st + 4 * h;
                        const s16x4 lo = *(const LAS s16x4*)vp, hi = *(const LAS s16x4*)(vp + 8);
                        O[dt] = MFMA32(__builtin_shufflevector(lo, hi, 0, 1, 2, 3, 4, 5, 6, 7), pb, O[dt]); } }
            }
#pragma unroll
            for (int i = 0; i < 16; ++i) { otl[i * 64] = g0 * O[0][i]; otl[(16 + i) * 64] = g0 * O[1][i]; }
        }
        __syncthreads();
        { const int q = tid >> 3, cur = (q0 + q) >> 6; unsigned mbits = 0u;
          for (int jj = 0; jj < 4; ++jj) { const int j = (tid & 7) * 4 + jj;
              const bool vj = j <= cur, fj = vj && (j == 0 || j > cur - 2); const float valj = fj ? 1e30f : (vj ? IMP[q * 32 + j] : -1e30f);
              int rank = 0;
              for (int k = 0; k < 32; ++k) { const bool vk = k <= cur, fk = vk && (k == 0 || k > cur - 2); const float valk = fk ? 1e30f : (vk ? IMP[q * 32 + k] : -1e30f);
                  rank += (valk > valj || (valk == valj && k < j)) ? 1 : 0; }
              if (rank < 8) mbits |= 1u << j; }
          mbits |= __shfl_xor(mbits, 1); mbits |= __shfl_xor(mbits, 2); mbits |= __shfl_xor(mbits, 4);
          if ((tid & 7) == 0) SELM[q] = mbits; }
        const int nsel = qb + 1, pw0 = q0 >= 512 ? q0 - 512 : 0, nwin = ((q0 - pw0) >> 6) + 1, ntile = nsel + nwin;
        const bf16* Ks = KV + (size_t)b * SEQ * NKV + 2 * 256 + g * 64; const bf16* Kw = KV + (size_t)b * SEQ * NKV + 4 * 256 + g * 64;
        const bf16* Vs = VTS + (size_t)bg * 64 * 2048; const bf16* Vw = VTS + (size_t)65536 * 256 + (size_t)bg * 64 * 2048;
        v4u kr0, vr0, kr1, vr1;
#define AT_LOAD(k, KR, VR) do { const bool sl_ = (k) < nsel; const int pb_ = sl_ ? 64 * (k) : pw0 + 64 * ((k) - nsel); \
            KR = *(const v4u*)((sl_ ? Ks : Kw) + (size_t)(pb_ + srow) * NKV + sch * 8); VR = *(const v4u*)((sl_ ? Vs : Vw) + (size_t)srow * 2048 + pb_ + sch * 8); } while (0)
#define AT_STORE(bufi, KR, VR) do { *(LAS v4u*)((LAS bf16*)(lds + (bufi) * AT_BUF) + srow * AT_KLD + sch * 8) = KR; { LAS bf16* vd_ = (LAS bf16*)(lds + (bufi) * AT_BUF + 64 * AT_KLD * 2) + srow * AT_VLD + sch * 8; *(LAS v2u*)vd_ = (v2u){VR.x, VR.y}; *(LAS v2u*)(vd_ + 4) = (v2u){VR.z, VR.w}; } } while (0)
        AT_LOAD(0, kr0, vr0); if (ntile > 1) AT_LOAD(1, kr1, vr1);
        AT_STORE(0, kr0, vr0);
        __syncthreads();
        const unsigned selm = SELM[8 * w + ql];
        float m_run = NEGF, l_run = 0.f;
#pragma unroll
        for (int i = 0; i < 16; ++i) { O[0][i] = 0.f; O[1][i] = 0.f; }
        const int tmin = q0 + 8 * w, tmax = tmin + 7;
        const float cbfar = blut[127];
        int bufc = 0;
#define AT_STEP(k, KRN, VRN, KRS, VRS) do { \
            if ((k) + 2 < ntile) AT_LOAD((k) + 2, KRN, VRN); \
            const bool sl = (k) < nsel; const int pbase = sl ? 64 * (k) : pw0 + 64 * ((k) - nsel); \
            const LAS bf16* Kt = (const LAS bf16*)(lds + bufc * AT_BUF); const LAS bf16* Vt = (const LAS bf16*)(lds + bufc * AT_BUF + 64 * AT_KLD * 2); \
            const bool ok = sl ? ((selm >> (k)) & 1u) != 0u : true; \
            const bool fast = (tmin - (pbase + 63) >= 113) && (sl || (tmax - pbase < 512));     \
            if (__builtin_amdgcn_ballot_w64(ok) != 0ull) {                  \
            if (fast) attn_tile<false>(Kt, Vt, qf, O, m_run, l_run, r, h, 0, 0u, ok, cbfar, blut); \
            else attn_tile<true>(Kt, Vt, qf, O, m_run, l_run, r, h, tq - pbase - 4 * h, sl ? 0x7fffffffu : 512u, ok, 0.f, blut); } \
            bufc = bufc == 2 ? 0 : bufc + 1; \
            if ((k) + 1 < ntile) AT_STORE(bufc, KRS, VRS); \
            __syncthreads(); \
            if ((k) == nsel - 1) {                                        \
                const float sc = l_run > 0.f ? g1 / l_run : 0.f; \
                _Pragma("unroll") for (int i = 0; i < 16; ++i) { otl[i * 64] += sc * O[0][i]; otl[(16 + i) * 64] += sc * O[1][i]; O[0][i] = 0.f; O[1][i] = 0.f; } \
                m_run = NEGF; l_run = 0.f; } } while (0)
        for (int k = 0; k < ntile; k += 2) {
            AT_STEP(k, kr0, vr0, kr1, vr1);
            if (k + 1 >= ntile) break;
            AT_STEP(k + 1, kr1, vr1, kr0, vr0);
        }
#undef AT_STEP
        { const float sc = l_run > 0.f ? g2 / l_run : 0.f;
#pragma unroll
          for (int i = 0; i < 16; ++i) { O[0][i] = otl[i * 64] + sc * O[0][i]; O[1][i] = otl[(16 + i) * 64] + sc * O[1][i]; } }
#undef AT_LOAD
#undef AT_STORE
#pragma unroll
        for (int dt = 0; dt < 2; ++dt)
#pragma unroll
            for (int gq = 0; gq < 4; ++gq) { v2u wv; wv.x = pkbf(O[dt][4 * gq], O[dt][4 * gq + 1]); wv.y = pkbf(O[dt][4 * gq + 2], O[dt][4 * gq + 3]);
                *(v2u*)(Og + row * 1024 + head * 64 + 32 * dt + 8 * gq + 4 * h) = wv; }
    }
    __syncthreads();
}

#define XB_TMO      128
#define XB_XCNT(j)  (256  + 64 * (j))
#define XB_XSUB(j)  (1280 + 64 * (j))
#define XB_XGEN(j)  (2304 + 64 * (j))
#define XB_TOP      3328
#define XB_TOPGEN   3392
#define XCD_BAR_WORDS 3456
#define XB_SPIN_CAP (1u << 18)
__device__ __forceinline__ unsigned xb_ld(unsigned* p)              { return __hip_atomic_load(p, __ATOMIC_RELAXED, __HIP_MEMORY_SCOPE_AGENT); }
__device__ __forceinline__ unsigned xb_add(unsigned* p, unsigned v) { return __hip_atomic_fetch_add(p, v, __ATOMIC_RELAXED, __HIP_MEMORY_SCOPE_AGENT); }
__device__ __forceinline__ unsigned xb_xcc_id() { return (unsigned)__builtin_amdgcn_s_getreg((3 << 11) | 20) & 0xFu; }
#define XB_SPIN(cond, bar) do { unsigned _sp = 0; while (cond) { __builtin_amdgcn_s_sleep(1); \
    if ((++_sp & 255u) == 0u) { if (xb_ld(&(bar)[XB_TMO])) break; if (_sp > XB_SPIN_CAP) { atomicAdd(&(bar)[XB_TMO], 1u); break; } } } } while (0)
__device__ __forceinline__ void xcd_barrier_complete(unsigned* bar, unsigned x, unsigned& nloc, unsigned& nx) {
    const unsigned G = gridDim.x * gridDim.y * gridDim.z;
    unsigned sum, cnt, mine, sp = 0u;
    for (;;) {
        sum = 0u; cnt = 0u; mine = 0u;
#pragma unroll
        for (unsigned j = 0; j < 16; ++j) { const unsigned c = xb_ld(&bar[XB_XCNT(j)]); sum += c; cnt += (c > 0u) ? 1u : 0u; mine = (j == x) ? c : mine; }
        if (sum == G) break;
        __builtin_amdgcn_s_sleep(1);
        if ((++sp & 255u) == 0u) { if (xb_ld(&bar[XB_TMO])) break; if (sp > XB_SPIN_CAP) { atomicAdd(&bar[XB_TMO], 1u); break; } }
    }
    nloc = mine > 0u ? mine : 1u; nx = cnt > 0u ? cnt : 1u;
}
__device__ __forceinline__ void xcd_barrier(unsigned* bar, unsigned x, volatile LAS unsigned* st, bool leader) {
    asm volatile("s_waitcnt vmcnt(0)" ::: "memory");
    __syncthreads();
    if (leader) {
        __builtin_amdgcn_s_waitcnt(0);
        unsigned nloc = st[0], nx = st[1];
        if (nloc == 0u) { xcd_barrier_complete(bar, x, nloc, nx); st[0] = nloc; st[1] = nx; }
        const unsigned old = xb_add(&bar[XB_XSUB(x)], 1u);
        const unsigned gen = old / nloc;
        if (old + 1u == (gen + 1u) * nloc) {
            __builtin_amdgcn_fence(__ATOMIC_RELEASE, "agent");
            asm volatile("s_waitcnt vmcnt(0)" ::: "memory");
            const unsigned og = xb_add(&bar[XB_TOP], 1u);
            const unsigned tg = og / nx;
            if (og + 1u == (tg + 1u) * nx) xb_add(&bar[XB_TOPGEN], 1u);
            else XB_SPIN(xb_ld(&bar[XB_TOPGEN]) == tg, bar);
            __builtin_amdgcn_fence(__ATOMIC_ACQUIRE, "agent");
            xb_add(&bar[XB_XGEN(x)], 1u);
            asm volatile("s_waitcnt vmcnt(0)" ::: "memory");
        } else {
            XB_SPIN(xb_ld(&bar[XB_XGEN(x)]) == gen, bar);
            __builtin_amdgcn_fence(__ATOMIC_ACQUIRE, "agent");
            asm volatile("s_waitcnt vmcnt(0)" ::: "memory");
        }
    }
    __syncthreads();
}

enum { PT_PREP = 0, PT_UP, PT_DOWN, PT_LN, PT_SGUIN, PT_SPATIAL, PT_SGUOUT, PT_KV, PT_CMP1, PT_CMP2, PT_QG, PT_ATTN, PT_WO };
constexpr int N_PHASES = 33;
constexpr int N_RUN = N_PHASES + (DUP_A >= 0 ? 2 : 0);
__device__ __forceinline__ void decode_phase(int ph, int& type, int& layer, int& pos) {
    pos = 0;
    if (ph == 0) { type = PT_PREP; layer = 0; return; }
    if (ph == N_PHASES - 1) { type = PT_LN; layer = 3; return; }
    if (ph <= 7) { layer = 0; pos = ph - 1; }
    else if (ph <= 14) { layer = 1; pos = ph - 8; }
    else if (ph <= 24) { layer = 2; pos = ph - 15; if (pos < 3) { type = PT_KV + pos; pos = 0; return; } pos -= 3; }
    else { layer = 3; pos = ph - 25; }
    const bool A = layer < 2;
    switch (pos) {
        case 0: case 5: type = PT_UP; break;
        case 1: case 6: type = PT_DOWN; break;
        case 2: type = A ? PT_SGUIN : PT_QG; break;
        case 3: type = A ? PT_SPATIAL : PT_ATTN; break;
        default: type = A ? PT_SGUOUT : PT_WO; break;
    }
}

__global__ void __launch_bounds__(NTHR, 2) mega_fwd(Args kargs) {
    extern __shared__ __attribute__((aligned(16))) unsigned char lds_raw[];
    LAS unsigned char* lds = (LAS unsigned char*)lds_raw;
    const int wave = __builtin_amdgcn_readfirstlane((int)threadIdx.x >> 6);
    int G = gridDim.x, bx = blockIdx.x;
    unsigned long long wsi = (unsigned long long)kargs.ws, Yi = (unsigned long long)kargs.out; const int ph_lo = kargs.ph_lo, ph_hi = kargs.ph_hi;
    LAS float* scr = (LAS float*)(lds + wave * 16384);
    using namespace pg8;
    volatile LAS unsigned* xst = (volatile LAS unsigned*)(lds + 147456);
    const unsigned xcc = xb_xcc_id();
    { const int t0 = cur_tid(wave); if (t0 == 0) { xst[0] = 0u; xst[1] = 0u; (void)xb_add((unsigned*)(kargs.ws + WS_CTL) + XB_XCNT(xcc), 1u); } }
    __syncthreads();

    for (int ph = ph_lo; ph < ph_hi; ++ph) {
        int type, layer, pos; decode_phase(DUP_A < 0 ? ph : (ph <= DUP_A ? ph : (ph <= DUP_B + 1 ? ph - 1 : ph - 2)), type, layer, pos);
        type = __builtin_amdgcn_readfirstlane(type); layer = __builtin_amdgcn_readfirstlane(layer); pos = __builtin_amdgcn_readfirstlane(pos);
        const __attribute__((address_space(4))) Args* ap = (const __attribute__((address_space(4))) Args*)__builtin_amdgcn_kernarg_segment_ptr(); asm volatile("" : "+s"(ap));
        const ArgP args = (ArgP)ap;
        const int tid = cur_tid(wave);
        const int lane = tid & 63;
        asm volatile("" : "+s"(wsi), "+s"(G), "+s"(bx), "+s"(Yi));
        unsigned char* ws = (unsigned char*)(__attribute__((address_space(1))) unsigned char*)wsi; float* Y = (float*)(__attribute__((address_space(1))) float*)Yi;
#if PROBE_MASK
        if (bx == 0 && tid == 0) { unsigned long long* pp = (unsigned long long*)(ws + WS_BIAS2 + 65536); if (ph == 0) pp[1] = 0ull; pp[0] = __builtin_amdgcn_s_memrealtime(); }
#endif
        bf16* HB = (bf16*)(ws + WS_HB); float* VEC = (float*)(ws + WS_VEC);
        const int gw = bx * NWAVES + wave, NGW = G * NWAVES;
        const int sub = pos >= 5 ? 1 : 0;
        const int dc = 3 * layer + (pos > 1 ? 1 : 0) + (pos > 4 ? 1 : 0);
        const float* PSc = dc > 0 ? (const float*)(ws + WS_PS + (size_t)((dc - 1) & 1) * PS_BYTES) : nullptr;
        float* PSn = (float*)(ws + WS_PS + (size_t)(dc & 1) * PS_BYTES);
        const int lnc = dc - 1;
        const float* lng = dc > 0 ? AIN(args, 2) + (size_t)lnc * D : nullptr; const float* lnb = dc > 0 ? AIN(args, 3) + (size_t)lnc * D : nullptr;
        const size_t wi = (size_t)(layer * 2 + sub);
        switch (type) {
        case PT_PREP: {
            for (int k = 0; k < 5; ++k) convert_set(args, ws, k, scr, gw, NGW, lane);
            if (gw < 512) { const int s = gw >> 8, j = gw & 255; const float* pe = AIN(args, 14) + (size_t)s * 2048; const float* w1 = AIN(args, 15) + (size_t)s * 2048 * 256; float acc = 0.f;
                for (int k = lane; k < 2048; k += 64) acc += pe[k] * w1[(size_t)k * 256 + j];
                acc = wave_sum(acc); if (lane == 0) ((float*)(ws + WS_BIAS2))[gw] = acc + AIN(args, 16)[gw]; }
            const float* x = AIN(args, 0);
            for (size_t i = (size_t)bx * NTHR + tid; i < (size_t)T * D / 8; i += (size_t)G * NTHR) { const f32x4 a0 = *((const f32x4*)x + 2 * i), a1 = *((const f32x4*)x + 2 * i + 1);
                *((v4u*)HB + i) = (v4u){cvt_pk_bf16(a0.x, a0.y), cvt_pk_bf16(a0.z, a0.w), cvt_pk_bf16(a1.x, a1.y), cvt_pk_bf16(a1.z, a1.w)}; }
        } break;
        case PT_UP: {
            Gemm g = make_gemm(HB, (const bf16*)(ws + WS_WUP + wi * UPW_BYTES), T, NUP, D); StaticOrder S; S.init(T, NUP, G, bx);
            EpiSwiGLU E{(bf16*)(ws + WS_U), FFN, PSc, VEC + VEC_UP + wi * 11264, VEC + VEC_UP + wi * 11264 + 5632};
            gemm_phase<EpiSwiGLU, StaticOrder>(lds, g, S, E, wave);
        } break;
        case PT_DOWN: {
            Gemm g = make_gemm((const bf16*)(ws + WS_U), (const bf16*)(ws + WS_WDN + wi * DNW_BYTES), T, D, FFN); StaticOrder S; S.init(T, D, G, bx);
            EpiResid E{dc > 0 ? Y : AIN(args, 0), Y, HB, PSc, PSn, lng, lnb, ALPHA, 0.5f, (layer == 3 && pos == 6) ? 1 : 0};
            gemm_phase<EpiResid, StaticOrder>(lds, g, S, E, wave);
        } break;
        case PT_LN: {
            const float* gg = AIN(args, 2) + (size_t)11 * D; const float* bb = AIN(args, 3) + (size_t)11 * D;
            for (int r = gw; r < T; r += NGW) ln_row(Y + (size_t)r * D, gg, bb, nullptr, nullptr, Y + (size_t)r * D, lane);
        } break;
        case PT_SGUIN: {
            Gemm g = make_gemm(HB, (const bf16*)(ws + WS_WMIXL + (size_t)layer * 8 * MiB), T, SGUH, D); StaticOrder S; S.init(T, SGUH, G, bx);
            EpiSguIn E{(bf16*)(ws + WS_UG), (bf16*)(ws + WS_VT), (float*)(ws + WS_VSTAT), PSc, VEC + VEC_MIX + layer * 8192, VEC + VEC_MIX + layer * 8192 + 4096, lds + STAGE_BYTES};
            gemm_phase<EpiSguIn, StaticOrder>(lds, g, S, E, wave);
        } break;
        case PT_SPATIAL: spatial_phase(args, ws, layer, lds, G, bx, wave, (DUP_A >= 0 && SGUIN_VARIANT && ph <= DUP_B + 1) ? 1 : 0); break;
        case PT_SGUOUT: case PT_WO: {
            const bool sg = type == PT_SGUOUT;
            Gemm g = make_gemm((const bf16*)(ws + (sg ? WS_UG : WS_O)), (const bf16*)(ws + WS_WMIX2L + (size_t)layer * 4 * MiB), T, D, sg ? SGUHALF : D); StaticOrder S; S.init(T, D, G, bx);
            EpiResid E{Y, Y, HB, PSc, PSn, lng, lnb, ALPHA, 1.0f, 0};
            gemm_phase<EpiResid, StaticOrder>(lds, g, S, E, wave);
        } break;
        case PT_KV: {
            Gemm g = make_gemm(HB, (const bf16*)(ws + WS_WKV), T, NKV, D); StaticOrder S; S.init(T, NKV, G, bx);
            EpiKV E{(bf16*)(ws + WS_KV), (bf16*)(ws + WS_VTS), PSc, VEC + VEC_KV, VEC + VEC_KV + 1536};
            gemm_phase<EpiKV, StaticOrder>(lds, g, S, E, wave);
        } break;
        case PT_CMP1: {
            const int half = G / 2, s = bx >= half ? 1 : 0;
            if (bx < 2 * half) {
                Gemm g; g.A = (const bf16*)(ws + WS_KV) + s * 256; g.Bt = (const bf16*)(ws + WS_WC1) + (size_t)s * 256 * 2048; g.M = NCMPROWS; g.N = 256; g.K = 2048;
                g.lda = 16 * NKV; g.a_kstep = NKV * 2; g.a_hstep = 64 * 2; g.a_div = 2; g.a_thi = (long)SEQ * NKV * 2; g.a_tlo = 128 * 2;
                StaticOrder S; S.init(NCMPROWS, 256, half, bx - s * half);
                EpiBf16<1> E{(bf16*)(ws + WS_HID) + (size_t)s * NCMPROWS * 256, 256, (const float*)(ws + WS_BIAS2) + s * 256};
                gemm_phase<EpiBf16<1>, StaticOrder>(lds, g, S, E, wave);
            }
        } break;
        case PT_CMP2: {
            const int half = G / 2, s = bx >= half ? 1 : 0;
            if (bx < 2 * half) {
                Gemm g = make_gemm((const bf16*)(ws + WS_HID) + (size_t)s * NCMPROWS * 256, (const bf16*)(ws + WS_WC2) + (size_t)s * 256 * 256, NCMPROWS, 256, 256);
                StaticOrder S; S.init(NCMPROWS, 256, half, bx - s * half);
                EpiCmp2 E{(bf16*)(ws + (s ? WS_VC : WS_KC)), s};
                gemm_phase<EpiCmp2, StaticOrder>(lds, g, S, E, wave);
            }
        } break;
        case PT_QG: {
            Gemm g = make_gemm(HB, (const bf16*)(ws + WS_WMIXL + (size_t)layer * 8 * MiB), T, NQGP, D); StaticOrder S; S.init(T, NQGP, G, bx);
            EpiQG E{(bf16*)(ws + WS_Q), (float*)(ws + WS_GATES), PSc, VEC + VEC_MIX + layer * 8192, VEC + VEC_MIX + layer * 8192 + 4096};
            gemm_phase<EpiQG, StaticOrder>(lds, g, S, E, wave);
        } break;
        case PT_ATTN: attn_mfma_phase(args, ws, lds, G, bx, wave); break;
        default: break;
        }
        if (ph + 1 < ph_hi) { if (ph == ph_lo) cg::this_grid().sync(); else xcd_barrier((unsigned*)(ws + WS_CTL), xcc, xst, tid == 0); }
#if PROBE_MASK
        if (bx == 0 && tid == 0 && ((PROBE_MASK >> type) & 1)) { unsigned long long* pp = (unsigned long long*)(ws + WS_BIAS2 + 65536); pp[1] += __builtin_amdgcn_s_memrealtime() - pp[0]; }
#endif
    }
#if PROBE_MASK
    __syncthreads();
    if (blockIdx.x == 0 && cur_tid(wave) == 0) { asm volatile("s_waitcnt vmcnt(0)" ::: "memory"); kargs.out[0] += (float)((unsigned long long*)(kargs.ws + WS_BIAS2 + 65536))[1] * 1e-5f; }
#endif
}

extern "C" void kernel_launch(void* const* d_in, const int* in_sizes, int n_in, void* d_out, int out_size, void* d_ws, size_t ws_size, hipStream_t stream) {
    static int grid = 0;
    if (grid == 0) {
        if (n_in != 20 || in_sizes[0] != T * D || out_size != T * D || ws_size < WS_END) { fprintf(stderr, "kernel_launch: unexpected shapes: n_in %d in0 %d out %d ws %zu\n", n_in, n_in > 0 ? in_sizes[0] : -1, out_size, ws_size); grid = -1; return; }
        int dev = 0, cus = 0, per_cu = 0;
        if (hipGetDevice(&dev) != hipSuccess || hipDeviceGetAttribute(&cus, hipDeviceAttributeMultiprocessorCount, dev) != hipSuccess) { grid = -1; return; }
        if (hipFuncSetAttribute((const void*)mega_fwd, hipFuncAttributeMaxDynamicSharedMemorySize, LDS_BYTES) != hipSuccess) { fprintf(stderr, "kernel_launch: hipFuncSetAttribute failed\n"); grid = -1; return; }
        if (hipOccupancyMaxActiveBlocksPerMultiprocessor(&per_cu, (const void*)mega_fwd, NTHR, LDS_BYTES) != hipSuccess || per_cu < 1) { fprintf(stderr, "kernel_launch: occupancy query says %d\n", per_cu); per_cu = 1; }
        (void)hipGetLastError();
        grid = cus * 1;
        if (grid & 1) grid -= 1;
    }
    if (grid < 0) return;
    Args a{};
    for (int i = 0; i < 20; ++i) a.in[i] = (const float*)d_in[i];
    a.out = (float*)d_out; a.ws = (unsigned char*)d_ws;
    if (hipMemsetAsync((char*)d_ws + WS_CTL, 0, CTL_BYTES, stream) != hipSuccess) { fprintf(stderr, "kernel_launch: hipMemsetAsync failed\n"); return; }
#if MK_PER_PHASE
    for (int ph = 0; ph < N_PHASES; ++ph) { a.ph_lo = ph; a.ph_hi = ph + 1; hipLaunchKernelGGL(mega_fwd, dim3(grid), dim3(NTHR), LDS_BYTES, stream, a); }
#else
    a.ph_lo = 0; a.ph_hi = N_RUN;
    void* kargs[] = {&a};
    hipError_t e = hipLaunchCooperativeKernel((const void*)mega_fwd, dim3(grid), dim3(NTHR), kargs, LDS_BYTES, stream);
    if (e != hipSuccess) fprintf(stderr, "kernel_launch: cooperative launch failed: %s (grid %d)\n", hipGetErrorString(e), grid);
#endif
}
```
